# Optimizing an MI355X kernel written in HIP

```python
import math
import jax, jax.numpy as jnp
from jax import lax
import numpy as np

D_MODEL = 1024
BATCH = 1
SEQ = 16384
DEPTH = 2

ATT_HEADS = 4
ATT_QK_DIM = D_MODEL // 16
ATT_V_DIM = 2 * ATT_QK_DIM
ATT_WIDTH = ATT_HEADS * ATT_V_DIM
Q_COLS = ATT_HEADS * 2 * ATT_QK_DIM
Q_BLOCK = 128
LRU_WIDTH = D_MODEL // 4
LRU_BLOCKS = 4
LRU_BLOCK_DIM = LRU_WIDTH // LRU_BLOCKS
LRU_CONV = 4
LRU_C = 8.0
CONV_WIDTH = D_MODEL // 4
CONV_KERNEL = 31
COL_WIDTHS = (Q_COLS, Q_COLS, ATT_WIDTH, LRU_WIDTH, LRU_WIDTH, CONV_WIDTH, CONV_WIDTH)
IN_COLS = sum(COL_WIDTHS)
SPLIT_POINTS = tuple(sum(COL_WIDTHS[:i + 1]) for i in range(len(COL_WIDTHS) - 1))
V_START = 2 * Q_COLS
V_END = V_START + ATT_WIDTH
D_MIX = ATT_WIDTH + LRU_WIDTH + CONV_WIDTH
N_EXPERTS = 32
TOP_K = 4
D_EXPERT = D_MODEL
SWIGLU_LIMIT = 7.0
SWIGLU_ALPHA = 1.702
MOE_BLOCK = 128
LN_EPS = 1e-5

kernel_name = "hymba_style_diffattn_rglru_conformer_moe_deepnorm"


def layer_norm(x, g, b):
    xf = x.astype(jnp.float32)
    mu = jnp.mean(xf, axis=-1, keepdims=True)
    var = jnp.mean(jnp.square(xf - mu), axis=-1, keepdims=True)
    y = (xf - mu) * lax.rsqrt(var + LN_EPS)
    return (y * g.astype(jnp.float32) + b.astype(jnp.float32)).astype(x.dtype)


def causal_depthwise_conv(x, w, b):
    k = w.shape[0]
    y = lax.conv_general_dilated(
        x, w.astype(x.dtype)[:, None, :], window_strides=(1,),
        padding=[(k - 1, 0)], dimension_numbers=('NWC', 'WIO', 'NWC'),
        feature_group_count=x.shape[-1])
    return y + b.astype(x.dtype)


def diff_attention(q, k, v, lam, slopes):
    B, S, H, _, DK = q.shape
    nqb = S // Q_BLOCK
    scale = DK ** -0.5
    qb = q.reshape(B, nqb, Q_BLOCK, H, 2, DK).transpose(1, 0, 2, 3, 4, 5)
    k_pos = jnp.arange(S)

    def block(args):
        q_blk, i = args
        q_pos = i * Q_BLOCK + jnp.arange(Q_BLOCK)
        s = jnp.einsum('bqhcd,bkhcd->bhcqk', q_blk, k).astype(jnp.float32) * scale
        dist = (q_pos[:, None] - k_pos[None, :]).astype(jnp.float32)
        s = s - (slopes[:, None, None] * dist[None])[None, :, None]
        s = jnp.where((dist >= 0)[None, None, None], s, -jnp.inf)
        p = jax.nn.softmax(s, axis=-1)
        attn = p[:, :, 0] - lam * p[:, :, 1]
        return jnp.einsum('bhqk,bkhd->bqhd', attn.astype(v.dtype), v)

    o = lax.map(block, (qb, jnp.arange(nqb)))
    return o.transpose(1, 0, 2, 3, 4).reshape(B, S, H, v.shape[-1])


def rg_lru(xc, wa, ba, wx, bx, lam_param):
    B, S, C = xc.shape
    xr = xc.reshape(B, S, LRU_BLOCKS, LRU_BLOCK_DIM)
    gate_a = jax.nn.sigmoid(jnp.einsum('bsnc,ncd->bsnd', xr, wa).reshape(B, S, C) + ba).astype(jnp.float32)
    gate_x = jax.nn.sigmoid(jnp.einsum('bsnc,ncd->bsnd', xr, wx).reshape(B, S, C) + bx).astype(jnp.float32)
    log_a = -LRU_C * gate_a * jax.nn.softplus(-lam_param.astype(jnp.float32))
    a = jnp.exp(log_a)
    mult = jnp.sqrt(1.0 - jnp.exp(2.0 * log_a))
    bterm = mult * gate_x * xc.astype(jnp.float32)

    def combine(left, right):
        a_l, b_l = left
        a_r, b_r = right
        return a_l * a_r, a_r * b_l + b_r

    _, h = lax.associative_scan(combine, (a, bterm), axis=1)
    return h.astype(xc.dtype)


def moe(x, router_w, router_b, w1, b1, w2, b2):
    B, S, D = x.shape
    T = B * S
    xf = x.reshape(T, D)
    logits = (xf @ router_w + router_b).astype(jnp.float32)
    top_vals, top_idx = lax.top_k(logits, TOP_K)
    gates = jax.nn.softmax(top_vals, axis=-1)
    n_assign = T * TOP_K
    expert_flat = top_idx.reshape(-1)
    token_flat = jnp.arange(n_assign) // TOP_K
    order = jnp.argsort(expert_flat)
    s_expert = expert_flat[order]
    s_token = token_flat[order]
    s_gate = gates.reshape(-1)[order]
    counts = jnp.bincount(expert_flat, length=N_EXPERTS)
    starts = jnp.cumsum(counts) - counts
    padded = (counts + MOE_BLOCK - 1) // MOE_BLOCK * MOE_BLOCK
    padded_end = jnp.cumsum(padded)
    padded_start = padded_end - padded
    dest = padded_start[s_expert] + jnp.arange(n_assign) - starts[s_expert]
    n_blocks = -(-(n_assign + N_EXPERTS * (MOE_BLOCK - 1)) // MOE_BLOCK)
    rows = n_blocks * MOE_BLOCK
    x_disp = jnp.zeros((rows, D), x.dtype).at[dest].set(xf[s_token])
    block_expert = jnp.minimum(
        jnp.searchsorted(padded_end, jnp.arange(n_blocks) * MOE_BLOCK, side='right'), N_EXPERTS - 1)

    def expert_block(args):
        xb, e = args
        hdn = xb @ w1[e] + b1[e]
        glu, lin = jnp.split(hdn, 2, axis=-1)
        glu = jnp.minimum(glu, SWIGLU_LIMIT)
        lin = jnp.clip(lin, -SWIGLU_LIMIT, SWIGLU_LIMIT)
        act = glu * jax.nn.sigmoid(SWIGLU_ALPHA * glu) * (lin + 1.0)
        return act @ w2[e] + b2[e]

    y_disp = lax.map(expert_block, (x_disp.reshape(n_blocks, MOE_BLOCK, D), block_expert)).reshape(rows, D)
    y = y_disp[dest] * s_gate[:, None].astype(x.dtype)
    out = jax.ops.segment_sum(y, s_token, num_segments=T)
    return out.reshape(B, S, D)


def setup_inputs(seed: int = 0) -> dict:
    key = jax.random.key(seed)
    ks = jax.random.split(key, 32)
    L, D = DEPTH, D_MODEL
    beta = (8.0 * DEPTH) ** -0.25

    def nrm(k, shape, scale):
        return jax.random.normal(k, shape, jnp.float32) * scale

    x = nrm(ks[0], (BATCH, SEQ, D), 1.0)
    ln_in_g = 1.0 + nrm(ks[1], (D,), 0.02)
    ln_in_b = nrm(ks[2], (D,), 0.02)
    col_scale = jnp.ones((IN_COLS,), jnp.float32).at[V_START:V_END].set(beta)
    w_in = nrm(ks[3], (L, D, IN_COLS), D ** -0.5) * col_scale
    lam_q1 = nrm(ks[4], (L, ATT_QK_DIM), 0.1)
    lam_k1 = nrm(ks[5], (L, ATT_QK_DIM), 0.1)
    lam_q2 = nrm(ks[6], (L, ATT_QK_DIM), 0.1)
    lam_k2 = nrm(ks[7], (L, ATT_QK_DIM), 0.1)
    subln_g = 1.0 + nrm(ks[8], (L, ATT_V_DIM), 0.02)
    lru_conv_w = nrm(ks[9], (L, LRU_CONV, LRU_WIDTH), LRU_CONV ** -0.5)
    lru_conv_b = nrm(ks[10], (L, LRU_WIDTH), 0.01)
    lru_wa = nrm(ks[11], (L, LRU_BLOCKS, LRU_BLOCK_DIM, LRU_BLOCK_DIM), LRU_BLOCK_DIM ** -0.5)
    lru_ba = nrm(ks[12], (L, LRU_WIDTH), 0.01)
    lru_wx = nrm(ks[13], (L, LRU_BLOCKS, LRU_BLOCK_DIM, LRU_BLOCK_DIM), LRU_BLOCK_DIM ** -0.5)
    lru_bx = nrm(ks[14], (L, LRU_WIDTH), 0.01)
    u = jax.random.uniform(ks[15], (L, LRU_WIDTH), jnp.float32, minval=0.9, maxval=0.999)
    sig = u ** (1.0 / LRU_C)
    lru_lambda = jnp.log(sig) - jnp.log1p(-sig)
    cf_conv_w = nrm(ks[16], (L, CONV_KERNEL, CONV_WIDTH), CONV_KERNEL ** -0.5)
    cf_conv_b = nrm(ks[17], (L, CONV_WIDTH), 0.01)
    cf_ln_g = 1.0 + nrm(ks[18], (L, CONV_WIDTH), 0.02)
    cf_ln_b = nrm(ks[19], (L, CONV_WIDTH), 0.02)
    w_out = nrm(ks[20], (L, D_MIX, D), D_MIX ** -0.5 * beta)
    ln1_g = 1.0 + nrm(ks[21], (L, D), 0.02)
    ln1_b = nrm(ks[22], (L, D), 0.02)
    router_w = nrm(ks[23], (L, D, N_EXPERTS), D ** -0.5)
    router_b = nrm(ks[24], (L, N_EXPERTS), 0.01)
    moe_w1 = nrm(ks[25], (L, N_EXPERTS, D, 2 * D_EXPERT), D ** -0.5)
    moe_b1 = nrm(ks[26], (L, N_EXPERTS, 2 * D_EXPERT), 0.01)
    moe_w2 = nrm(ks[27], (L, N_EXPERTS, D_EXPERT, D), D_EXPERT ** -0.5 * beta)
    moe_b2 = nrm(ks[28], (L, N_EXPERTS, D), 0.01)
    ln2_g = 1.0 + nrm(ks[29], (L, D), 0.02)
    ln2_b = nrm(ks[30], (L, D), 0.02)
    return {"x": x, "ln_in_g": ln_in_g, "ln_in_b": ln_in_b, "w_in": w_in,
            "lam_q1": lam_q1, "lam_k1": lam_k1, "lam_q2": lam_q2, "lam_k2": lam_k2,
            "subln_g": subln_g, "lru_conv_w": lru_conv_w, "lru_conv_b": lru_conv_b,
            "lru_wa": lru_wa, "lru_ba": lru_ba, "lru_wx": lru_wx, "lru_bx": lru_bx,
            "lru_lambda": lru_lambda, "cf_conv_w": cf_conv_w, "cf_conv_b": cf_conv_b,
            "cf_ln_g": cf_ln_g, "cf_ln_b": cf_ln_b, "w_out": w_out,
            "ln1_g": ln1_g, "ln1_b": ln1_b, "router_w": router_w, "router_b": router_b,
            "moe_w1": moe_w1, "moe_b1": moe_b1, "moe_w2": moe_w2, "moe_b2": moe_b2,
            "ln2_g": ln2_g, "ln2_b": ln2_b}


def reference(x, ln_in_g, ln_in_b, w_in, lam_q1, lam_k1, lam_q2, lam_k2, subln_g,
              lru_conv_w, lru_conv_b, lru_wa, lru_ba, lru_wx, lru_bx, lru_lambda,
              cf_conv_w, cf_conv_b, cf_ln_g, cf_ln_b, w_out, ln1_g, ln1_b,
              router_w, router_b, moe_w1, moe_b1, moe_w2, moe_b2, ln2_g, ln2_b):
    B, S, D = x.shape
    alpha = (2.0 * DEPTH) ** 0.25
    slopes = jnp.exp2(-8.0 * (jnp.arange(ATT_HEADS, dtype=jnp.float32) + 1.0) / ATT_HEADS)
    h = layer_norm(x, ln_in_g, ln_in_b)
    for l in range(DEPTH):
        u = h @ w_in[l]
        q, k, v, lru_x, lru_y, cf_a, cf_b = jnp.split(u, SPLIT_POINTS, axis=-1)
        lam_init = 0.8 - 0.6 * math.exp(-0.3 * l)
        lam = (jnp.exp(jnp.sum(lam_q1[l].astype(jnp.float32) * lam_k1[l].astype(jnp.float32)))
               - jnp.exp(jnp.sum(lam_q2[l].astype(jnp.float32) * lam_k2[l].astype(jnp.float32)))
               + lam_init)
        att = diff_attention(q.reshape(B, S, ATT_HEADS, 2, ATT_QK_DIM),
                             k.reshape(B, S, ATT_HEADS, 2, ATT_QK_DIM),
                             v.reshape(B, S, ATT_HEADS, ATT_V_DIM), lam, slopes)
        af = att.astype(jnp.float32)
        af = af * lax.rsqrt(jnp.mean(jnp.square(af), axis=-1, keepdims=True) + LN_EPS)
        att = (af * subln_g[l].astype(jnp.float32) * (1.0 - lam_init)).astype(h.dtype).reshape(B, S, ATT_WIDTH)
        xc = causal_depthwise_conv(lru_x, lru_conv_w[l], lru_conv_b[l])
        rec = rg_lru(xc, lru_wa[l], lru_ba[l], lru_wx[l], lru_bx[l], lru_lambda[l]) * jax.nn.gelu(lru_y)
        c = cf_a * jax.nn.sigmoid(cf_b)
        c = causal_depthwise_conv(c, cf_conv_w[l], cf_conv_b[l])
        c = jax.nn.silu(layer_norm(c, cf_ln_g[l], cf_ln_b[l]))
        mix = jnp.concatenate([att, rec, c], axis=-1) @ w_out[l]
        h = layer_norm(alpha * h + mix, ln1_g[l], ln1_b[l])
        ff = moe(h, router_w[l], router_b[l], moe_w1[l], moe_b1[l], moe_w2[l], moe_b2[l])
        h = layer_norm(alpha * h + ff, ln2_g[l], ln2_b[l])
    return h
```

```cpp
#include <hip/hip_runtime.h>
#include <cstdio>
#include <cstdint>

#ifndef MK_ONE_LAUNCH
#define MK_ONE_LAUNCH 1
#endif

#define LAS __attribute__((address_space(3)))
#define GAS __attribute__((address_space(1)))
typedef unsigned short bf16_t;
typedef short bf16x8 __attribute__((ext_vector_type(8)));
typedef float f32x2 __attribute__((ext_vector_type(2)));
typedef float f32x4 __attribute__((ext_vector_type(4)));
typedef float f32x16 __attribute__((ext_vector_type(16)));
typedef unsigned u32x4 __attribute__((ext_vector_type(4)));
typedef unsigned u32x2 __attribute__((ext_vector_type(2)));

constexpr int T = 16384, D = 1024, NL = 2, NE = 32, KD = 1024;
constexpr int NCOLA = 2048;
constexpr int UQ = 0, UK = 512, ULX = 1024, ULY = 1280, UCA = 1536, UCB = 1792;
constexpr float LN_EPS = 1e-5f;
constexpr float ALPHA = 1.41421356237309515f;
constexpr float LOG2E = 1.44269504088896341f;
constexpr int NWAVES = 8, NTHREADS = 512;
constexpr int ACT_ROWS = 65536 + 32 * 256 + 256;

constexpr size_t MiB = 1u << 20;
constexpr size_t WS_CTL = 0, CTL_ZERO_BYTES = 1 * MiB;
constexpr size_t WS_WINT = 2 * MiB;
constexpr size_t WS_WOUTT = 12 * MiB;
constexpr size_t WS_W1T = 16 * MiB;
constexpr size_t WS_W2T = 272 * MiB;
constexpr size_t WS_HA = 400 * MiB;
constexpr size_t WS_HB = 464 * MiB;
constexpr size_t WS_XB = 528 * MiB;
constexpr size_t WS_U = 560 * MiB;
constexpr size_t WS_VT = 624 * MiB;
constexpr size_t WS_MIX = 640 * MiB;
constexpr size_t WS_MIXO = 672 * MiB;
constexpr size_t WS_HLOC = 736 * MiB;
constexpr size_t WS_CUMA = 752 * MiB;
constexpr size_t WS_AGG = 768 * MiB;
constexpr size_t WS_TKS = 769 * MiB;
constexpr size_t WS_TKG = 769 * MiB + 512 * 1024;
constexpr size_t WS_LIST = 770 * MiB;
constexpr size_t WS_ACT = 772 * MiB;
constexpr size_t WS_Y = 920 * MiB;
constexpr size_t WS_END = 1068 * MiB;
static_assert(WS_ACT + (size_t)ACT_ROWS * 2048 <= WS_Y && WS_Y + (size_t)ACT_ROWS * 2048 <= WS_END, "ws map");
constexpr int CW_BAR = 4096;
constexpr int CW_CNT = 16384;

constexpr int RING_BYTES = 131072;
constexpr int MISC_OFF = RING_BYTES;
constexpr int LDS_BYTES = 147456;
constexpr int VA_PARK_OFF = MISC_OFF + 4096;

__device__ __forceinline__ unsigned f2bf(float f) { unsigned u = __builtin_bit_cast(unsigned, f); return (u + 0x7fffu + ((u >> 16) & 1u)) >> 16; }
__device__ __forceinline__ unsigned pk2(float lo, float hi) { return f2bf(lo) | (f2bf(hi) << 16); }
__device__ __forceinline__ float bf2f(bf16_t v) { return __builtin_bit_cast(float, (unsigned)v << 16); }
__device__ __forceinline__ float bflo(unsigned w) { return __builtin_bit_cast(float, w << 16); }
__device__ __forceinline__ float bfhi(unsigned w) { return __builtin_bit_cast(float, w & 0xffff0000u); }
__device__ __forceinline__ unsigned cvt_pk_bf16(float lo, float hi) { unsigned r; asm volatile("v_cvt_pk_bf16_f32 %0, %1, %2" : "=v"(r) : "v"(lo), "v"(hi)); return r; }
__device__ __forceinline__ float wave_sum(float v) {
#pragma unroll
    for (int o = 1; o < 64; o <<= 1) v += __shfl_xor(v, o);
    return v;
}
__device__ __forceinline__ float sigmoidf_(float x) { return 1.0f / (1.0f + __expf(-x)); }
#define LDS_WAIT() asm volatile("s_waitcnt lgkmcnt(0)" ::: "memory")
#define VM_WAIT() asm volatile("s_waitcnt vmcnt(0)" ::: "memory")

namespace pg8 {
constexpr int BM = 256, BK = 64, HALF = 128, HTB = HALF * BK * 2, STAGE_BYTES = 8 * HTB, NXCD = 8, WGM = 8;
__device__ __forceinline__ int lds_byte(int r, int c) { const int st = (r >> 4) * 2 + (c >> 5), rr = r & 15, cc = c & 31, ob = rr * 64 + cc * 2; return st * 1024 + (ob ^ (((ob >> 9) & 1) << 5)); }
__device__ __forceinline__ void stage_rc(int b, int& R, int& C) { const unsigned ub = (unsigned)b, st = ub >> 10, sb = ub & 1023u, swz = sb ^ (((sb >> 9) & 1u) << 5); R = (int)((st >> 1) * 16u + (swz >> 6)); C = (int)((st & 1u) * 32u + ((swz & 63u) >> 1)); }
__device__ __forceinline__ int perm32(int rho) { const int n = rho >> 4, i = rho & 15; return 8 * (i >> 2) + 4 * n + (i & 3); }

struct Unit { unsigned A, B; int pn, e, orow; unsigned va00, va01, va10, va11; };

struct PlainOrder {
    unsigned A, Bt; int nM, nN, nwg, G, c;
    __device__ void init(size_t A_, size_t Bt_, int M, int N, int G_, int c_) { A = (unsigned)A_; Bt = (unsigned)Bt_; nM = M / BM; nN = N / BM; nwg = nM * nN; G = G_; c = c_; }
    __device__ __forceinline__ bool next(int i, Unit& u, int tid) const {
        const long L = (long)i * G + c; if (L >= nwg) return false;
        int R0, C0, R1, C1; stage_rc(tid * 16, R0, C0); stage_rc(tid * 16 + 8192, R1, C1);
        int wgid = (int)L; { const int q = nwg / NXCD, r = nwg % NXCD, xcd = wgid % NXCD, off = wgid / NXCD; wgid = (xcd < r ? xcd * (q + 1) : r * (q + 1) + (xcd - r) * q) + off; }
        const int nig = WGM * nN, gid = wgid / nig, fm = gid * WGM, gsz = (nM - fm) < WGM ? (nM - fm) : WGM;
        const int pm = fm + ((wgid % nig) % gsz), pn = (wgid % nig) / gsz;
        u.A = A + (unsigned)pm * (BM * KD * 2); u.B = Bt + (unsigned)pn * (BM * KD * 2); u.pn = pn; u.e = 0; u.orow = pm * BM;
        u.va00 = (unsigned)(R0 * KD + C0) * 2u; u.va01 = (unsigned)(R1 * KD + C1) * 2u; u.va10 = (unsigned)((R0 + HALF) * KD + C0) * 2u; u.va11 = (unsigned)((R1 + HALF) * KD + C1) * 2u;
        return true;
    }
};

struct MoeOrder {
    unsigned Abase, Bt, bstride; int NT; int gather; const int* list; const LAS int* tab; int G, c;
    __device__ __forceinline__ bool next(int i, Unit& u, int tid) const {
        const int NU = __builtin_amdgcn_readfirstlane(tab[32]);
        int L;
        if ((G & 7) == 0) { const int g8 = G >> 3, per = (NU + 7) >> 3, idx = i * g8 + (c >> 3); if (idx >= per) return false; L = (c & 7) * per + idx; }
        else L = i * G + c;
        if (L >= NU) return false;
        int R0, C0, R1, C1; stage_rc(tid * 16, R0, C0); stage_rc(tid * 16 + 8192, R1, C1);
        const int ln_ = tid & 63;
        int e = __popcll(__ballot(ln_ >= 1 && ln_ < 32 && L >= tab[ln_ & 31]));
        e = __builtin_amdgcn_readfirstlane(e);
        const int ub = __builtin_amdgcn_readfirstlane(tab[e]), ub1 = __builtin_amdgcn_readfirstlane(tab[e + 1]);
        const int ps = __builtin_amdgcn_readfirstlane(tab[40 + e]), cnt = __builtin_amdgcn_readfirstlane(tab[80 + e]);
        const int tm = (ub1 - ub) / NT, r = L - ub, mt = r % tm, nt = r / tm;
        u.e = e; u.pn = nt; u.orow = ps + mt * BM;
        u.B = Bt + (unsigned)e * bstride + (unsigned)nt * (BM * KD * 2);
        if (gather) {
            u.A = Abase;
            const int* lp = list + (size_t)e * T + mt * BM; const int lim = cnt - mt * BM;
            const int t00 = (R0 < lim) ? lp[R0] : 0, t01 = (R1 < lim) ? lp[R1] : 0, t10 = (R0 + HALF < lim) ? lp[R0 + HALF] : 0, t11 = (R1 + HALF < lim) ? lp[R1 + HALF] : 0;
            u.va00 = (unsigned)(t00 * KD + C0) * 2u; u.va01 = (unsigned)(t01 * KD + C1) * 2u; u.va10 = (unsigned)(t10 * KD + C0) * 2u; u.va11 = (unsigned)(t11 * KD + C1) * 2u;
        } else {
            u.A = Abase + (unsigned)u.orow * (KD * 2);
            u.va00 = (unsigned)(R0 * KD + C0) * 2u; u.va01 = (unsigned)(R1 * KD + C1) * 2u; u.va10 = (unsigned)((R0 + HALF) * KD + C0) * 2u; u.va11 = (unsigned)((R1 + HALF) * KD + C1) * 2u;
        }
        return true;
    }
};

struct EpiBf16 {
    static constexpr bool PERM = true;
    bf16_t* O; int ldc; const float* bias; int bias_stride; float scale0; int scale_cols;
    __device__ __forceinline__ void operator()(const f32x4 (&acc)[2][2][4][2], const Unit& u, int wr, int wc, int fr, int fq) const {
        const int row0 = u.orow + wr * 64 + fr, colt = u.pn * BM, col0 = colt + wc * 32 + 8 * fq;
        const float sc = (colt < scale_cols) ? scale0 : 1.f;
        const float* bp = bias ? bias + (size_t)u.e * bias_stride : nullptr;
        f32x4 bv[2][2];
#pragma unroll
        for (int bj = 0; bj < 2; ++bj)
#pragma unroll
            for (int n = 0; n < 2; ++n) bv[bj][n] = bp ? *(const f32x4*)(bp + col0 + bj * HALF + 4 * n) : (f32x4){0.f, 0.f, 0.f, 0.f};
#pragma unroll
        for (int ai = 0; ai < 2; ++ai)
#pragma unroll
            for (int m = 0; m < 4; ++m) { bf16_t* rowp = O + (size_t)(row0 + ai * HALF + m * 16) * ldc + col0;
#pragma unroll
                for (int bj = 0; bj < 2; ++bj) { f32x4 v0 = (acc[ai][bj][m][0] + bv[bj][0]) * sc, v1 = (acc[ai][bj][m][1] + bv[bj][1]) * sc;
                    u32x4 w; w.x = cvt_pk_bf16(v0[0], v0[1]); w.y = cvt_pk_bf16(v0[2], v0[3]); w.z = cvt_pk_bf16(v1[0], v1[1]); w.w = cvt_pk_bf16(v1[2], v1[3]);
                    *(u32x4*)(rowp + bj * HALF) = w; } }
    }
};
struct EpiVT {
    static constexpr bool PERM = false;
    bf16_t* O;
    __device__ __forceinline__ void operator()(const f32x4 (&acc)[2][2][4][2], const Unit& u, int wr, int wc, int fr, int fq) const {
        const int sfq = (fq == 1) ? 2 : ((fq == 2) ? 1 : fq);
        const int row0 = u.orow + wr * 64 + fr, col0 = u.pn * BM + wc * 32 + 4 * sfq;
#pragma unroll
        for (int ai = 0; ai < 2; ++ai)
#pragma unroll
            for (int m = 0; m < 4; ++m) { bf16_t* rowp = O + (size_t)(row0 + ai * HALF + m * 16) * T + col0;
#pragma unroll
                for (int bj = 0; bj < 2; ++bj)
#pragma unroll
                    for (int n = 0; n < 2; ++n) { const f32x4 v = acc[ai][bj][m][n]; u32x2 w; w.x = cvt_pk_bf16(v[0], v[1]); w.y = cvt_pk_bf16(v[2], v[3]); *(u32x2*)(rowp + bj * HALF + n * 16) = w; } }
    }
};
struct EpiF32 {
    static constexpr bool PERM = false;
    float* O; int ldc;
    __device__ __forceinline__ void operator()(const f32x4 (&acc)[2][2][4][2], const Unit& u, int wr, int wc, int fr, int fq) const {
        const int row0 = u.orow + wr * 64 + fr, col0 = u.pn * BM + wc * 32 + 4 * fq;
#pragma unroll
        for (int ai = 0; ai < 2; ++ai)
#pragma unroll
            for (int m = 0; m < 4; ++m) { float* rowp = O + (size_t)(row0 + ai * HALF + m * 16) * ldc + col0;
#pragma unroll
                for (int bj = 0; bj < 2; ++bj)
#pragma unroll
                    for (int n = 0; n < 2; ++n) *(f32x4*)(rowp + bj * HALF + n * 16) = acc[ai][bj][m][n]; }
    }
};
struct EpiAct {
    static constexpr bool PERM = true;
    bf16_t* O; const float* b1;
    __device__ __forceinline__ void operator()(const f32x4 (&acc)[2][2][4][2], const Unit& u, int wr, int wc, int fr, int fq) const {
        const int row0 = u.orow + wr * 64 + fr, j0 = u.pn * HALF + wc * 32 + 8 * fq;
        const float* bp = b1 + (size_t)u.e * 2048;
        f32x4 bg[2], bl[2];
#pragma unroll
        for (int n = 0; n < 2; ++n) { bg[n] = *(const f32x4*)(bp + j0 + 4 * n); bl[n] = *(const f32x4*)(bp + 1024 + j0 + 4 * n); }
#pragma unroll
        for (int ai = 0; ai < 2; ++ai)
#pragma unroll
            for (int m = 0; m < 4; ++m) { bf16_t* rowp = O + (size_t)(row0 + ai * HALF + m * 16) * 1024 + j0;
                float o[8];
#pragma unroll
                for (int n = 0; n < 2; ++n)
#pragma unroll
                    for (int q = 0; q < 4; ++q) { float g = acc[ai][0][m][n][q] + bg[n][q], l = acc[ai][1][m][n][q] + bl[n][q];
                        g = fminf(g, 7.0f); l = fminf(fmaxf(l, -7.0f), 7.0f);
                        o[n * 4 + q] = g * (1.0f / (1.0f + __builtin_amdgcn_exp2f(-1.702f * LOG2E * g))) * (l + 1.0f); }
                u32x4 w; w.x = cvt_pk_bf16(o[0], o[1]); w.y = cvt_pk_bf16(o[2], o[3]); w.z = cvt_pk_bf16(o[4], o[5]); w.w = cvt_pk_bf16(o[6], o[7]);
                *(u32x4*)rowp = w; }
    }
};

template <class Epi, class Sched, bool ALIGN_EPI>
__device__ __forceinline__ void gemm_phase(LAS unsigned char* lds, const char* wsb, const int tid0, const Sched& S, const Epi& E) {
    Unit cur, nxt; int ui = 0;
    if (!S.next(0, cur, tid0)) return;
    int tid = tid0; asm volatile("" : "+v"(tid));
    const int wid = __builtin_amdgcn_readfirstlane(tid >> 6), lane = tid & 63, wr = wid >> 2, wc = wid & 3, fr = lane & 15, fq = lane >> 4;
    constexpr int K = KD, nt = K / BK;
    unsigned voffB[2];
    { int R0, C0, R1, C1; stage_rc(tid * 16, R0, C0); stage_rc(tid * 16 + 8192, R1, C1);
      const int Rb0 = Epi::PERM ? ((R0 & ~31) + perm32(R0 & 31)) : R0, Rb1 = Epi::PERM ? ((R1 & ~31) + perm32(R1 & 31)) : R1;
      voffB[0] = (unsigned)(Rb0 * K + C0) * 2u; voffB[1] = (unsigned)(Rb1 * K + C1) * 2u; }
    constexpr unsigned kstep = (unsigned)(BK * 2);
    constexpr unsigned hstep = (unsigned)HALF * K * 2;
    const unsigned ldsw = (unsigned)wid * 1024u;
    const int aoff = lds_byte(wr * 64 + fr, fq * 8), boff = lds_byte(wc * 32 + fr, fq * 8);
#define PG8_SA(b, h) (((b) * 2 + (h)) * HTB)
#define PG8_SB(b, h) ((4 + (b) * 2 + (h)) * HTB)
#define PG8_GLDS(gp, lp) __builtin_amdgcn_global_load_lds((const unsigned*)(gp), (LAS unsigned*)(lp), 16, 0, 0)
#define PG8_STB(bufoff, gbase) do { PG8_GLDS(wsb + (size_t)((gbase) + voffB[0]), lds + (bufoff) + ldsw); PG8_GLDS(wsb + (size_t)((gbase) + voffB[1]), lds + (bufoff) + ldsw + 8192); } while (0)
#define PG8_STA(bufoff, gbase, v0, v1) do { PG8_GLDS(wsb + (size_t)((gbase) + (v0)), lds + (bufoff) + ldsw); PG8_GLDS(wsb + (size_t)((gbase) + (v1)), lds + (bufoff) + ldsw + 8192); } while (0)
#define PG8_LDA(dst, b, h) do { _Pragma("unroll") for (int m = 0; m < 4; ++m) _Pragma("unroll") for (int k = 0; k < 2; ++k) dst[m][k] = *(const LAS bf16x8*)(lds + PG8_SA(b, h) + aoff + m * 2048 + k * 1024); } while (0)
#define PG8_LDB(dst, b, h) do { _Pragma("unroll") for (int n = 0; n < 2; ++n) _Pragma("unroll") for (int k = 0; k < 2; ++k) dst[n][k] = *(const LAS bf16x8*)(lds + PG8_SB(b, h) + boff + n * 2048 + k * 1024); } while (0)
#define PG8_MMA(ai, bj, At, Bt) do { __builtin_amdgcn_s_setprio(1); _Pragma("unroll") for (int m = 0; m < 4; ++m) _Pragma("unroll") for (int n = 0; n < 2; ++n) _Pragma("unroll") for (int k = 0; k < 2; ++k) \
        acc[ai][bj][m][n] = __builtin_amdgcn_mfma_f32_16x16x32_bf16(Bt[n][k], At[m][k], acc[ai][bj][m][n], 0, 0, 0); __builtin_amdgcn_s_setprio(0); } while (0)
#define PG8_WAIT_V(n) asm volatile("s_waitcnt vmcnt(" #n ")" ::: "memory")
#define PG8_WAIT_L(n) asm volatile("s_waitcnt lgkmcnt(" #n ")" ::: "memory")
#define PG8_BAR __builtin_amdgcn_s_barrier()
#define PG8_SCHED __builtin_amdgcn_sched_barrier(0)
    f32x4 acc[2][2][4][2];
#pragma unroll
    for (int a = 0; a < 2; ++a)
#pragma unroll
        for (int b = 0; b < 2; ++b)
#pragma unroll
            for (int m = 0; m < 4; ++m)
#pragma unroll
                for (int n = 0; n < 2; ++n) acc[a][b][m][n] = (f32x4){0.f, 0.f, 0.f, 0.f};
    bf16x8 At[4][2], B0[2][2], B1[2][2];
    unsigned cA = cur.A, cB = cur.B;
    unsigned c00 = cur.va00, c01 = cur.va01, c10 = cur.va10, c11 = cur.va11;
    PG8_STB(PG8_SB(0, 0), cB); PG8_STB(PG8_SB(0, 1), cB + hstep); PG8_STA(PG8_SA(0, 0), cA, c00, c01); PG8_STA(PG8_SA(0, 1), cA, c10, c11);
    if (wr == 1) PG8_BAR;
    PG8_WAIT_V(2); PG8_BAR;
    PG8_STB(PG8_SB(1, 0), cB + kstep); PG8_STA(PG8_SA(1, 0), cA + kstep, c00, c01); PG8_STB(PG8_SB(1, 1), cB + hstep + kstep);
    PG8_WAIT_V(6); PG8_BAR;
    for (;;) {
        const bool has_next = S.next(ui + 1, nxt, tid);
        const unsigned nA = has_next ? nxt.A : cA, nB = has_next ? nxt.B : cB;
        { u32x4 pv; pv.x = has_next ? nxt.va00 : c00; pv.y = has_next ? nxt.va01 : c01; pv.z = has_next ? nxt.va10 : c10; pv.w = has_next ? nxt.va11 : c11; *(LAS u32x4*)(lds + VA_PARK_OFF + tid * 16) = pv; }
        for (int t = 0; t < nt; t += 2) {
            const bool last = (t == nt - 2);
            const unsigned a1 = cA + (unsigned)(t + 1) * kstep;
            const unsigned a2 = last ? nA : cA + (unsigned)(t + 2) * kstep, b2 = last ? nB : cB + (unsigned)(t + 2) * kstep;
            const unsigned a3 = a2 + kstep, b3 = b2 + kstep;
            unsigned s00 = c00, s01 = c01, s10 = c10, s11 = c11;
            if (last) { const u32x4 pv = *(const LAS u32x4*)(lds + VA_PARK_OFF + tid * 16); s00 = pv.x; s01 = pv.y; s10 = pv.z; s11 = pv.w; }
            PG8_LDB(B0, 0, 0); PG8_LDB(B1, 0, 1); PG8_SCHED; PG8_LDA(At, 0, 0); PG8_STA(PG8_SA(1, 1), a1, c10, c11);
            PG8_WAIT_V(8); PG8_WAIT_L(0); PG8_BAR; PG8_MMA(0, 0, At, B0); PG8_MMA(0, 1, At, B1); PG8_BAR; PG8_SCHED;
            PG8_LDA(At, 0, 1); PG8_STB(PG8_SB(0, 0), b2); PG8_STB(PG8_SB(0, 1), b2 + hstep); PG8_STA(PG8_SA(0, 0), a2, s00, s01);
            PG8_WAIT_V(8); PG8_WAIT_L(0); PG8_BAR; PG8_MMA(1, 0, At, B0); PG8_MMA(1, 1, At, B1); PG8_BAR; PG8_SCHED;
            PG8_LDB(B0, 1, 0); PG8_LDB(B1, 1, 1); PG8_SCHED; PG8_LDA(At, 1, 0); PG8_STA(PG8_SA(0, 1), a2, s10, s11);
            PG8_WAIT_V(8); PG8_WAIT_L(0); PG8_BAR; PG8_MMA(0, 0, At, B0); PG8_MMA(0, 1, At, B1); PG8_BAR; PG8_SCHED;
            PG8_LDA(At, 1, 1); PG8_STB(PG8_SB(1, 0), b3); PG8_STB(PG8_SB(1, 1), b3 + hstep); PG8_STA(PG8_SA(1, 0), a3, s00, s01);
            PG8_WAIT_V(8); PG8_WAIT_L(0); PG8_BAR; PG8_MMA(1, 0, At, B0); PG8_MMA(1, 1, At, B1); PG8_BAR; PG8_SCHED;
        }
        if constexpr (ALIGN_EPI) { if (wr == 0) PG8_BAR; }
        E(acc, cur, wr, wc, fr, fq);
        if (!has_next) break;
#pragma unroll
        for (int a = 0; a < 2; ++a)
#pragma unroll
            for (int b = 0; b < 2; ++b)
#pragma unroll
                for (int m = 0; m < 4; ++m)
#pragma unroll
                    for (int n = 0; n < 2; ++n) acc[a][b][m][n] = (f32x4){0.f, 0.f, 0.f, 0.f};
        cur = nxt; cA = nA; cB = nB; { const u32x4 pv = *(const LAS u32x4*)(lds + VA_PARK_OFF + tid * 16); c00 = pv.x; c01 = pv.y; c10 = pv.z; c11 = pv.w; } ++ui;
        if constexpr (ALIGN_EPI) { if (wr == 1) PG8_BAR; }
    }
    PG8_WAIT_V(0);
    if constexpr (!ALIGN_EPI) { if (wr == 0) PG8_BAR; }
    PG8_BAR;
#undef PG8_SA
#undef PG8_SB
#undef PG8_GLDS
#undef PG8_STB
#undef PG8_STA
#undef PG8_LDA
#undef PG8_LDB
#undef PG8_MMA
#undef PG8_WAIT_V
#undef PG8_WAIT_L
#undef PG8_BAR
#undef PG8_SCHED
}
}

#define XB_TMO      128
#define XB_XCNT(j)  (256  + 64 * (j))
#define XB_XSUB(j)  (1280 + 64 * (j))
#define XB_XGEN(j)  (2304 + 64 * (j))
#define XB_TOP      3328
#define XB_TOPGEN   3392
#define XCD_BAR_WORDS 3456
#define XB_SPIN_CAP (1u << 22)
__device__ __forceinline__ unsigned xb_ld(unsigned* p)              { return __hip_atomic_load(p, __ATOMIC_RELAXED, __HIP_MEMORY_SCOPE_AGENT); }
__device__ __forceinline__ unsigned xb_add(unsigned* p, unsigned v) { return __hip_atomic_fetch_add(p, v, __ATOMIC_RELAXED, __HIP_MEMORY_SCOPE_AGENT); }
__device__ __forceinline__ unsigned xb_xcc_id() { return (unsigned)__builtin_amdgcn_s_getreg((3 << 11) | 20) & 0xFu; }
#define XB_SPIN(cond, bar) do { unsigned _sp = 0; while (cond) { __builtin_amdgcn_s_sleep(1); \
    if ((++_sp & 255u) == 0u) { if (xb_ld(&(bar)[XB_TMO])) break; if (_sp > XB_SPIN_CAP) { atomicAdd(&(bar)[XB_TMO], 1u); break; } } } } while (0)
struct XcdBarrier { unsigned* bar; unsigned x; volatile LAS unsigned* st; };
__device__ __forceinline__ XcdBarrier xcd_barrier_post(unsigned* bar, volatile LAS unsigned* st) {
    XcdBarrier b; b.bar = bar; b.x = xb_xcc_id(); b.st = st;
    if (threadIdx.x == 0) (void)xb_add(&bar[XB_XCNT(b.x)], 1u);
    return b;
}
__device__ __forceinline__ void xcd_barrier_complete(unsigned* bar, unsigned x, unsigned& nloc, unsigned& nx) {
    const unsigned G = gridDim.x * gridDim.y * gridDim.z;
    unsigned sum, cnt, mine, sp = 0u;
    for (;;) {
        sum = 0u; cnt = 0u; mine = 0u;
#pragma unroll
        for (unsigned j = 0; j < 16; ++j) { const unsigned c = xb_ld(&bar[XB_XCNT(j)]); sum += c; cnt += (c > 0u) ? 1u : 0u; mine = (j == x) ? c : mine; }
        if (sum == G) break;
        __builtin_amdgcn_s_sleep(1);
        if ((++sp & 255u) == 0u) { if (xb_ld(&bar[XB_TMO])) break; if (sp > XB_SPIN_CAP) { atomicAdd(&bar[XB_TMO], 1u); break; } }
    }
    nloc = mine > 0u ? mine : 1u; nx = cnt > 0u ? cnt : 1u;
}
__device__ __forceinline__ void xcd_barrier(const XcdBarrier& b) {
    asm volatile("s_waitcnt vmcnt(0)" ::: "memory");
    __syncthreads();
    if (threadIdx.x == 0) {
        unsigned* bar = b.bar;
        __builtin_amdgcn_s_waitcnt(0);
        unsigned nloc = b.st[0], nx = b.st[1];
        if (nloc == 0u) { xcd_barrier_complete(bar, b.x, nloc, nx); b.st[0] = nloc; b.st[1] = nx; }
        const unsigned old = xb_add(&bar[XB_XSUB(b.x)], 1u);
        const unsigned gen = old / nloc;
        if (old + 1u == (gen + 1u) * nloc) {
            __builtin_amdgcn_fence(__ATOMIC_RELEASE, "agent");
            asm volatile("s_waitcnt vmcnt(0)" ::: "memory");
            const unsigned og = xb_add(&bar[XB_TOP], 1u);
            const unsigned tg = og / nx;
            if (og + 1u == (tg + 1u) * nx) xb_add(&bar[XB_TOPGEN], 1u);
            else XB_SPIN(xb_ld(&bar[XB_TOPGEN]) == tg, bar);
            __builtin_amdgcn_fence(__ATOMIC_ACQUIRE, "agent");
            xb_add(&bar[XB_XGEN(b.x)], 1u);
            asm volatile("s_waitcnt vmcnt(0)" ::: "memory");
        } else {
            XB_SPIN(xb_ld(&bar[XB_XGEN(b.x)]) == gen, bar);
            __builtin_amdgcn_fence(__ATOMIC_ACQUIRE, "agent");
            asm volatile("s_waitcnt vmcnt(0)" ::: "memory");
        }
    }
    __syncthreads();
}

struct Args { const float* in[31]; float* out; unsigned char* ws; int ph_lo, ph_hi; };

struct Frame {
    LAS unsigned char* lds;
    int tid, lane, wave, G, bid;
    unsigned char* ws;
};
constexpr int PTAB_OFF = MISC_OFF + 3072;
struct InTab { LAS unsigned char* lds;
    __device__ __forceinline__ const float* operator[](int k) const {
        const LAS unsigned* p = (const LAS unsigned*)(lds + PTAB_OFF) + 2 * k;
        const unsigned lo = __builtin_amdgcn_readfirstlane(p[0]), hi = __builtin_amdgcn_readfirstlane(p[1]);
        return (const float*)(((unsigned long long)hi << 32) | lo); } };
struct ArgsV { InTab in; };
__device__ __forceinline__ Frame make_frame(LAS unsigned char* lds, unsigned char* ws) {
    Frame F; F.lds = lds;
    int tid = threadIdx.x; asm volatile("" : "+v"(tid));
    F.tid = tid; F.lane = tid & 63; F.wave = __builtin_amdgcn_readfirstlane(tid >> 6);
    F.G = gridDim.x; F.bid = blockIdx.x;
    unsigned long long w = (unsigned long long)ws; asm volatile("" : "+s"(w)); F.ws = (unsigned char*)w;
    return F;
}

__device__ __forceinline__ void transpose_item(const float* W, int N, bf16_t* WT, int k0, int n0, int drow0, LAS float* scr, int lane) {
#pragma unroll 8
    for (int i = 0; i < 32; ++i) { const int kk = 2 * i + (lane >> 5); scr[kk * 33 + (lane & 31)] = W[(size_t)(k0 + kk) * N + n0 + (lane & 31)]; }
    LDS_WAIT(); asm volatile("" ::: "memory");
    const int c = lane & 7;
#pragma unroll
    for (int j = 0; j < 4; ++j) { const int n = (lane >> 3) + 8 * j; const LAS float* s = scr + (8 * c) * 33 + n;
        u32x4 o; o.x = pk2(s[0 * 33], s[1 * 33]); o.y = pk2(s[2 * 33], s[3 * 33]); o.z = pk2(s[4 * 33], s[5 * 33]); o.w = pk2(s[6 * 33], s[7 * 33]);
        *(u32x4*)(WT + (size_t)(drow0 + n) * KD + k0 + 8 * c) = o; }
    LDS_WAIT(); asm volatile("" ::: "memory");
}
__device__ __forceinline__ void ln_store(f32x4 (&v)[4], const float* g, const float* b, float* of32, bf16_t* obf, int lane) {
    float s = 0.f;
#pragma unroll
    for (int j = 0; j < 4; ++j) s += (v[j].x + v[j].y) + (v[j].z + v[j].w);
    const float mean = wave_sum(s) * (1.f / D); float s2 = 0.f;
#pragma unroll
    for (int j = 0; j < 4; ++j) { v[j] = v[j] - mean; s2 += (v[j].x * v[j].x + v[j].y * v[j].y) + (v[j].z * v[j].z + v[j].w * v[j].w); }
    const float rstd = 1.f / sqrtf(wave_sum(s2) * (1.f / D) + LN_EPS);
#pragma unroll
    for (int j = 0; j < 4; ++j) {
        const f32x4 gv = *(const f32x4*)(g + 4 * lane + 256 * j), bv = *(const f32x4*)(b + 4 * lane + 256 * j);
        const f32x4 o = v[j] * rstd * gv + bv;
        if (of32) *(f32x4*)(of32 + 4 * lane + 256 * j) = o;
        if (obf) { u32x2 w; w.x = pk2(o.x, o.y); w.y = pk2(o.z, o.w); *(u32x2*)(obf + 4 * lane + 256 * j) = w; }
    }
}

__device__ __forceinline__ void phase_prologue(Frame& F, const ArgsV& A_) {
    LAS float* scr = (LAS float*)(F.lds + F.wave * 16384);
    const int gw = F.bid * NWAVES + F.wave, NGW = F.G * NWAVES;
    bf16_t* WINT = (bf16_t*)(F.ws + WS_WINT); bf16_t* WOUTT = (bf16_t*)(F.ws + WS_WOUTT); bf16_t* W1T = (bf16_t*)(F.ws + WS_W1T); bf16_t* W2T = (bf16_t*)(F.ws + WS_W2T);
    constexpr int I_IN = NL * 16 * 80, I_OUT = NL * 16 * 32, I_W1 = NL * NE * 16 * 64, I_W2 = NL * NE * 16 * 32;
    for (int it = gw; it < I_IN + I_OUT + I_W1 + I_W2; it += NGW) {
        int r = it;
        if (r < I_IN) { const int l = r / (16 * 80), q = r % (16 * 80), kb = q / 80, nb = q % 80, n0 = nb * 32;
            const int drow = (n0 < 1024) ? n0 : ((n0 < 1536) ? (2048 + n0 - 1024) : (n0 - 512));
            transpose_item(A_.in[3] + (size_t)l * 1024 * 2560, 2560, WINT + (size_t)l * 2560 * 1024, kb * 64, n0, drow, scr, F.lane); continue; }
        r -= I_IN;
        if (r < I_OUT) { const int l = r / (16 * 32), q = r % (16 * 32), kb = q / 32, nb = q % 32;
            transpose_item(A_.in[20] + (size_t)l * 1024 * 1024, 1024, WOUTT + (size_t)l * 1024 * 1024, kb * 64, nb * 32, nb * 32, scr, F.lane); continue; }
        r -= I_OUT;
        if (r < I_W1) { const int le = r / (16 * 64), q = r % (16 * 64), kb = q / 64, nb = q % 64, n0 = nb * 32;
            const int drow = (n0 < 1024) ? ((n0 >> 7) * 256 + (n0 & 127)) : (((n0 - 1024) >> 7) * 256 + 128 + ((n0 - 1024) & 127));
            transpose_item(A_.in[25] + (size_t)le * 1024 * 2048, 2048, W1T + (size_t)le * 2048 * 1024, kb * 64, n0, drow, scr, F.lane); continue; }
        r -= I_W1;
        { const int le = r / (16 * 32), q = r % (16 * 32), kb = q / 32, nb = q % 32;
            transpose_item(A_.in[27] + (size_t)le * 1024 * 1024, 1024, W2T + (size_t)le * 1024 * 1024, kb * 64, nb * 32, nb * 32, scr, F.lane); }
    }
    float* HA = (float*)(F.ws + WS_HA); bf16_t* XB = (bf16_t*)(F.ws + WS_XB);
    for (int m = gw; m < T; m += NGW) {
        f32x4 v[4];
#pragma unroll
        for (int j = 0; j < 4; ++j) v[j] = *(const f32x4*)(A_.in[0] + (size_t)m * D + 4 * F.lane + 256 * j);
        ln_store(v, A_.in[1], A_.in[2], HA + (size_t)m * D, XB + (size_t)m * D, F.lane);
    }
}

namespace attn {
__device__ __forceinline__ int crow(int r, int hi) { return (r & 3) + 8 * (r >> 2) + 4 * hi; }
__device__ __forceinline__ int swz(int row, int chunk) { return row * 128 + ((chunk ^ ((row >> 1) & 7)) << 4); }
#define MFMA32(a, b, c) __builtin_amdgcn_mfma_f32_32x32x16_bf16(a, b, c, 0, 0, 0)

__device__ __forceinline__ void attn_unit(LAS unsigned char* lds, const bf16_t* U, const bf16_t* VT, bf16_t* MIX, const float* subg, float lam, float outscale, int h, int qb, const int tid) {
    const int w = __builtin_amdgcn_readfirstlane(tid >> 6), lane = tid & 63, ln = lane & 31, hi = lane >> 5;
    const int c = w >> 2, rg = w & 3;
    const int i0 = qb * 128, rowmin = i0 + 32 * rg;
    const float slope2 = __builtin_amdgcn_exp2f(-2.0f * (float)(h + 1)) * LOG2E;
    bf16x8 Qf[4];
    { const bf16_t* qp = U + (size_t)(rowmin + ln) * NCOLA + UQ + h * 128 + c * 64 + 8 * hi;
#pragma unroll
      for (int ks = 0; ks < 4; ++ks) Qf[ks] = *(const bf16x8*)(qp + 16 * ks); }
    const int kkey = tid >> 4, kcc = tid & 15, vdv = tid >> 3, vch = tid & 7;
    const bf16_t* kg = U + (size_t)kkey * NCOLA + UK + h * 128 + kcc * 8;
    const bf16_t* vg = VT + (size_t)(h * 128 + vdv) * T + vch * 8;
    const int klds0 = (kcc >> 3) * 8192 + swz(kkey, kcc & 7), klds1 = (kcc >> 3) * 8192 + swz(kkey + 32, kcc & 7);
    const int vlds0 = 16384 + swz(vdv, vch), vlds1 = 16384 + swz(vdv + 64, vch);
    f32x16 O[4];
#pragma unroll
    for (int db = 0; db < 4; ++db)
#pragma unroll
        for (int r = 0; r < 16; ++r) O[db][r] = 0.f;
    float m = -__builtin_inff(), lsum = 0.f;
    const int jt_hi = 2 * qb + 1;
    u32x4 pk0, pk1, pv0, pv1;
    { const size_t j0 = (size_t)jt_hi * 64;
      pk0 = *(const u32x4*)(kg + j0 * NCOLA); pk1 = *(const u32x4*)(kg + (j0 + 32) * NCOLA); pv0 = *(const u32x4*)(vg + j0); pv1 = *(const u32x4*)(vg + j0 + (size_t)64 * T);
      *(LAS u32x4*)(lds + klds0) = pk0; *(LAS u32x4*)(lds + klds1) = pk1; *(LAS u32x4*)(lds + vlds0) = pv0; *(LAS u32x4*)(lds + vlds1) = pv1; }
    __syncthreads();
    for (int jt = jt_hi; jt >= 0; --jt) {
        const int cur = (jt_hi - jt) & 1;
        LAS unsigned char* buf = lds + cur * 32768;
        LAS unsigned char* nbuf = lds + (cur ^ 1) * 32768;
        if (jt > 0) { const size_t j0 = (size_t)(jt - 1) * 64;
            pk0 = *(const u32x4*)(kg + j0 * NCOLA); pk1 = *(const u32x4*)(kg + (j0 + 32) * NCOLA); pv0 = *(const u32x4*)(vg + j0); pv1 = *(const u32x4*)(vg + j0 + (size_t)64 * T); }
        const int j0 = jt * 64;
        if (j0 <= rowmin + 31) {
            f32x16 s0, s1;
            { const float b0 = slope2 * (float)(j0 + 4 * hi - i0);
#pragma unroll
              for (int r = 0; r < 16; ++r) { s0[r] = b0 + slope2 * (float)((r & 3) + 8 * (r >> 2)); s1[r] = s0[r] + slope2 * 32.0f; } }
#pragma unroll
            for (int ks = 0; ks < 4; ++ks) {
                const bf16x8 k0 = *(const LAS bf16x8*)(buf + c * 8192 + swz(ln, 2 * ks + hi));
                const bf16x8 k1 = *(const LAS bf16x8*)(buf + c * 8192 + swz(ln + 32, 2 * ks + hi));
                s0 = MFMA32(k0, Qf[ks], s0); s1 = MFMA32(k1, Qf[ks], s1);
            }
            if (j0 + 63 > rowmin) {
                const int qrow = rowmin + ln;
#pragma unroll
                for (int r = 0; r < 16; ++r) { const int key = j0 + crow(r, hi); if (key > qrow) s0[r] = -__builtin_inff(); if (key + 32 > qrow) s1[r] = -__builtin_inff(); }
            }
            float mx = fmaxf(s0[0], s1[0]);
#pragma unroll
            for (int r = 1; r < 16; ++r) mx = fmaxf(mx, fmaxf(s0[r], s1[r]));
            mx = fmaxf(mx, __shfl_xor(mx, 32));
            if (__any(mx > m)) {
                const float mn = fmaxf(m, mx), al = __builtin_amdgcn_exp2f(m - mn);
#pragma unroll
                for (int db = 0; db < 4; ++db)
#pragma unroll
                    for (int r = 0; r < 16; ++r) O[db][r] *= al;
                lsum *= al; m = mn;
            }
#pragma unroll
            for (int r = 0; r < 16; ++r) { s0[r] = __builtin_amdgcn_exp2f(s0[r] - m); s1[r] = __builtin_amdgcn_exp2f(s1[r] - m); lsum += s0[r] + s1[r]; }
            bf16x8 Pf[4];
#pragma unroll
            for (int s2 = 0; s2 < 2; ++s2) {
                u32x4 a, b;
                a.x = cvt_pk_bf16(s0[8 * s2 + 0], s0[8 * s2 + 1]); a.y = cvt_pk_bf16(s0[8 * s2 + 2], s0[8 * s2 + 3]); a.z = cvt_pk_bf16(s0[8 * s2 + 4], s0[8 * s2 + 5]); a.w = cvt_pk_bf16(s0[8 * s2 + 6], s0[8 * s2 + 7]);
                b.x = cvt_pk_bf16(s1[8 * s2 + 0], s1[8 * s2 + 1]); b.y = cvt_pk_bf16(s1[8 * s2 + 2], s1[8 * s2 + 3]); b.z = cvt_pk_bf16(s1[8 * s2 + 4], s1[8 * s2 + 5]); b.w = cvt_pk_bf16(s1[8 * s2 + 6], s1[8 * s2 + 7]);
                Pf[s2] = __builtin_bit_cast(bf16x8, a); Pf[2 + s2] = __builtin_bit_cast(bf16x8, b);
            }
#pragma unroll
            for (int db = 0; db < 4; ++db)
#pragma unroll
                for (int g = 0; g < 4; ++g) {
                    const bf16x8 vf = *(const LAS bf16x8*)(buf + 16384 + swz(32 * db + ln, 2 * g + hi));
                    O[db] = MFMA32(vf, Pf[g], O[db]);
                }
        }
        if (jt > 0) { *(LAS u32x4*)(nbuf + klds0) = pk0; *(LAS u32x4*)(nbuf + klds1) = pk1; *(LAS u32x4*)(nbuf + vlds0) = pv0; *(LAS u32x4*)(nbuf + vlds1) = pv1; }
        __syncthreads();
    }
    const float ltot = lsum + __shfl_xor(lsum, 32);
    LAS float* ex = (LAS float*)lds;
    if (c == 1) {
        const float sc = lam / ltot;
#pragma unroll
        for (int db = 0; db < 4; ++db)
#pragma unroll
            for (int r = 0; r < 16; ++r) ex[(rg * 64 + db * 16 + r) * 64 + lane] = O[db][r] * sc;
    }
    __syncthreads();
    if (c == 0) {
        const float inv = 1.0f / ltot; float ss = 0.f;
#pragma unroll
        for (int db = 0; db < 4; ++db)
#pragma unroll
            for (int r = 0; r < 16; ++r) { const float o = O[db][r] * inv - ex[(rg * 64 + db * 16 + r) * 64 + lane]; O[db][r] = o; ss += o * o; }
        ss += __shfl_xor(ss, 32);
        const float rn = (1.0f / sqrtf(ss * (1.0f / 128.0f) + LN_EPS)) * outscale;
        bf16_t* op = MIX + (size_t)(rowmin + ln) * 1024 + h * 128 + 4 * hi;
#pragma unroll
        for (int db = 0; db < 4; ++db)
#pragma unroll
            for (int g = 0; g < 4; ++g) { const int dv0 = 32 * db + 8 * g;
                const f32x4 gv = *(const f32x4*)(subg + dv0 + 4 * hi);
                u32x2 wv; wv.x = cvt_pk_bf16(O[db][4 * g + 0] * rn * gv.x, O[db][4 * g + 1] * rn * gv.y); wv.y = cvt_pk_bf16(O[db][4 * g + 2] * rn * gv.z, O[db][4 * g + 3] * rn * gv.w);
                *(u32x2*)(op + dv0) = wv; }
    }
    __syncthreads();
}
#undef MFMA32
}

__device__ __forceinline__ void phase_attention(Frame& F, const ArgsV& A_, int l) {
    const bf16_t* U = (const bf16_t*)(F.ws + WS_U); const bf16_t* VT = (const bf16_t*)(F.ws + WS_VT); bf16_t* MIX = (bf16_t*)(F.ws + WS_MIX);
    float d1 = 0.f, d2 = 0.f;
    for (int i = 0; i < 64; ++i) { d1 += A_.in[4][l * 64 + i] * A_.in[5][l * 64 + i]; d2 += A_.in[6][l * 64 + i] * A_.in[7][l * 64 + i]; }
    const float lam_init = 0.8f - 0.6f * expf(-0.3f * (float)l);
    const float lam = expf(d1) - expf(d2) + lam_init;
    for (int uu = F.bid; uu < 512; uu += 2 * F.G) {
        { const int u = uu; attn::attn_unit(F.lds, U, VT, MIX, A_.in[8] + l * 128, lam, 1.0f - lam_init, u & 3, 127 - (u >> 2), F.tid); }
        { const int u = 511 - uu; if (u >= 0 && u != uu) attn::attn_unit(F.lds, U, VT, MIX, A_.in[8] + l * 128, lam, 1.0f - lam_init, u & 3, 127 - (u >> 2), F.tid); }
    }
}

__device__ __forceinline__ void phase_lru_local(Frame& F, const ArgsV& A_, int l) {
    const bf16_t* U = (const bf16_t*)(F.ws + WS_U);
    float* HLOC = (float*)(F.ws + WS_HLOC); float* CUMA = (float*)(F.ws + WS_CUMA); float* AGG = (float*)(F.ws + WS_AGG);
    const float* cw = A_.in[9] + l * 4 * 256; const float* cb = A_.in[10] + l * 256;
    const float* wa = A_.in[11] + l * 4 * 4096; const float* ba = A_.in[12] + l * 256;
    const float* wx = A_.in[13] + l * 4 * 4096; const float* bx = A_.in[14] + l * 256; const float* lamp = A_.in[15] + l * 256;
    LAS float* wA = (LAS float*)F.lds; LAS float* wX = wA + 4096; LAS float* xc = wA + 8192; LAS float* wagg = wA + 8192 + 16384;
    const int w = F.wave, d = F.lane;
    for (int unit = F.bid; unit < 256; unit += F.G) {
        const int chunk = unit >> 2, blk = unit & 3, t0 = chunk * 256, ch0 = blk * 64;
        for (int i = F.tid; i < 4096; i += NTHREADS) { wA[i] = wa[blk * 4096 + i]; wX[i] = wx[blk * 4096 + i]; }
        { const int dd = F.tid & 63, ch = ch0 + dd; const float w0 = cw[ch], w1 = cw[256 + ch], w2 = cw[512 + ch], w3 = cw[768 + ch], bb = cb[ch];
          for (int t = F.tid >> 6; t < 256; t += 8) { const int tt = t0 + t; float a = bb;
              const bf16_t* up = U + (size_t)tt * NCOLA + ULX + ch;
              if (tt >= 3) a += w0 * bf2f(up[-3 * NCOLA]);
              if (tt >= 2) a += w1 * bf2f(up[-2 * NCOLA]);
              if (tt >= 1) a += w2 * bf2f(up[-1 * NCOLA]);
              a += w3 * bf2f(up[0]);
              xc[t * 64 + dd] = a; } }
        __syncthreads();
        float ga[32], gx[32];
#pragma unroll
        for (int tt = 0; tt < 32; ++tt) { ga[tt] = 0.f; gx[tt] = 0.f; }
        for (int cc = 0; cc < 64; ++cc) { const float wav = wA[cc * 64 + d], wxv = wX[cc * 64 + d];
#pragma unroll
            for (int tt = 0; tt < 32; ++tt) { const float x = xc[(32 * w + tt) * 64 + cc]; ga[tt] += x * wav; gx[tt] += x * wxv; } }
        const int ch = ch0 + d; const float bav = ba[ch], bxv = bx[ch];
        const float sp = log1pf(expf(-lamp[ch]));
        float hl = 0.f, ca = 1.f;
#pragma unroll
        for (int tt = 0; tt < 32; ++tt) {
            const float sa = sigmoidf_(ga[tt] + bav), sx = sigmoidf_(gx[tt] + bxv);
            const float log_a = -8.0f * sa * sp, a = expf(log_a), mult = sqrtf(-expm1f(2.0f * log_a));
            const float b = mult * sx * xc[(32 * w + tt) * 64 + d];
            hl = a * hl + b; ca *= a; ga[tt] = hl; gx[tt] = ca;
        }
        wagg[(w * 2 + 0) * 64 + d] = ca; wagg[(w * 2 + 1) * 64 + d] = hl;
        __syncthreads();
        float cin = 0.f, cprod = 1.f;
        for (int w2 = 0; w2 < w; ++w2) { const float A2 = wagg[(w2 * 2 + 0) * 64 + d], B2 = wagg[(w2 * 2 + 1) * 64 + d]; cin = A2 * cin + B2; cprod *= A2; }
#pragma unroll
        for (int tt = 0; tt < 32; ++tt) { const size_t o = (size_t)(t0 + 32 * w + tt) * 256 + ch; const float hh = ga[tt] + gx[tt] * cin, cA = gx[tt] * cprod; HLOC[o] = hh; CUMA[o] = cA;
            if (w == 7 && tt == 31) { AGG[(chunk * 2 + 0) * 256 + ch] = cA; AGG[(chunk * 2 + 1) * 256 + ch] = hh; } }
        __syncthreads();
    }
}
__device__ __forceinline__ void phase_lru_fix(Frame& F, const ArgsV& A_, int l) {
    const bf16_t* U = (const bf16_t*)(F.ws + WS_U); bf16_t* MIX = (bf16_t*)(F.ws + WS_MIX);
    const float* HLOC = (const float*)(F.ws + WS_HLOC); const float* CUMA = (const float*)(F.ws + WS_CUMA); const float* AGG = (const float*)(F.ws + WS_AGG);
    const int ch = F.tid & 255, half = F.tid >> 8;
    for (int unit = F.bid; unit < 256; unit += F.G) {
        const int chunk = unit >> 2, qt = unit & 3, t0 = chunk * 256 + qt * 64 + half * 32;
        float cin = 0.f;
        for (int k = 0; k < chunk; ++k) cin = AGG[(k * 2 + 0) * 256 + ch] * cin + AGG[(k * 2 + 1) * 256 + ch];
        for (int t = 0; t < 32; ++t) { const size_t tt = (size_t)(t0 + t);
            const float hh = HLOC[tt * 256 + ch] + CUMA[tt * 256 + ch] * cin;
            const float y = bf2f(U[tt * NCOLA + ULY + ch]);
            const float gl = 0.5f * y * (1.0f + tanhf(0.7978845608028654f * (y + 0.044715f * y * y * y)));
            MIX[tt * 1024 + 512 + ch] = (bf16_t)f2bf(hh * gl); }
    }
}

__device__ __forceinline__ void phase_conformer(Frame& F, const ArgsV& A_, int l) {
    const bf16_t* U = (const bf16_t*)(F.ws + WS_U); bf16_t* MIX = (bf16_t*)(F.ws + WS_MIX);
    const float* cw = A_.in[16] + l * 31 * 256; const float* cb = A_.in[17] + l * 256; const float* lg = A_.in[18] + l * 256; const float* lb = A_.in[19] + l * 256;
    LAS float* gin = (LAS float*)F.lds; LAS float* cout = gin + 62 * 256;
    const int ch = F.tid & 255, half = F.tid >> 8;
    float wreg[31];
#pragma unroll
    for (int j = 0; j < 31; ++j) wreg[j] = cw[j * 256 + ch];
    const float bb = cb[ch];
    for (int unit = F.bid; unit < 512; unit += F.G) {
        const int t0 = unit * 32;
        for (int i = F.tid; i < 62 * 256; i += NTHREADS) { const int r = i >> 8, c2 = i & 255, ts = t0 - 30 + r; float v = 0.f;
            if (ts >= 0) { const float a = bf2f(U[(size_t)ts * NCOLA + UCA + c2]), b = bf2f(U[(size_t)ts * NCOLA + UCB + c2]); v = a * sigmoidf_(b); }
            gin[i] = v; }
        __syncthreads();
        for (int tt = 0; tt < 16; ++tt) { const int t = half * 16 + tt; float a = bb;
#pragma unroll
            for (int j = 0; j < 31; ++j) a += wreg[j] * gin[(t + j) * 256 + ch];
            cout[t * 256 + ch] = a; }
        __syncthreads();
#pragma unroll
        for (int q = 0; q < 4; ++q) { const int t = 4 * F.wave + q;
            f32x4 v = *(const LAS f32x4*)(cout + t * 256 + 4 * F.lane);
            const float mean = wave_sum((v.x + v.y) + (v.z + v.w)) * (1.f / 256.f); v = v - mean;
            const float var = wave_sum((v.x * v.x + v.y * v.y) + (v.z * v.z + v.w * v.w)) * (1.f / 256.f), rstd = 1.f / sqrtf(var + LN_EPS);
            const f32x4 gv = *(const f32x4*)(lg + 4 * F.lane), bv = *(const f32x4*)(lb + 4 * F.lane);
            f32x4 y = v * rstd * gv + bv;
            y.x = y.x * sigmoidf_(y.x); y.y = y.y * sigmoidf_(y.y); y.z = y.z * sigmoidf_(y.z); y.w = y.w * sigmoidf_(y.w);
            u32x2 wv; wv.x = pk2(y.x, y.y); wv.y = pk2(y.z, y.w);
            *(u32x2*)(MIX + (size_t)(t0 + t) * 1024 + 768 + 4 * F.lane) = wv; }
        __syncthreads();
    }
}

__device__ __forceinline__ void phase_ln1(Frame& F, const ArgsV& A_, int l) {
    const float* HA = (const float*)(F.ws + WS_HA); const float* MO = (const float*)(F.ws + WS_MIXO); float* HB = (float*)(F.ws + WS_HB); bf16_t* XB = (bf16_t*)(F.ws + WS_XB);
    const int gw = F.bid * NWAVES + F.wave, NGW = F.G * NWAVES;
    for (int m = gw; m < T; m += NGW) {
        f32x4 v[4];
#pragma unroll
        for (int j = 0; j < 4; ++j) v[j] = *(const f32x4*)(HA + (size_t)m * D + 4 * F.lane + 256 * j) * ALPHA + *(const f32x4*)(MO + (size_t)m * D + 4 * F.lane + 256 * j);
        ln_store(v, A_.in[21] + l * D, A_.in[22] + l * D, HB + (size_t)m * D, XB + (size_t)m * D, F.lane);
    }
}

__device__ __forceinline__ void phase_router(Frame& F, const ArgsV& A_, int l) {
    const float* HB = (const float*)(F.ws + WS_HB); const float* rw = A_.in[23] + (size_t)l * 1024 * 32; const float* rb = A_.in[24] + l * 32;
    int* TKS = (int*)(F.ws + WS_TKS); float* TKG = (float*)(F.ws + WS_TKG); int* LIST = (int*)(F.ws + WS_LIST);
    unsigned* gcnt = (unsigned*)(F.ws + WS_CTL) + CW_CNT + l * 64;
    LAS float* lg = (LAS float*)F.lds;
    LAS unsigned* lcnt = (LAS unsigned*)(F.lds + 65536);
    const int ln = F.lane & 31, hf = F.lane >> 5;
    for (int base = F.bid * 256; base < T; base += F.G * 256) {
        if (F.tid < 64) lcnt[F.tid] = 0u;
        __syncthreads();
        const int tok0 = base + F.wave * 32;
        f32x16 acc;
#pragma unroll
        for (int r = 0; r < 16; ++r) acc[r] = 0.f;
        const float* hp = HB + (size_t)(tok0 + ln) * D + 4 * hf;
        for (int i = 0; i < 128; ++i) {
            const f32x4 hv = *(const f32x4*)(hp + 8 * i);
            const float* rp = rw + (size_t)(8 * i + 4 * hf) * 32 + ln;
            acc = __builtin_amdgcn_mfma_f32_32x32x2f32(rp[0], hv.x, acc, 0, 0, 0);
            acc = __builtin_amdgcn_mfma_f32_32x32x2f32(rp[32], hv.y, acc, 0, 0, 0);
            acc = __builtin_amdgcn_mfma_f32_32x32x2f32(rp[64], hv.z, acc, 0, 0, 0);
            acc = __builtin_amdgcn_mfma_f32_32x32x2f32(rp[96], hv.w, acc, 0, 0, 0);
        }
        LAS float* mylg = lg + F.wave * 32 * 33;
#pragma unroll
        for (int r = 0; r < 16; ++r) { const int e = (r & 3) + 8 * (r >> 2) + 4 * hf; mylg[ln * 33 + e] = acc[r] + rb[e]; }
        LDS_WAIT(); asm volatile("" ::: "memory");
        int sel[4]; float sv[4]; int pos[4];
        if (F.lane < 32) {
            float v[32];
#pragma unroll
            for (int e = 0; e < 32; ++e) v[e] = mylg[ln * 33 + e];
#pragma unroll
            for (int k = 0; k < 4; ++k) { float best = -__builtin_inff(); int bi = 0;
#pragma unroll
                for (int e = 0; e < 32; ++e) { if (v[e] > best) { best = v[e]; bi = e; } }
                sel[k] = bi; sv[k] = best;
#pragma unroll
                for (int e = 0; e < 32; ++e) if (e == bi) v[e] = -__builtin_inff(); }
            const float e1 = expf(sv[1] - sv[0]), e2 = expf(sv[2] - sv[0]), e3 = expf(sv[3] - sv[0]), inv = 1.0f / (1.0f + e1 + e2 + e3);
            sv[0] = inv; sv[1] = e1 * inv; sv[2] = e2 * inv; sv[3] = e3 * inv;
#pragma unroll
            for (int k = 0; k < 4; ++k) pos[k] = (int)atomicAdd((unsigned*)&lcnt[sel[k]], 1u);
        }
        __syncthreads();
        if (F.tid < 32) lcnt[32 + F.tid] = atomicAdd(&gcnt[F.tid], lcnt[F.tid]);
        __syncthreads();
        if (F.lane < 32) {
            const int t = tok0 + ln;
#pragma unroll
            for (int k = 0; k < 4; ++k) { const int p = pos[k] + (int)lcnt[32 + sel[k]]; TKS[t * 4 + k] = sel[k] * T + p; TKG[t * 4 + k] = sv[k]; LIST[(size_t)sel[k] * T + p] = t; }
        }
        __syncthreads();
    }
}

__device__ __forceinline__ void moe_tables(Frame& F, int l, int NT) {
    LAS int* tab = (LAS int*)(F.lds + MISC_OFF);
    if (F.wave == 0) {
        const unsigned* gcnt = (const unsigned*)(F.ws + WS_CTL) + CW_CNT + l * 64;
        const int e = F.lane & 31;
        const int c = (int)__hip_atomic_load(&gcnt[e], __ATOMIC_RELAXED, __HIP_MEMORY_SCOPE_AGENT);
        const int tm = (c + 255) >> 8;
        int incl = tm;
#pragma unroll
        for (int o = 1; o < 32; o <<= 1) { const int v = __shfl_up(incl, o, 32); if (e >= o) incl += v; }
        if (F.lane < 32) { tab[e] = (incl - tm) * NT; tab[40 + e] = (incl - tm) * 256; tab[80 + e] = c; if (e == 31) tab[32] = incl * NT; }
    }
    __syncthreads();
}

__device__ __forceinline__ void phase_combine(Frame& F, const ArgsV& A_, int l, float* outp) {
    moe_tables(F, l, 1);
    const LAS int* tab = (const LAS int*)(F.lds + MISC_OFF);
    const float* HB = (const float*)(F.ws + WS_HB); const bf16_t* Y = (const bf16_t*)(F.ws + WS_Y);
    const int* TKS = (const int*)(F.ws + WS_TKS); const float* TKG = (const float*)(F.ws + WS_TKG);
    float* HA = outp ? outp : (float*)(F.ws + WS_HA); bf16_t* XB = outp ? nullptr : (bf16_t*)(F.ws + WS_XB);
    const int gw = F.bid * NWAVES + F.wave, NGW = F.G * NWAVES;
    for (int m = gw; m < T; m += NGW) {
        f32x4 v[4];
#pragma unroll
        for (int j = 0; j < 4; ++j) v[j] = *(const f32x4*)(HB + (size_t)m * D + 4 * F.lane + 256 * j) * ALPHA;
#pragma unroll
        for (int k = 0; k < 4; ++k) { const int code = TKS[m * 4 + k]; const float g = TKG[m * 4 + k]; const int e = code >> 14, p = code & (T - 1);
            const bf16_t* yr = Y + (size_t)(tab[40 + e] + p) * 1024 + 4 * F.lane;
#pragma unroll
            for (int j = 0; j < 4; ++j) { const u32x2 wv = *(const u32x2*)(yr + 256 * j); v[j].x += g * bflo(wv.x); v[j].y += g * bfhi(wv.x); v[j].z += g * bflo(wv.y); v[j].w += g * bfhi(wv.y); } }
        ln_store(v, A_.in[29] + l * D, A_.in[30] + l * D, HA + (size_t)m * D, XB ? XB + (size_t)m * D : nullptr, F.lane);
    }
    __syncthreads();
}

constexpr int PH_PER_LAYER = 10, N_PHASES = 1 + NL * PH_PER_LAYER;

__global__ void __launch_bounds__(NTHREADS, 2) mk_fwd(Args args) {
    extern __shared__ __attribute__((aligned(16))) unsigned char lds_raw[];
    LAS unsigned char* const lds = (LAS unsigned char*)lds_raw;
    const int lo = args.ph_lo, hi = args.ph_hi;
    volatile LAS unsigned* bst = (volatile LAS unsigned*)(lds + MISC_OFF + 2048);
    if (threadIdx.x < 2) bst[threadIdx.x] = 0u;
    if (threadIdx.x == 0) {
        LAS unsigned long long* pt = (LAS unsigned long long*)(lds + PTAB_OFF);
#pragma unroll
        for (int k = 0; k < 31; ++k) pt[k] = (unsigned long long)args.in[k];
    }
    __syncthreads();
    XcdBarrier bar; bar.bar = (unsigned*)(args.ws + WS_CTL) + CW_BAR; bar.x = 0; bar.st = bst;
    if (hi - lo > 1) bar = xcd_barrier_post((unsigned*)(args.ws + WS_CTL) + CW_BAR, bst);
    const ArgsV AV{InTab{lds}};
#ifdef ONLY_SUB
    const int only_sub = ONLY_SUB;
#else
    const int only_sub = -2;
#endif
#pragma unroll 1
    for (int ph = lo; ph < hi; ++ph) {
        const int l = (ph > 0) ? (ph - 1) / PH_PER_LAYER : 0;
        int sub = (ph > 0) ? (ph - 1) % PH_PER_LAYER : -1;
        if (only_sub != -2 && sub != only_sub) continue;
        bool seam = true;
        switch (sub) {
        case -1: { Frame F = make_frame(lds, args.ws); phase_prologue(F, AV); } break;
        case 0: {
            Frame F = make_frame(lds, args.ws);
            pg8::PlainOrder S; S.init(WS_XB, WS_WINT + (size_t)l * 2560 * 1024 * 2, T, NCOLA, F.G, F.bid);
            pg8::EpiBf16 E{(bf16_t*)(F.ws + WS_U), NCOLA, nullptr, 0, 0.125f * LOG2E, 512};
            pg8::gemm_phase<pg8::EpiBf16, pg8::PlainOrder, true>(F.lds, (const char*)F.ws, F.tid, S, E);
            seam = false; } break;
        case 1: {
            Frame F = make_frame(lds, args.ws);
            pg8::PlainOrder S; S.init(WS_WINT + ((size_t)l * 2560 + 2048) * 1024 * 2, WS_XB, 512, T, F.G, F.bid);
            pg8::EpiVT E{(bf16_t*)(F.ws + WS_VT)};
            pg8::gemm_phase<pg8::EpiVT, pg8::PlainOrder, true>(F.lds, (const char*)F.ws, F.tid, S, E); } break;
        case 2: {
            { Frame F = make_frame(lds, args.ws); phase_attention(F, AV, l); }
            { Frame F = make_frame(lds, args.ws); phase_lru_local(F, AV, l); }
            { Frame F = make_frame(lds, args.ws); phase_conformer(F, AV, l); } } break;
        case 3: { Frame F = make_frame(lds, args.ws); phase_lru_fix(F, AV, l); } break;
        case 4: {
            Frame F = make_frame(lds, args.ws);
            pg8::PlainOrder S; S.init(WS_MIX, WS_WOUTT + (size_t)l * 1024 * 1024 * 2, T, D, F.G, F.bid);
            pg8::EpiF32 E{(float*)(F.ws + WS_MIXO), D};
            pg8::gemm_phase<pg8::EpiF32, pg8::PlainOrder, true>(F.lds, (const char*)F.ws, F.tid, S, E); } break;
        case 5: { Frame F = make_frame(lds, args.ws); phase_ln1(F, AV, l); } break;
        case 6: { Frame F = make_frame(lds, args.ws); phase_router(F, AV, l); } break;
        case 7: {
            Frame F = make_frame(lds, args.ws);
            moe_tables(F, l, 8);
            pg8::MoeOrder S{(unsigned)WS_XB, (unsigned)(WS_W1T + (size_t)l * NE * 2048 * 1024 * 2), 2048u * 1024u * 2u, 8, 1, (const int*)(F.ws + WS_LIST), (const LAS int*)(F.lds + MISC_OFF), F.G, F.bid};
            pg8::EpiAct E{(bf16_t*)(F.ws + WS_ACT), AV.in[26] + (size_t)l * NE * 2048};
            pg8::gemm_phase<pg8::EpiAct, pg8::MoeOrder, true>(F.lds, (const char*)F.ws, F.tid, S, E); } break;
        case 8: {
            Frame F = make_frame(lds, args.ws);
            moe_tables(F, l, 4);
            pg8::MoeOrder S{(unsigned)WS_ACT, (unsigned)(WS_W2T + (size_t)l * NE * 1024 * 1024 * 2), 1024u * 1024u * 2u, 4, 0, nullptr, (const LAS int*)(F.lds + MISC_OFF), F.G, F.bid};
            pg8::EpiBf16 E{(bf16_t*)(F.ws + WS_Y), 1024, AV.in[28] + (size_t)l * NE * 1024, 1024, 1.0f, 0};
            pg8::gemm_phase<pg8::EpiBf16, pg8::MoeOrder, true>(F.lds, (const char*)F.ws, F.tid, S, E); } break;
        default: { Frame F = make_frame(lds, args.ws); phase_combine(F, AV, l, (l == NL - 1) ? args.out : nullptr); } break;
        }
        if (seam && ph + 1 < hi) xcd_barrier(bar);
    }
}

extern "C" void kernel_launch(void* const* d_in, const int* in_sizes, int n_in, void* d_out, int out_size, void* d_ws, size_t ws_size, hipStream_t stream) {
    static int grid = 0;
    if (grid == 0) {
        if (n_in != 31 || out_size != T * D || ws_size < WS_END) { fprintf(stderr, "kernel_launch: unexpected sizes n_in %d out %d ws %zu (need %zu)\n", n_in, out_size, ws_size, (size_t)WS_END); grid = -1; return; }
        int dev = 0, cus = 0, per_cu = 0;
        if (hipGetDevice(&dev) != hipSuccess || hipDeviceGetAttribute(&cus, hipDeviceAttributeMultiprocessorCount, dev) != hipSuccess) { grid = -1; return; }
        if (hipFuncSetAttribute((const void*)mk_fwd, hipFuncAttributeMaxDynamicSharedMemorySize, LDS_BYTES) != hipSuccess) { fprintf(stderr, "kernel_launch: hipFuncSetAttribute failed\n"); grid = -1; return; }
        if (hipOccupancyMaxActiveBlocksPerMultiprocessor(&per_cu, (const void*)mk_fwd, NTHREADS, LDS_BYTES) != hipSuccess || per_cu < 1) { fprintf(stderr, "kernel_launch: occupancy query says %d blocks per CU\n", per_cu); (void)hipGetLastError(); grid = -1; return; }
        grid = cus;
    }
    if (grid < 0) return;
    (void)hipMemsetAsync((char*)d_ws + WS_CTL, 0, CTL_ZERO_BYTES, stream);
    Args a{};
    for (int i = 0; i < 31; ++i) a.in[i] = (const float*)d_in[i];
    a.out = (float*)d_out; a.ws = (unsigned char*)d_ws;
#if MK_ONE_LAUNCH
    a.ph_lo = 0; a.ph_hi = N_PHASES;
    hipLaunchKernelGGL(mk_fwd, dim3(grid), dim3(NTHREADS), LDS_BYTES, stream, a);
#else
    for (int p = 0; p < N_PHASES; ++p) { a.ph_lo = p; a.ph_hi = p + 1; hipLaunchKernelGGL(mk_fwd, dim3(grid), dim3(NTHREADS), LDS_BYTES, stream, a); }
#endif
}
```

```cpp
#include <hip/hip_runtime.h>
#include <cstdio>
#include <cstdint>

#ifndef PROBE_DUP
#define PROBE_DUP 0
#endif
#ifndef MK_ONE_LAUNCH
#define MK_ONE_LAUNCH 1
#endif

#define LAS __attribute__((address_space(3)))
#define GAS __attribute__((address_space(1)))
typedef unsigned short bf16_t;
typedef short bf16x8 __attribute__((ext_vector_type(8)));
typedef float f32x2 __attribute__((ext_vector_type(2)));
typedef float f32x4 __attribute__((ext_vector_type(4)));
typedef float f32x16 __attribute__((ext_vector_type(16)));
typedef unsigned u32x4 __attribute__((ext_vector_type(4)));
typedef unsigned u32x2 __attribute__((ext_vector_type(2)));

constexpr int T = 16384, D = 1024, NL = 2, NE = 32, KD = 1024;
constexpr int NCOLA = 2048;
constexpr int UQ = 0, UK = 512, ULX = 1024, ULY = 1280, UCA = 1536, UCB = 1792;
constexpr float LN_EPS = 1e-5f;
constexpr float ALPHA = 1.41421356237309515f;
constexpr float LOG2E = 1.44269504088896341f;
constexpr int NWAVES = 8, NTHREADS = 512;
constexpr int ACT_ROWS = 65536 + 32 * 256 + 256;

constexpr size_t MiB = 1u << 20;
constexpr size_t WS_CTL = 0, CTL_ZERO_BYTES = 1 * MiB;
constexpr size_t WS_WINT = 2 * MiB;
constexpr size_t WS_WOUTT = 12 * MiB;
constexpr size_t WS_W1T = 16 * MiB;
constexpr size_t WS_W2T = 272 * MiB;
constexpr size_t WS_HA = 400 * MiB;
constexpr size_t WS_HB = 464 * MiB;
constexpr size_t WS_XB = 528 * MiB;
constexpr size_t WS_U = 560 * MiB;
constexpr size_t WS_VT = 624 * MiB;
constexpr size_t WS_MIX = 640 * MiB;
constexpr size_t WS_MIXO = 672 * MiB;
constexpr size_t WS_HLOC = 736 * MiB;
constexpr size_t WS_CUMA = 752 * MiB;
constexpr size_t WS_AGG = 768 * MiB;
constexpr size_t WS_TKS = 769 * MiB;
constexpr size_t WS_TKG = 769 * MiB + 512 * 1024;
constexpr size_t WS_LIST = 770 * MiB;
constexpr size_t WS_ACT = 772 * MiB;
constexpr size_t WS_Y = 920 * MiB;
constexpr size_t WS_END = 1068 * MiB;
static_assert(WS_ACT + (size_t)ACT_ROWS * 2048 <= WS_Y && WS_Y + (size_t)ACT_ROWS * 2048 <= WS_END, "ws map");
constexpr int CW_BAR = 4096;
constexpr int CW_CNT = 16384;

constexpr int RING_BYTES = 135168;
constexpr int MISC_OFF = RING_BYTES;
constexpr int LDS_BYTES = 147456;
constexpr int VA_PARK_OFF = MISC_OFF + 4096;

__device__ __forceinline__ unsigned f2bf(float f) { unsigned u = __builtin_bit_cast(unsigned, f); return (u + 0x7fffu + ((u >> 16) & 1u)) >> 16; }
__device__ __forceinline__ unsigned pk2(float lo, float hi) { return f2bf(lo) | (f2bf(hi) << 16); }
__device__ __forceinline__ float bf2f(bf16_t v) { return __builtin_bit_cast(float, (unsigned)v << 16); }
__device__ __forceinline__ float bflo(unsigned w) { return __builtin_bit_cast(float, w << 16); }
__device__ __forceinline__ float bfhi(unsigned w) { return __builtin_bit_cast(float, w & 0xffff0000u); }
__device__ __forceinline__ unsigned cvt_pk_bf16(float lo, float hi) { unsigned r; asm volatile("v_cvt_pk_bf16_f32 %0, %1, %2" : "=v"(r) : "v"(lo), "v"(hi)); return r; }
__device__ __forceinline__ float wave_sum(float v) {
#pragma unroll
    for (int o = 1; o < 64; o <<= 1) v += __shfl_xor(v, o);
    return v;
}
__device__ __forceinline__ float ex2(float x) { return __builtin_amdgcn_exp2f(x); }
__device__ __forceinline__ float fexp(float x) { return __builtin_amdgcn_exp2f(x * LOG2E); }
__device__ __forceinline__ float frcp(float x) { return __builtin_amdgcn_rcpf(x); }
__device__ __forceinline__ float fsqrt(float x) { return __builtin_amdgcn_sqrtf(x); }
__device__ __forceinline__ float flog(float x) { return __builtin_amdgcn_logf(x) * 0.693147180559945f; }
__device__ __forceinline__ float sigmoidf_(float x) { return frcp(1.0f + fexp(-x)); }
#define LDS_WAIT() asm volatile("s_waitcnt lgkmcnt(0)" ::: "memory")
#define VM_WAIT() asm volatile("s_waitcnt vmcnt(0)" ::: "memory")

namespace pg8 {
constexpr int BM = 256, BK = 64, HALF = 128, HTB = HALF * BK * 2, STAGE_BYTES = 8 * HTB, NXCD = 8, WGM = 8;
__device__ __forceinline__ int lds_byte(int r, int c) { const int st = (r >> 4) * 2 + (c >> 5), rr = r & 15, cc = c & 31, ob = rr * 64 + cc * 2; return st * 1024 + (ob ^ (((ob >> 9) & 1) << 5)); }
__device__ __forceinline__ void stage_rc(int b, int& R, int& C) { const unsigned ub = (unsigned)b, st = ub >> 10, sb = ub & 1023u, swz = sb ^ (((sb >> 9) & 1u) << 5); R = (int)((st >> 1) * 16u + (swz >> 6)); C = (int)((st & 1u) * 32u + ((swz & 63u) >> 1)); }
__device__ __forceinline__ int perm32(int rho) { const int n = rho >> 4, i = rho & 15; return 8 * (i >> 2) + 4 * n + (i & 3); }

struct Unit { unsigned A, B; int pn, e, orow; unsigned va00, va01, va10, va11; };

struct PlainOrder {
    unsigned A, Bt; int nM, nN, nwg, G, c;
    __device__ void init(size_t A_, size_t Bt_, int M, int N, int G_, int c_) { A = (unsigned)A_; Bt = (unsigned)Bt_; nM = M / BM; nN = N / BM; nwg = nM * nN; G = G_; c = c_; }
    __device__ __forceinline__ bool next(int i, Unit& u, int tid) const {
        const long L = (long)i * G + c; if (L >= nwg) return false;
        int R0, C0, R1, C1; stage_rc(tid * 16, R0, C0); stage_rc(tid * 16 + 8192, R1, C1);
        int wgid = (int)L; { const int q = nwg / NXCD, r = nwg % NXCD, xcd = wgid % NXCD, off = wgid / NXCD; wgid = (xcd < r ? xcd * (q + 1) : r * (q + 1) + (xcd - r) * q) + off; }
        const int nig = WGM * nN, gid = wgid / nig, fm = gid * WGM, gsz = (nM - fm) < WGM ? (nM - fm) : WGM;
        const int pm = fm + ((wgid % nig) % gsz), pn = (wgid % nig) / gsz;
        u.A = A + (unsigned)pm * (BM * KD * 2); u.B = Bt + (unsigned)pn * (BM * KD * 2); u.pn = pn; u.e = 0; u.orow = pm * BM;
        u.va00 = (unsigned)(R0 * KD + C0) * 2u; u.va01 = (unsigned)(R1 * KD + C1) * 2u; u.va10 = (unsigned)((R0 + HALF) * KD + C0) * 2u; u.va11 = (unsigned)((R1 + HALF) * KD + C1) * 2u;
        return true;
    }
};

struct MoeOrder {
    unsigned Abase, Bt, bstride; int NT; int gather; const int* list; const LAS int* tab; int G, c;
    __device__ __forceinline__ bool next(int i, Unit& u, int tid) const {
        const int NU = __builtin_amdgcn_readfirstlane(tab[32]);
        int L;
        if ((G & 7) == 0) { const int g8 = G >> 3, per = (NU + 7) >> 3, idx = i * g8 + (c >> 3); if (idx >= per) return false; L = (c & 7) * per + idx; }
        else L = i * G + c;
        if (L >= NU) return false;
        int R0, C0, R1, C1; stage_rc(tid * 16, R0, C0); stage_rc(tid * 16 + 8192, R1, C1);
        const int ln_ = tid & 63;
        int e = __popcll(__ballot(ln_ >= 1 && ln_ < 32 && L >= tab[ln_ & 31]));
        e = __builtin_amdgcn_readfirstlane(e);
        const int ub = __builtin_amdgcn_readfirstlane(tab[e]), ub1 = __builtin_amdgcn_readfirstlane(tab[e + 1]);
        const int ps = __builtin_amdgcn_readfirstlane(tab[40 + e]), cnt = __builtin_amdgcn_readfirstlane(tab[80 + e]);
        const int tm = (ub1 - ub) / NT, r = L - ub, mt = r % tm, nt = r / tm;
        u.e = e; u.pn = nt; u.orow = ps + mt * BM;
        u.B = Bt + (unsigned)e * bstride + (unsigned)nt * (BM * KD * 2);
        if (gather) {
            u.A = Abase;
            const int* lp = list + (size_t)e * T + mt * BM; const int lim = cnt - mt * BM;
            const int t00 = (R0 < lim) ? lp[R0] : 0, t01 = (R1 < lim) ? lp[R1] : 0, t10 = (R0 + HALF < lim) ? lp[R0 + HALF] : 0, t11 = (R1 + HALF < lim) ? lp[R1 + HALF] : 0;
            u.va00 = (unsigned)(t00 * KD + C0) * 2u; u.va01 = (unsigned)(t01 * KD + C1) * 2u; u.va10 = (unsigned)(t10 * KD + C0) * 2u; u.va11 = (unsigned)(t11 * KD + C1) * 2u;
        } else {
            u.A = Abase + (unsigned)u.orow * (KD * 2);
            u.va00 = (unsigned)(R0 * KD + C0) * 2u; u.va01 = (unsigned)(R1 * KD + C1) * 2u; u.va10 = (unsigned)((R0 + HALF) * KD + C0) * 2u; u.va11 = (unsigned)((R1 + HALF) * KD + C1) * 2u;
        }
        return true;
    }
};

struct EpiBf16 {
    static constexpr bool PERM = true;
    bf16_t* O; int ldc; const float* bias; int bias_stride; float scale0; int scale_cols;
    __device__ __forceinline__ void operator()(const f32x4 (&acc)[2][2][4][2], const Unit& u, int wr, int wc, int fr, int fq) const {
        const int row0 = u.orow + wr * 64 + fr, colt = u.pn * BM, col0 = colt + wc * 32 + 8 * fq;
        const float sc = (colt < scale_cols) ? scale0 : 1.f;
        const float* bp = bias ? bias + (size_t)u.e * bias_stride : nullptr;
        f32x4 bv[2][2];
#pragma unroll
        for (int bj = 0; bj < 2; ++bj)
#pragma unroll
            for (int n = 0; n < 2; ++n) bv[bj][n] = bp ? *(const f32x4*)(bp + col0 + bj * HALF + 4 * n) : (f32x4){0.f, 0.f, 0.f, 0.f};
#pragma unroll
        for (int ai = 0; ai < 2; ++ai)
#pragma unroll
            for (int m = 0; m < 4; ++m) { bf16_t* rowp = O + (size_t)(row0 + ai * HALF + m * 16) * ldc + col0;
#pragma unroll
                for (int bj = 0; bj < 2; ++bj) { f32x4 v0 = (acc[ai][bj][m][0] + bv[bj][0]) * sc, v1 = (acc[ai][bj][m][1] + bv[bj][1]) * sc;
                    u32x4 w; w.x = cvt_pk_bf16(v0[0], v0[1]); w.y = cvt_pk_bf16(v0[2], v0[3]); w.z = cvt_pk_bf16(v1[0], v1[1]); w.w = cvt_pk_bf16(v1[2], v1[3]);
                    *(u32x4*)(rowp + bj * HALF) = w; } }
    }
};
struct EpiVT {
    static constexpr bool PERM = false;
    bf16_t* O;
    __device__ __forceinline__ void operator()(const f32x4 (&acc)[2][2][4][2], const Unit& u, int wr, int wc, int fr, int fq) const {
        const int sfq = (fq == 1) ? 2 : ((fq == 2) ? 1 : fq);
        const int row0 = u.orow + wr * 64 + fr, col0 = u.pn * BM + wc * 32 + 4 * sfq;
#pragma unroll
        for (int ai = 0; ai < 2; ++ai)
#pragma unroll
            for (int m = 0; m < 4; ++m) { bf16_t* rowp = O + (size_t)(row0 + ai * HALF + m * 16) * T + col0;
#pragma unroll
                for (int bj = 0; bj < 2; ++bj)
#pragma unroll
                    for (int n = 0; n < 2; ++n) { const f32x4 v = acc[ai][bj][m][n]; u32x2 w; w.x = cvt_pk_bf16(v[0], v[1]); w.y = cvt_pk_bf16(v[2], v[3]); *(u32x2*)(rowp + bj * HALF + n * 16) = w; } }
    }
};
struct EpiF32 {
    static constexpr bool PERM = false;
    float* O; int ldc;
    __device__ __forceinline__ void operator()(const f32x4 (&acc)[2][2][4][2], const Unit& u, int wr, int wc, int fr, int fq) const {
        const int row0 = u.orow + wr * 64 + fr, col0 = u.pn * BM + wc * 32 + 4 * fq;
#pragma unroll
        for (int ai = 0; ai < 2; ++ai)
#pragma unroll
            for (int m = 0; m < 4; ++m) { float* rowp = O + (size_t)(row0 + ai * HALF + m * 16) * ldc + col0;
#pragma unroll
                for (int bj = 0; bj < 2; ++bj)
#pragma unroll
                    for (int n = 0; n < 2; ++n) *(f32x4*)(rowp + bj * HALF + n * 16) = acc[ai][bj][m][n]; }
    }
};
struct EpiAct {
    static constexpr bool PERM = true;
    bf16_t* O; const float* b1;
    __device__ __forceinline__ void operator()(const f32x4 (&acc)[2][2][4][2], const Unit& u, int wr, int wc, int fr, int fq) const {
        const int row0 = u.orow + wr * 64 + fr, j0 = u.pn * HALF + wc * 32 + 8 * fq;
        const float* bp = b1 + (size_t)u.e * 2048;
        f32x4 bg[2], bl[2];
#pragma unroll
        for (int n = 0; n < 2; ++n) { bg[n] = *(const f32x4*)(bp + j0 + 4 * n); bl[n] = *(const f32x4*)(bp + 1024 + j0 + 4 * n); }
#pragma unroll
        for (int ai = 0; ai < 2; ++ai)
#pragma unroll
            for (int m = 0; m < 4; ++m) { bf16_t* rowp = O + (size_t)(row0 + ai * HALF + m * 16) * 1024 + j0;
                float o[8];
#pragma unroll
                for (int n = 0; n < 2; ++n)
#pragma unroll
                    for (int q = 0; q < 4; ++q) { float g = acc[ai][0][m][n][q] + bg[n][q], l = acc[ai][1][m][n][q] + bl[n][q];
                        g = fminf(g, 7.0f); l = fminf(fmaxf(l, -7.0f), 7.0f);
                        o[n * 4 + q] = g * (1.0f / (1.0f + __builtin_amdgcn_exp2f(-1.702f * LOG2E * g))) * (l + 1.0f); }
                u32x4 w; w.x = cvt_pk_bf16(o[0], o[1]); w.y = cvt_pk_bf16(o[2], o[3]); w.z = cvt_pk_bf16(o[4], o[5]); w.w = cvt_pk_bf16(o[6], o[7]);
                *(u32x4*)rowp = w; }
    }
};

template <class Epi, class Sched, bool ALIGN_EPI>
__device__ __forceinline__ void gemm_phase(LAS unsigned char* lds, const char* wsb, const int tid0, const Sched& S, const Epi& E) {
    Unit cur, nxt; int ui = 0;
    if (!S.next(0, cur, tid0)) return;
    int tid = tid0; asm volatile("" : "+v"(tid));
    const int wid = __builtin_amdgcn_readfirstlane(tid >> 6), lane = tid & 63, wr = wid >> 2, wc = wid & 3, fr = lane & 15, fq = lane >> 4;
    constexpr int K = KD, nt = K / BK;
    unsigned voffB[2];
    { int R0, C0, R1, C1; stage_rc(tid * 16, R0, C0); stage_rc(tid * 16 + 8192, R1, C1);
      const int Rb0 = Epi::PERM ? ((R0 & ~31) + perm32(R0 & 31)) : R0, Rb1 = Epi::PERM ? ((R1 & ~31) + perm32(R1 & 31)) : R1;
      voffB[0] = (unsigned)(Rb0 * K + C0) * 2u; voffB[1] = (unsigned)(Rb1 * K + C1) * 2u; }
    constexpr unsigned kstep = (unsigned)(BK * 2);
    constexpr unsigned hstep = (unsigned)HALF * K * 2;
    const unsigned ldsw = (unsigned)wid * 1024u;
    const int aoff = lds_byte(wr * 64 + fr, fq * 8), boff = lds_byte(wc * 32 + fr, fq * 8);
#define PG8_SA(b, h) (((b) * 2 + (h)) * HTB)
#define PG8_SB(b, h) ((4 + (b) * 2 + (h)) * HTB)
#define PG8_GLDS(gp, lp) __builtin_amdgcn_global_load_lds((const unsigned*)(gp), (LAS unsigned*)(lp), 16, 0, 0)
#define PG8_STB(bufoff, gbase) do { PG8_GLDS(wsb + (size_t)((gbase) + voffB[0]), lds + (bufoff) + ldsw); PG8_GLDS(wsb + (size_t)((gbase) + voffB[1]), lds + (bufoff) + ldsw + 8192); } while (0)
#define PG8_STA(bufoff, gbase, v0, v1) do { PG8_GLDS(wsb + (size_t)((gbase) + (v0)), lds + (bufoff) + ldsw); PG8_GLDS(wsb + (size_t)((gbase) + (v1)), lds + (bufoff) + ldsw + 8192); } while (0)
#define PG8_LDA(dst, b, h) do { _Pragma("unroll") for (int m = 0; m < 4; ++m) _Pragma("unroll") for (int k = 0; k < 2; ++k) dst[m][k] = *(const LAS bf16x8*)(lds + PG8_SA(b, h) + aoff + m * 2048 + k * 1024); } while (0)
#define PG8_LDB(dst, b, h) do { _Pragma("unroll") for (int n = 0; n < 2; ++n) _Pragma("unroll") for (int k = 0; k < 2; ++k) dst[n][k] = *(const LAS bf16x8*)(lds + PG8_SB(b, h) + boff + n * 2048 + k * 1024); } while (0)
#define PG8_MMA(ai, bj, At, Bt) do { __builtin_amdgcn_s_setprio(1); _Pragma("unroll") for (int m = 0; m < 4; ++m) _Pragma("unroll") for (int n = 0; n < 2; ++n) _Pragma("unroll") for (int k = 0; k < 2; ++k) \
        acc[ai][bj][m][n] = __builtin_amdgcn_mfma_f32_16x16x32_bf16(Bt[n][k], At[m][k], acc[ai][bj][m][n], 0, 0, 0); __builtin_amdgcn_s_setprio(0); } while (0)
#define PG8_WAIT_V(n) asm volatile("s_waitcnt vmcnt(" #n ")" ::: "memory")
#define PG8_WAIT_L(n) asm volatile("s_waitcnt lgkmcnt(" #n ")" ::: "memory")
#define PG8_BAR __builtin_amdgcn_s_barrier()
#define PG8_SCHED __builtin_amdgcn_sched_barrier(0)
    f32x4 acc[2][2][4][2];
#pragma unroll
    for (int a = 0; a < 2; ++a)
#pragma unroll
        for (int b = 0; b < 2; ++b)
#pragma unroll
            for (int m = 0; m < 4; ++m)
#pragma unroll
                for (int n = 0; n < 2; ++n) acc[a][b][m][n] = (f32x4){0.f, 0.f, 0.f, 0.f};
    bf16x8 At[4][2], B0[2][2], B1[2][2];
    unsigned cA = cur.A, cB = cur.B;
    unsigned c00 = cur.va00, c01 = cur.va01, c10 = cur.va10, c11 = cur.va11;
    PG8_STB(PG8_SB(0, 0), cB); PG8_STB(PG8_SB(0, 1), cB + hstep); PG8_STA(PG8_SA(0, 0), cA, c00, c01); PG8_STA(PG8_SA(0, 1), cA, c10, c11);
    if (wr == 1) PG8_BAR;
    PG8_WAIT_V(2); PG8_BAR;
    PG8_STB(PG8_SB(1, 0), cB + kstep); PG8_STA(PG8_SA(1, 0), cA + kstep, c00, c01); PG8_STB(PG8_SB(1, 1), cB + hstep + kstep);
    PG8_WAIT_V(6); PG8_BAR;
    for (;;) {
        const bool has_next = S.next(ui + 1, nxt, tid);
        const unsigned nA = has_next ? nxt.A : cA, nB = has_next ? nxt.B : cB;
        { u32x4 pv; pv.x = has_next ? nxt.va00 : c00; pv.y = has_next ? nxt.va01 : c01; pv.z = has_next ? nxt.va10 : c10; pv.w = has_next ? nxt.va11 : c11; *(LAS u32x4*)(lds + VA_PARK_OFF + tid * 16) = pv; }
        for (int t = 0; t < nt; t += 2) {
            const bool last = (t == nt - 2);
            const unsigned a1 = cA + (unsigned)(t + 1) * kstep;
            const unsigned a2 = last ? nA : cA + (unsigned)(t + 2) * kstep, b2 = last ? nB : cB + (unsigned)(t + 2) * kstep;
            const unsigned a3 = a2 + kstep, b3 = b2 + kstep;
            unsigned s00 = c00, s01 = c01, s10 = c10, s11 = c11;
            if (last) { const u32x4 pv = *(const LAS u32x4*)(lds + VA_PARK_OFF + tid * 16); s00 = pv.x; s01 = pv.y; s10 = pv.z; s11 = pv.w; }
            PG8_LDB(B0, 0, 0); PG8_LDB(B1, 0, 1); PG8_SCHED; PG8_LDA(At, 0, 0); PG8_STA(PG8_SA(1, 1), a1, c10, c11);
            PG8_WAIT_V(8); PG8_WAIT_L(0); PG8_BAR; PG8_MMA(0, 0, At, B0); PG8_MMA(0, 1, At, B1); PG8_BAR; PG8_SCHED;
            PG8_LDA(At, 0, 1); PG8_STB(PG8_SB(0, 0), b2); PG8_STB(PG8_SB(0, 1), b2 + hstep); PG8_STA(PG8_SA(0, 0), a2, s00, s01);
            PG8_WAIT_V(8); PG8_WAIT_L(0); PG8_BAR; PG8_MMA(1, 0, At, B0); PG8_MMA(1, 1, At, B1); PG8_BAR; PG8_SCHED;
            PG8_LDB(B0, 1, 0); PG8_LDB(B1, 1, 1); PG8_SCHED; PG8_LDA(At, 1, 0); PG8_STA(PG8_SA(0, 1), a2, s10, s11);
            PG8_WAIT_V(8); PG8_WAIT_L(0); PG8_BAR; PG8_MMA(0, 0, At, B0); PG8_MMA(0, 1, At, B1); PG8_BAR; PG8_SCHED;
            PG8_LDA(At, 1, 1); PG8_STB(PG8_SB(1, 0), b3); PG8_STB(PG8_SB(1, 1), b3 + hstep); PG8_STA(PG8_SA(1, 0), a3, s00, s01);
            PG8_WAIT_V(8); PG8_WAIT_L(0); PG8_BAR; PG8_MMA(1, 0, At, B0); PG8_MMA(1, 1, At, B1); PG8_BAR; PG8_SCHED;
        }
        if constexpr (ALIGN_EPI) { if (wr == 0) PG8_BAR; }
        E(acc, cur, wr, wc, fr, fq);
        if (!has_next) break;
#pragma unroll
        for (int a = 0; a < 2; ++a)
#pragma unroll
            for (int b = 0; b < 2; ++b)
#pragma unroll
                for (int m = 0; m < 4; ++m)
#pragma unroll
                    for (int n = 0; n < 2; ++n) acc[a][b][m][n] = (f32x4){0.f, 0.f, 0.f, 0.f};
        cur = nxt; cA = nA; cB = nB; { const u32x4 pv = *(const LAS u32x4*)(lds + VA_PARK_OFF + tid * 16); c00 = pv.x; c01 = pv.y; c10 = pv.z; c11 = pv.w; } ++ui;
        if constexpr (ALIGN_EPI) { if (wr == 1) PG8_BAR; }
    }
    PG8_WAIT_V(0);
    if constexpr (!ALIGN_EPI) { if (wr == 0) PG8_BAR; }
    PG8_BAR;
#undef PG8_SA
#undef PG8_SB
#undef PG8_GLDS
#undef PG8_STB
#undef PG8_STA
#undef PG8_LDA
#undef PG8_LDB
#undef PG8_MMA
#undef PG8_WAIT_V
#undef PG8_WAIT_L
#undef PG8_BAR
#undef PG8_SCHED
}
}

#define XB_TMO      128
#define XB_XCNT(j)  (256  + 64 * (j))
#define XB_XSUB(j)  (1280 + 64 * (j))
#define XB_XGEN(j)  (2304 + 64 * (j))
#define XB_TOP      3328
#define XB_TOPGEN   3392
#define XCD_BAR_WORDS 3456
#define XB_SPIN_CAP (1u << 22)
__device__ __forceinline__ unsigned xb_ld(unsigned* p)              { return __hip_atomic_load(p, __ATOMIC_RELAXED, __HIP_MEMORY_SCOPE_AGENT); }
__device__ __forceinline__ unsigned xb_add(unsigned* p, unsigned v) { return __hip_atomic_fetch_add(p, v, __ATOMIC_RELAXED, __HIP_MEMORY_SCOPE_AGENT); }
__device__ __forceinline__ unsigned xb_xcc_id() { return (unsigned)__builtin_amdgcn_s_getreg((3 << 11) | 20) & 0xFu; }
#define XB_SPIN(cond, bar) do { unsigned _sp = 0; while (cond) { __builtin_amdgcn_s_sleep(1); \
    if ((++_sp & 255u) == 0u) { if (xb_ld(&(bar)[XB_TMO])) break; if (_sp > XB_SPIN_CAP) { atomicAdd(&(bar)[XB_TMO], 1u); break; } } } } while (0)
struct XcdBarrier { unsigned* bar; unsigned x; volatile LAS unsigned* st; };
__device__ __forceinline__ XcdBarrier xcd_barrier_post(unsigned* bar, volatile LAS unsigned* st) {
    XcdBarrier b; b.bar = bar; b.x = xb_xcc_id(); b.st = st;
    if (threadIdx.x == 0) (void)xb_add(&bar[XB_XCNT(b.x)], 1u);
    return b;
}
__device__ __forceinline__ void xcd_barrier_complete(unsigned* bar, unsigned x, unsigned& nloc, unsigned& nx) {
    const unsigned G = gridDim.x * gridDim.y * gridDim.z;
    unsigned sum, cnt, mine, sp = 0u;
    for (;;) {
        sum = 0u; cnt = 0u; mine = 0u;
#pragma unroll 1
        for (unsigned j = 0; j < 16; ++j) { const unsigned c = xb_ld(&bar[XB_XCNT(j)]); sum += c; cnt += (c > 0u) ? 1u : 0u; mine = (j == x) ? c : mine; }
        if (sum == G) break;
        __builtin_amdgcn_s_sleep(1);
        if ((++sp & 255u) == 0u) { if (xb_ld(&bar[XB_TMO])) break; if (sp > XB_SPIN_CAP) { atomicAdd(&bar[XB_TMO], 1u); break; } }
    }
    nloc = mine > 0u ? mine : 1u; nx = cnt > 0u ? cnt : 1u;
}
__device__ __forceinline__ void xcd_barrier(const XcdBarrier& b) {
    asm volatile("s_waitcnt vmcnt(0)" ::: "memory");
    __syncthreads();
    if (threadIdx.x == 0) {
        unsigned* bar = b.bar;
        __builtin_amdgcn_s_waitcnt(0);
        unsigned nloc = b.st[0], nx = b.st[1];
        if (nloc == 0u) { xcd_barrier_complete(bar, b.x, nloc, nx); b.st[0] = nloc; b.st[1] = nx; }
        const unsigned old = xb_add(&bar[XB_XSUB(b.x)], 1u);
        const unsigned gen = old / nloc;
        if (old + 1u == (gen + 1u) * nloc) {
            __builtin_amdgcn_fence(__ATOMIC_RELEASE, "agent");
            asm volatile("s_waitcnt vmcnt(0)" ::: "memory");
            const unsigned og = xb_add(&bar[XB_TOP], 1u);
            const unsigned tg = og / nx;
            if (og + 1u == (tg + 1u) * nx) xb_add(&bar[XB_TOPGEN], 1u);
            else XB_SPIN(xb_ld(&bar[XB_TOPGEN]) == tg, bar);
            __builtin_amdgcn_fence(__ATOMIC_ACQUIRE, "agent");
            xb_add(&bar[XB_XGEN(b.x)], 1u);
            asm volatile("s_waitcnt vmcnt(0)" ::: "memory");
        } else {
            XB_SPIN(xb_ld(&bar[XB_XGEN(b.x)]) == gen, bar);
            __builtin_amdgcn_fence(__ATOMIC_ACQUIRE, "agent");
            asm volatile("s_waitcnt vmcnt(0)" ::: "memory");
        }
    }
    __syncthreads();
}

struct Args { const float* in[31]; float* out; unsigned char* ws; int ph_lo, ph_hi; };

struct Frame {
    LAS unsigned char* lds;
    int tid, lane, wave, G, bid;
    unsigned char* ws;
};
constexpr int PTAB_OFF = MISC_OFF + 3072;
struct InTab { LAS unsigned char* lds;
    __device__ __forceinline__ const float* operator[](int k) const {
        const LAS unsigned* p = (const LAS unsigned*)(lds + PTAB_OFF) + 2 * k;
        const unsigned lo = __builtin_amdgcn_readfirstlane(p[0]), hi = __builtin_amdgcn_readfirstlane(p[1]);
        return (const float*)(((unsigned long long)hi << 32) | lo); } };
struct ArgsV { InTab in; };
__device__ __forceinline__ Frame make_frame(LAS unsigned char* lds, unsigned char* ws) {
    Frame F; F.lds = lds;
    int tid = threadIdx.x; asm volatile("" : "+v"(tid));
    F.tid = tid; F.lane = tid & 63; F.wave = __builtin_amdgcn_readfirstlane(tid >> 6);
    F.G = gridDim.x; F.bid = blockIdx.x;
    unsigned long long w = (unsigned long long)ws; asm volatile("" : "+s"(w)); F.ws = (unsigned char*)w;
    return F;
}

__device__ __forceinline__ void transpose_item(const float* W, int N, bf16_t* WT, int k0, int n0, int drow0, LAS float* scr, int lane) {
    f32x4 v[16];
    const int lr = lane >> 4, lc = (lane & 15) * 4;
#pragma unroll
    for (int i = 0; i < 16; ++i) v[i] = __builtin_nontemporal_load((const f32x4*)(W + (size_t)(k0 + 4 * i + lr) * N + n0 + lc));
#pragma unroll
    for (int i = 0; i < 16; ++i) { LAS float* s = scr + (4 * i + lr) * 65 + lc; s[0] = v[i].x; s[1] = v[i].y; s[2] = v[i].z; s[3] = v[i].w; }
    LDS_WAIT(); asm volatile("" ::: "memory");
    const int c = lane & 7;
#pragma unroll
    for (int j = 0; j < 8; ++j) { const int n = (lane >> 3) + 8 * j; const LAS float* s = scr + (8 * c) * 65 + n;
        u32x4 o; o.x = pk2(s[0 * 65], s[1 * 65]); o.y = pk2(s[2 * 65], s[3 * 65]); o.z = pk2(s[4 * 65], s[5 * 65]); o.w = pk2(s[6 * 65], s[7 * 65]);
        *(u32x4*)(WT + (size_t)(drow0 + n) * KD + k0 + 8 * c) = o; }
    LDS_WAIT(); asm volatile("" ::: "memory");
}
__device__ __forceinline__ void ln_store(f32x4 (&v)[4], const float* g, const float* b, float* of32, bf16_t* obf, int lane) {
    float s = 0.f;
#pragma unroll
    for (int j = 0; j < 4; ++j) s += (v[j].x + v[j].y) + (v[j].z + v[j].w);
    const float mean = wave_sum(s) * (1.f / D); float s2 = 0.f;
#pragma unroll
    for (int j = 0; j < 4; ++j) { v[j] = v[j] - mean; s2 += (v[j].x * v[j].x + v[j].y * v[j].y) + (v[j].z * v[j].z + v[j].w * v[j].w); }
    const float rstd = __builtin_amdgcn_rsqf(wave_sum(s2) * (1.f / D) + LN_EPS);
#pragma unroll
    for (int j = 0; j < 4; ++j) {
        const f32x4 gv = *(const f32x4*)(g + 4 * lane + 256 * j), bv = *(const f32x4*)(b + 4 * lane + 256 * j);
        const f32x4 o = v[j] * rstd * gv + bv;
        if (of32) *(f32x4*)(of32 + 4 * lane + 256 * j) = o;
        if (obf) { u32x2 w; w.x = pk2(o.x, o.y); w.y = pk2(o.z, o.w); *(u32x2*)(obf + 4 * lane + 256 * j) = w; }
    }
}

__device__ __forceinline__ void phase_prologue(Frame& F, const ArgsV& A_) {
    LAS float* scr = (LAS float*)(F.lds + F.wave * 16640);
    const int gw = F.bid * NWAVES + F.wave, NGW = F.G * NWAVES;
    bf16_t* WINT = (bf16_t*)(F.ws + WS_WINT); bf16_t* WOUTT = (bf16_t*)(F.ws + WS_WOUTT); bf16_t* W1T = (bf16_t*)(F.ws + WS_W1T); bf16_t* W2T = (bf16_t*)(F.ws + WS_W2T);
    constexpr int I_IN = NL * 16 * 40, I_OUT = NL * 16 * 16, I_W1 = NL * NE * 16 * 32, I_W2 = NL * NE * 16 * 16;
    const float* w_in = A_.in[3]; const float* w_out = A_.in[20]; const float* w1 = A_.in[25]; const float* w2 = A_.in[27];
    for (int it = gw; it < I_IN + I_OUT + I_W1 + I_W2; it += NGW) {
        int r = it;
        if (r < I_W1) { const int le = r / (16 * 32), q = r % (16 * 32), kb = q / 32, nb = q % 32, n0 = nb * 64;
            const int drow = (n0 < 1024) ? ((n0 >> 7) * 256 + (n0 & 127)) : (((n0 - 1024) >> 7) * 256 + 128 + ((n0 - 1024) & 127));
            transpose_item(w1 + (size_t)le * 1024 * 2048, 2048, W1T + (size_t)le * 2048 * 1024, kb * 64, n0, drow, scr, F.lane); continue; }
        r -= I_W1;
        if (r < I_W2) { const int le = r / (16 * 16), q = r % (16 * 16), kb = q / 16, nb = q % 16;
            transpose_item(w2 + (size_t)le * 1024 * 1024, 1024, W2T + (size_t)le * 1024 * 1024, kb * 64, nb * 64, nb * 64, scr, F.lane); continue; }
        r -= I_W2;
        if (r < I_IN) { const int l = r / (16 * 40), q = r % (16 * 40), kb = q / 40, nb = q % 40, n0 = nb * 64;
            const int drow = (n0 < 1024) ? n0 : ((n0 < 1536) ? (2048 + n0 - 1024) : (n0 - 512));
            transpose_item(w_in + (size_t)l * 1024 * 2560, 2560, WINT + (size_t)l * 2560 * 1024, kb * 64, n0, drow, scr, F.lane); continue; }
        r -= I_IN;
        { const int l = r / (16 * 16), q = r % (16 * 16), kb = q / 16, nb = q % 16;
            transpose_item(w_out + (size_t)l * 1024 * 1024, 1024, WOUTT + (size_t)l * 1024 * 1024, kb * 64, nb * 64, nb * 64, scr, F.lane); }
    }
    float* HA = (float*)(F.ws + WS_HA); bf16_t* XB = (bf16_t*)(F.ws + WS_XB);
    for (int m = gw; m < T; m += NGW) {
        f32x4 v[4];
#pragma unroll
        for (int j = 0; j < 4; ++j) v[j] = *(const f32x4*)(A_.in[0] + (size_t)m * D + 4 * F.lane + 256 * j);
        ln_store(v, A_.in[1], A_.in[2], HA + (size_t)m * D, XB + (size_t)m * D, F.lane);
    }
}

namespace attn {
__device__ __forceinline__ int crow(int r, int hi) { return (r & 3) + 8 * (r >> 2) + 4 * hi; }
__device__ __forceinline__ int swz(int row, int chunk) { return row * 128 + ((chunk ^ ((row >> 1) & 7)) << 4); }
#define MFMA32(a, b, c) __builtin_amdgcn_mfma_f32_32x32x16_bf16(a, b, c, 0, 0, 0)

__device__ __forceinline__ void attn_unit(LAS unsigned char* lds, const bf16_t* U, const bf16_t* VT, bf16_t* MIX, const float* subg, float lam, float outscale, int h, int qb, const int tid) {
    const int w = __builtin_amdgcn_readfirstlane(tid >> 6), lane = tid & 63, ln = lane & 31, hi = lane >> 5;
    const int c = w >> 2, rg = w & 3;
    const int i0 = qb * 128, rowmin = i0 + 32 * rg;
    const float slope2 = __builtin_amdgcn_exp2f(-2.0f * (float)(h + 1)) * LOG2E;
    bf16x8 Qf[4];
    { const bf16_t* qp = U + (size_t)(rowmin + ln) * NCOLA + UQ + h * 128 + c * 64 + 8 * hi;
#pragma unroll
      for (int ks = 0; ks < 4; ++ks) Qf[ks] = *(const bf16x8*)(qp + 16 * ks); }
    const int kkey = tid >> 4, kcc = tid & 15, vdv = tid >> 3, vch = tid & 7;
    const bf16_t* kg = U + (size_t)kkey * NCOLA + UK + h * 128 + kcc * 8;
    const bf16_t* vg = VT + (size_t)(h * 128 + vdv) * T + vch * 8;
    const int klds0 = (kcc >> 3) * 8192 + swz(kkey, kcc & 7), klds1 = (kcc >> 3) * 8192 + swz(kkey + 32, kcc & 7);
    const int vlds0 = 16384 + swz(vdv, vch), vlds1 = 16384 + swz(vdv + 64, vch);
    f32x16 O[4];
#pragma unroll
    for (int db = 0; db < 4; ++db)
#pragma unroll
        for (int r = 0; r < 16; ++r) O[db][r] = 0.f;
    float m = -__builtin_inff(), lsum = 0.f;
    const int jt_hi = 2 * qb + 1;
    u32x4 pk0, pk1, pv0, pv1;
    { const size_t j0 = (size_t)jt_hi * 64;
      pk0 = *(const u32x4*)(kg + j0 * NCOLA); pk1 = *(const u32x4*)(kg + (j0 + 32) * NCOLA); pv0 = *(const u32x4*)(vg + j0); pv1 = *(const u32x4*)(vg + j0 + (size_t)64 * T);
      *(LAS u32x4*)(lds + klds0) = pk0; *(LAS u32x4*)(lds + klds1) = pk1; *(LAS u32x4*)(lds + vlds0) = pv0; *(LAS u32x4*)(lds + vlds1) = pv1; }
    __syncthreads();
    for (int jt = jt_hi; jt >= 0; --jt) {
        const int cur = (jt_hi - jt) & 1;
        LAS unsigned char* buf = lds + cur * 32768;
        LAS unsigned char* nbuf = lds + (cur ^ 1) * 32768;
        if (jt > 0) { const size_t j0 = (size_t)(jt - 1) * 64;
            pk0 = *(const u32x4*)(kg + j0 * NCOLA); pk1 = *(const u32x4*)(kg + (j0 + 32) * NCOLA); pv0 = *(const u32x4*)(vg + j0); pv1 = *(const u32x4*)(vg + j0 + (size_t)64 * T); }
        const int j0 = jt * 64;
        if (j0 <= rowmin + 31) {
            f32x16 s0, s1;
            { const float b0 = slope2 * (float)(j0 + 4 * hi - i0);
#pragma unroll
              for (int r = 0; r < 16; ++r) { s0[r] = b0 + slope2 * (float)((r & 3) + 8 * (r >> 2)); s1[r] = s0[r] + slope2 * 32.0f; } }
#pragma unroll
            for (int ks = 0; ks < 4; ++ks) {
                const bf16x8 k0 = *(const LAS bf16x8*)(buf + c * 8192 + swz(ln, 2 * ks + hi));
                const bf16x8 k1 = *(const LAS bf16x8*)(buf + c * 8192 + swz(ln + 32, 2 * ks + hi));
                s0 = MFMA32(k0, Qf[ks], s0); s1 = MFMA32(k1, Qf[ks], s1);
            }
            if (j0 + 63 > rowmin) {
                const int qrow = rowmin + ln;
#pragma unroll
                for (int r = 0; r < 16; ++r) { const int key = j0 + crow(r, hi); if (key > qrow) s0[r] = -__builtin_inff(); if (key + 32 > qrow) s1[r] = -__builtin_inff(); }
            }
            float mx = fmaxf(s0[0], s1[0]);
#pragma unroll
            for (int r = 1; r < 16; ++r) mx = fmaxf(mx, fmaxf(s0[r], s1[r]));
            mx = fmaxf(mx, __shfl_xor(mx, 32));
            if (__any(mx > m)) {
                const float mn = fmaxf(m, mx), al = __builtin_amdgcn_exp2f(m - mn);
#pragma unroll
                for (int db = 0; db < 4; ++db)
#pragma unroll
                    for (int r = 0; r < 16; ++r) O[db][r] *= al;
                lsum *= al; m = mn;
            }
#pragma unroll
            for (int r = 0; r < 16; ++r) { s0[r] = __builtin_amdgcn_exp2f(s0[r] - m); s1[r] = __builtin_amdgcn_exp2f(s1[r] - m); lsum += s0[r] + s1[r]; }
            bf16x8 Pf[4];
#pragma unroll
            for (int s2 = 0; s2 < 2; ++s2) {
                u32x4 a, b;
                a.x = cvt_pk_bf16(s0[8 * s2 + 0], s0[8 * s2 + 1]); a.y = cvt_pk_bf16(s0[8 * s2 + 2], s0[8 * s2 + 3]); a.z = cvt_pk_bf16(s0[8 * s2 + 4], s0[8 * s2 + 5]); a.w = cvt_pk_bf16(s0[8 * s2 + 6], s0[8 * s2 + 7]);
                b.x = cvt_pk_bf16(s1[8 * s2 + 0], s1[8 * s2 + 1]); b.y = cvt_pk_bf16(s1[8 * s2 + 2], s1[8 * s2 + 3]); b.z = cvt_pk_bf16(s1[8 * s2 + 4], s1[8 * s2 + 5]); b.w = cvt_pk_bf16(s1[8 * s2 + 6], s1[8 * s2 + 7]);
                Pf[s2] = __builtin_bit_cast(bf16x8, a); Pf[2 + s2] = __builtin_bit_cast(bf16x8, b);
            }
#pragma unroll
            for (int db = 0; db < 4; ++db)
#pragma unroll
                for (int g = 0; g < 4; ++g) {
                    const bf16x8 vf = *(const LAS bf16x8*)(buf + 16384 + swz(32 * db + ln, 2 * g + hi));
                    O[db] = MFMA32(vf, Pf[g], O[db]);
                }
        }
        if (jt > 0) { *(LAS u32x4*)(nbuf + klds0) = pk0; *(LAS u32x4*)(nbuf + klds1) = pk1; *(LAS u32x4*)(nbuf + vlds0) = pv0; *(LAS u32x4*)(nbuf + vlds1) = pv1; }
        __syncthreads();
    }
    const float ltot = lsum + __shfl_xor(lsum, 32);
    LAS float* ex = (LAS float*)lds;
    if (c == 1) {
        const float sc = lam / ltot;
#pragma unroll
        for (int db = 0; db < 4; ++db)
#pragma unroll
            for (int r = 0; r < 16; ++r) ex[(rg * 64 + db * 16 + r) * 64 + lane] = O[db][r] * sc;
    }
    __syncthreads();
    if (c == 0) {
        const float inv = 1.0f / ltot; float ss = 0.f;
#pragma unroll
        for (int db = 0; db < 4; ++db)
#pragma unroll
            for (int r = 0; r < 16; ++r) { const float o = O[db][r] * inv - ex[(rg * 64 + db * 16 + r) * 64 + lane]; O[db][r] = o; ss += o * o; }
        ss += __shfl_xor(ss, 32);
        const float rn = __builtin_amdgcn_rsqf(ss * (1.0f / 128.0f) + LN_EPS) * outscale;
        bf16_t* op = MIX + (size_t)(rowmin + ln) * 1024 + h * 128 + 4 * hi;
#pragma unroll
        for (int db = 0; db < 4; ++db)
#pragma unroll
            for (int g = 0; g < 4; ++g) { const int dv0 = 32 * db + 8 * g;
                const f32x4 gv = *(const f32x4*)(subg + dv0 + 4 * hi);
                u32x2 wv; wv.x = cvt_pk_bf16(O[db][4 * g + 0] * rn * gv.x, O[db][4 * g + 1] * rn * gv.y); wv.y = cvt_pk_bf16(O[db][4 * g + 2] * rn * gv.z, O[db][4 * g + 3] * rn * gv.w);
                *(u32x2*)(op + dv0) = wv; }
    }
    __syncthreads();
}
#undef MFMA32
}

__device__ __forceinline__ void phase_attention(Frame& F, const ArgsV& A_, int l) {
    const bf16_t* U = (const bf16_t*)(F.ws + WS_U); const bf16_t* VT = (const bf16_t*)(F.ws + WS_VT); bf16_t* MIX = (bf16_t*)(F.ws + WS_MIX);
    float d1 = 0.f, d2 = 0.f;
    for (int i = 0; i < 64; ++i) { d1 += A_.in[4][l * 64 + i] * A_.in[5][l * 64 + i]; d2 += A_.in[6][l * 64 + i] * A_.in[7][l * 64 + i]; }
    const float lam_init = 0.8f - 0.6f * fexp(-0.3f * (float)l);
    const float lam = fexp(d1) - fexp(d2) + lam_init;
    for (int uu = F.bid; uu < 512; uu += 2 * F.G) {
        { const int u = uu; attn::attn_unit(F.lds, U, VT, MIX, A_.in[8] + l * 128, lam, 1.0f - lam_init, u & 3, 127 - (u >> 2), F.tid); }
        { const int u = 511 - uu; if (u >= 0 && u != uu) attn::attn_unit(F.lds, U, VT, MIX, A_.in[8] + l * 128, lam, 1.0f - lam_init, u & 3, 127 - (u >> 2), F.tid); }
    }
}

__device__ __forceinline__ void phase_lru_local(Frame& F, const ArgsV& A_, int l) {
    const bf16_t* U = (const bf16_t*)(F.ws + WS_U);
    float* HLOC = (float*)(F.ws + WS_HLOC); float* CUMA = (float*)(F.ws + WS_CUMA); float* AGG = (float*)(F.ws + WS_AGG);
    const float* cw = A_.in[9] + l * 4 * 256; const float* cb = A_.in[10] + l * 256;
    const float* wa = A_.in[11] + l * 4 * 4096; const float* ba = A_.in[12] + l * 256;
    const float* wx = A_.in[13] + l * 4 * 4096; const float* bx = A_.in[14] + l * 256; const float* lamp = A_.in[15] + l * 256;
    LAS float* wA = (LAS float*)F.lds; LAS float* wX = wA + 4096; LAS float* xc = wA + 8192; LAS float* wagg = wA + 8192 + 16384;
    const int w = F.wave, d = F.lane;
    for (int unit = F.bid; unit < 256; unit += F.G) {
        const int chunk = unit >> 2, blk = unit & 3, t0 = chunk * 256, ch0 = blk * 64;
        for (int i = F.tid; i < 4096; i += NTHREADS) { wA[i] = wa[blk * 4096 + i]; wX[i] = wx[blk * 4096 + i]; }
        { const int dd = F.tid & 63, ch = ch0 + dd; const float w0 = cw[ch], w1 = cw[256 + ch], w2 = cw[512 + ch], w3 = cw[768 + ch], bb = cb[ch];
          for (int t = F.tid >> 6; t < 256; t += 8) { const int tt = t0 + t; float a = bb;
              const bf16_t* up = U + (size_t)tt * NCOLA + ULX + ch;
              if (tt >= 3) a += w0 * bf2f(up[-3 * NCOLA]);
              if (tt >= 2) a += w1 * bf2f(up[-2 * NCOLA]);
              if (tt >= 1) a += w2 * bf2f(up[-1 * NCOLA]);
              a += w3 * bf2f(up[0]);
              xc[t * 64 + dd] = a; } }
        __syncthreads();
        float ga[32], gx[32];
#pragma unroll
        for (int tt = 0; tt < 32; ++tt) { ga[tt] = 0.f; gx[tt] = 0.f; }
        for (int cc = 0; cc < 64; ++cc) { const float wav = wA[cc * 64 + d], wxv = wX[cc * 64 + d];
#pragma unroll
            for (int tt = 0; tt < 32; ++tt) { const float x = xc[(32 * w + tt) * 64 + cc]; ga[tt] += x * wav; gx[tt] += x * wxv; } }
        const int ch = ch0 + d; const float bav = ba[ch], bxv = bx[ch];
        const float sp = flog(1.0f + fexp(-lamp[ch]));
        float hl = 0.f, ca = 1.f;
#pragma unroll
        for (int tt = 0; tt < 32; ++tt) {
            const float sa = sigmoidf_(ga[tt] + bav), sx = sigmoidf_(gx[tt] + bxv);
            const float log_a = -8.0f * sa * sp, a = fexp(log_a), mult = fsqrt(fmaxf(1.0f - a * a, 0.f));
            const float b = mult * sx * xc[(32 * w + tt) * 64 + d];
            hl = a * hl + b; ca *= a; ga[tt] = hl; gx[tt] = ca;
        }
        wagg[(w * 2 + 0) * 64 + d] = ca; wagg[(w * 2 + 1) * 64 + d] = hl;
        __syncthreads();
        float cin = 0.f, cprod = 1.f;
        for (int w2 = 0; w2 < w; ++w2) { const float A2 = wagg[(w2 * 2 + 0) * 64 + d], B2 = wagg[(w2 * 2 + 1) * 64 + d]; cin = A2 * cin + B2; cprod *= A2; }
#pragma unroll
        for (int tt = 0; tt < 32; ++tt) { const size_t o = (size_t)(t0 + 32 * w + tt) * 256 + ch; const float hh = ga[tt] + gx[tt] * cin, cA = gx[tt] * cprod; HLOC[o] = hh; CUMA[o] = cA;
            if (w == 7 && tt == 31) { AGG[(chunk * 2 + 0) * 256 + ch] = cA; AGG[(chunk * 2 + 1) * 256 + ch] = hh; } }
        __syncthreads();
    }
}
__device__ __forceinline__ void phase_lru_fix(Frame& F, const ArgsV& A_, int l) {
    const bf16_t* U = (const bf16_t*)(F.ws + WS_U); bf16_t* MIX = (bf16_t*)(F.ws + WS_MIX);
    const float* HLOC = (const float*)(F.ws + WS_HLOC); const float* CUMA = (const float*)(F.ws + WS_CUMA); const float* AGG = (const float*)(F.ws + WS_AGG);
    const int ch = F.tid & 255, half = F.tid >> 8;
    for (int unit = F.bid; unit < 256; unit += F.G) {
        const int chunk = unit >> 2, qt = unit & 3, t0 = chunk * 256 + qt * 64 + half * 32;
        float cin = 0.f;
        for (int k = 0; k < chunk; ++k) cin = AGG[(k * 2 + 0) * 256 + ch] * cin + AGG[(k * 2 + 1) * 256 + ch];
        for (int t = 0; t < 32; ++t) { const size_t tt = (size_t)(t0 + t);
            const float hh = HLOC[tt * 256 + ch] + CUMA[tt * 256 + ch] * cin;
            const float y = bf2f(U[tt * NCOLA + ULY + ch]);
            const float gl = y * frcp(1.0f + fexp(-2.0f * 0.7978845608028654f * (y + 0.044715f * y * y * y)));
            MIX[tt * 1024 + 512 + ch] = (bf16_t)f2bf(hh * gl); }
    }
}

__device__ __forceinline__ void phase_conformer(Frame& F, const ArgsV& A_, int l) {
    const bf16_t* U = (const bf16_t*)(F.ws + WS_U); bf16_t* MIX = (bf16_t*)(F.ws + WS_MIX);
    const float* cw = A_.in[16] + l * 31 * 256; const float* cb = A_.in[17] + l * 256; const float* lg = A_.in[18] + l * 256; const float* lb = A_.in[19] + l * 256;
    LAS float* gin = (LAS float*)F.lds; LAS float* cout = gin + 62 * 256;
    const int ch = F.tid & 255, half = F.tid >> 8;
    float wreg[31];
#pragma unroll
    for (int j = 0; j < 31; ++j) wreg[j] = cw[j * 256 + ch];
    const float bb = cb[ch];
    for (int unit = F.bid; unit < 512; unit += F.G) {
        const int t0 = unit * 32;
        for (int i = F.tid; i < 62 * 256; i += NTHREADS) { const int r = i >> 8, c2 = i & 255, ts = t0 - 30 + r; float v = 0.f;
            if (ts >= 0) { const float a = bf2f(U[(size_t)ts * NCOLA + UCA + c2]), b = bf2f(U[(size_t)ts * NCOLA + UCB + c2]); v = a * sigmoidf_(b); }
            gin[i] = v; }
        __syncthreads();
        for (int tt = 0; tt < 16; ++tt) { const int t = half * 16 + tt; float a = bb;
#pragma unroll
            for (int j = 0; j < 31; ++j) a += wreg[j] * gin[(t + j) * 256 + ch];
            cout[t * 256 + ch] = a; }
        __syncthreads();
#pragma unroll
        for (int q = 0; q < 4; ++q) { const int t = 4 * F.wave + q;
            f32x4 v = *(const LAS f32x4*)(cout + t * 256 + 4 * F.lane);
            const float mean = wave_sum((v.x + v.y) + (v.z + v.w)) * (1.f / 256.f); v = v - mean;
            const float var = wave_sum((v.x * v.x + v.y * v.y) + (v.z * v.z + v.w * v.w)) * (1.f / 256.f), rstd = __builtin_amdgcn_rsqf(var + LN_EPS);
            const f32x4 gv = *(const f32x4*)(lg + 4 * F.lane), bv = *(const f32x4*)(lb + 4 * F.lane);
            f32x4 y = v * rstd * gv + bv;
            y.x = y.x * sigmoidf_(y.x); y.y = y.y * sigmoidf_(y.y); y.z = y.z * sigmoidf_(y.z); y.w = y.w * sigmoidf_(y.w);
            u32x2 wv; wv.x = pk2(y.x, y.y); wv.y = pk2(y.z, y.w);
            *(u32x2*)(MIX + (size_t)(t0 + t) * 1024 + 768 + 4 * F.lane) = wv; }
        __syncthreads();
    }
}

__device__ __forceinline__ void phase_ln1(Frame& F, const ArgsV& A_, int l) {
    const float* HA = (const float*)(F.ws + WS_HA); const float* MO = (const float*)(F.ws + WS_MIXO); float* HB = (float*)(F.ws + WS_HB); bf16_t* XB = (bf16_t*)(F.ws + WS_XB);
    const int gw = F.bid * NWAVES + F.wave, NGW = F.G * NWAVES;
    for (int m = gw; m < T; m += NGW) {
        f32x4 v[4];
#pragma unroll
        for (int j = 0; j < 4; ++j) v[j] = *(const f32x4*)(HA + (size_t)m * D + 4 * F.lane + 256 * j) * ALPHA + *(const f32x4*)(MO + (size_t)m * D + 4 * F.lane + 256 * j);
        ln_store(v, A_.in[21] + l * D, A_.in[22] + l * D, HB + (size_t)m * D, XB + (size_t)m * D, F.lane);
    }
}

__device__ __forceinline__ void phase_router(Frame& F, const ArgsV& A_, int l) {
    const float* HB = (const float*)(F.ws + WS_HB); const float* rw = A_.in[23] + (size_t)l * 1024 * 32; const float* rb = A_.in[24] + l * 32;
    int* TKS = (int*)(F.ws + WS_TKS); float* TKG = (float*)(F.ws + WS_TKG); int* LIST = (int*)(F.ws + WS_LIST);
    unsigned* gcnt = (unsigned*)(F.ws + WS_CTL) + CW_CNT + l * 64;
    LAS float* part = (LAS float*)F.lds;
    LAS float* lg = (LAS float*)(F.lds + 65536);
    LAS unsigned* lcnt = (LAS unsigned*)(F.lds + 81920);
    const int ln = F.lane & 31, hf = F.lane >> 5, kb = F.wave * 128;
    float rwv[16][4];
#pragma unroll
    for (int i = 0; i < 16; ++i)
#pragma unroll
        for (int s = 0; s < 4; ++s) rwv[i][s] = rw[(size_t)(kb + 8 * i + 4 * hf + s) * 32 + ln];
    for (int base = F.bid * 64; base < T; base += F.G * 64) {
        if (F.tid < 64) lcnt[F.tid] = 0u;
#pragma unroll
        for (int g = 0; g < 2; ++g) {
            f32x4 hv[16];
            const float* hp = HB + (size_t)(base + 32 * g + ln) * D + kb + 4 * hf;
#pragma unroll
            for (int i = 0; i < 16; ++i) hv[i] = *(const f32x4*)(hp + 8 * i);
            f32x16 acc;
#pragma unroll
            for (int r = 0; r < 16; ++r) acc[r] = 0.f;
#pragma unroll
            for (int i = 0; i < 16; ++i) {
                acc = __builtin_amdgcn_mfma_f32_32x32x2f32(rwv[i][0], hv[i].x, acc, 0, 0, 0);
                acc = __builtin_amdgcn_mfma_f32_32x32x2f32(rwv[i][1], hv[i].y, acc, 0, 0, 0);
                acc = __builtin_amdgcn_mfma_f32_32x32x2f32(rwv[i][2], hv[i].z, acc, 0, 0, 0);
                acc = __builtin_amdgcn_mfma_f32_32x32x2f32(rwv[i][3], hv[i].w, acc, 0, 0, 0);
            }
#pragma unroll
            for (int r = 0; r < 16; ++r) { const int e = (r & 3) + 8 * (r >> 2) + 4 * hf; part[((F.wave * 2 + g) * 32 + e) * 32 + ln] = acc[r]; }
        }
        __syncthreads();
        { const int tt = F.tid & 63, eg = F.tid >> 6;
#pragma unroll
          for (int q = 0; q < 4; ++q) { const int e = 4 * eg + q; float s = rb[e];
#pragma unroll
              for (int w2 = 0; w2 < 8; ++w2) s += part[((w2 * 2 + (tt >> 5)) * 32 + e) * 32 + (tt & 31)];
              lg[tt * 33 + e] = s; } }
        __syncthreads();
        int sel[4]; float sv[4]; int pos[4];
        if (F.tid < 64) {
            float v[32];
#pragma unroll
            for (int e = 0; e < 32; ++e) v[e] = lg[F.tid * 33 + e];
#pragma unroll
            for (int k = 0; k < 4; ++k) { float best = -__builtin_inff(); int bi = 0;
#pragma unroll
                for (int e = 0; e < 32; ++e) { if (v[e] > best) { best = v[e]; bi = e; } }
                sel[k] = bi; sv[k] = best;
#pragma unroll
                for (int e = 0; e < 32; ++e) if (e == bi) v[e] = -__builtin_inff(); }
            const float e1 = fexp(sv[1] - sv[0]), e2 = fexp(sv[2] - sv[0]), e3 = fexp(sv[3] - sv[0]), inv = 1.0f / (1.0f + e1 + e2 + e3);
            sv[0] = inv; sv[1] = e1 * inv; sv[2] = e2 * inv; sv[3] = e3 * inv;
#pragma unroll
            for (int k = 0; k < 4; ++k) pos[k] = (int)atomicAdd((unsigned*)&lcnt[sel[k]], 1u);
        }
        __syncthreads();
        if (F.tid < 32) lcnt[32 + F.tid] = atomicAdd(&gcnt[F.tid], lcnt[F.tid]);
        __syncthreads();
        if (F.tid < 64) {
            const int t = base + F.tid;
#pragma unroll
            for (int k = 0; k < 4; ++k) { const int p = pos[k] + (int)lcnt[32 + sel[k]]; TKS[t * 4 + k] = sel[k] * T + p; TKG[t * 4 + k] = sv[k]; LIST[(size_t)sel[k] * T + p] = t; }
        }
        __syncthreads();
    }
}

__device__ __forceinline__ void moe_tables(Frame& F, int l, int NT) {
    LAS int* tab = (LAS int*)(F.lds + MISC_OFF);
    if (F.wave == 0) {
        const unsigned* gcnt = (const unsigned*)(F.ws + WS_CTL) + CW_CNT + l * 64;
        const int e = F.lane & 31;
        const int c = (int)__hip_atomic_load(&gcnt[e], __ATOMIC_RELAXED, __HIP_MEMORY_SCOPE_AGENT);
        const int tm = (c + 255) >> 8;
        int incl = tm;
#pragma unroll
        for (int o = 1; o < 32; o <<= 1) { const int v = __shfl_up(incl, o, 32); if (e >= o) incl += v; }
        if (F.lane < 32) { tab[e] = (incl - tm) * NT; tab[40 + e] = (incl - tm) * 256; tab[80 + e] = c; if (e == 31) tab[32] = incl * NT; }
    }
    __syncthreads();
}

__device__ __forceinline__ void phase_combine(Frame& F, const ArgsV& A_, int l, float* outp) {
    moe_tables(F, l, 1);
    const LAS int* tab = (const LAS int*)(F.lds + MISC_OFF);
    const float* HB = (const float*)(F.ws + WS_HB); const bf16_t* Y = (const bf16_t*)(F.ws + WS_Y);
    const int* TKS = (const int*)(F.ws + WS_TKS); const float* TKG = (const float*)(F.ws + WS_TKG);
    float* HA = outp ? outp : (float*)(F.ws + WS_HA); bf16_t* XB = outp ? nullptr : (bf16_t*)(F.ws + WS_XB);
    const int gw = F.bid * NWAVES + F.wave, NGW = F.G * NWAVES;
    for (int m = gw; m < T; m += NGW) {
        f32x4 v[4];
#pragma unroll
        for (int j = 0; j < 4; ++j) v[j] = *(const f32x4*)(HB + (size_t)m * D + 4 * F.lane + 256 * j) * ALPHA;
#pragma unroll
        for (int k = 0; k < 4; ++k) { const int code = TKS[m * 4 + k]; const float g = TKG[m * 4 + k]; const int e = code >> 14, p = code & (T - 1);
            const bf16_t* yr = Y + (size_t)(tab[40 + e] + p) * 1024 + 4 * F.lane;
#pragma unroll
            for (int j = 0; j < 4; ++j) { const u32x2 wv = *(const u32x2*)(yr + 256 * j); v[j].x += g * bflo(wv.x); v[j].y += g * bfhi(wv.x); v[j].z += g * bflo(wv.y); v[j].w += g * bfhi(wv.y); } }
        ln_store(v, A_.in[29] + l * D, A_.in[30] + l * D, HA + (size_t)m * D, XB ? XB + (size_t)m * D : nullptr, F.lane);
    }
    __syncthreads();
}

constexpr int PH_PER_LAYER = 10, N_PHASES = 1 + NL * PH_PER_LAYER;

__global__ void __launch_bounds__(NTHREADS, 2) mk_fwd(Args args) {
    extern __shared__ __attribute__((aligned(16))) unsigned char lds_raw[];
    LAS unsigned char* const lds = (LAS unsigned char*)lds_raw;
    const int lo = args.ph_lo, hi = args.ph_hi;
    volatile LAS unsigned* bst = (volatile LAS unsigned*)(lds + MISC_OFF + 2048);
    if (threadIdx.x < 2) bst[threadIdx.x] = 0u;
    if (threadIdx.x == 0) {
        LAS unsigned long long* pt = (LAS unsigned long long*)(lds + PTAB_OFF);
#pragma unroll
        for (int k = 0; k < 31; ++k) pt[k] = (unsigned long long)args.in[k];
    }
    __syncthreads();
    XcdBarrier bar; bar.bar = (unsigned*)(args.ws + WS_CTL) + CW_BAR; bar.x = 0; bar.st = bst;
    if (hi - lo > 1) bar = xcd_barrier_post((unsigned*)(args.ws + WS_CTL) + CW_BAR, bst);
    const ArgsV AV{InTab{lds}};
#ifdef ONLY_SUB
    const int only_sub = ONLY_SUB;
#else
    const int only_sub = -2;
#endif
#pragma unroll 1
    for (int ph = lo; ph < hi; ++ph) {
        const int l = (ph > 0) ? (ph - 1) / PH_PER_LAYER : 0;
        int sub = (ph > 0) ? (ph - 1) % PH_PER_LAYER : -1;
        if (only_sub != -2 && sub != only_sub) continue;
        bool seam = true;
        switch (sub) {
        case -1: { Frame F = make_frame(lds, args.ws); phase_prologue(F, AV); } break;
        case 0: {
            Frame F = make_frame(lds, args.ws);
            pg8::PlainOrder S; S.init(WS_XB, WS_WINT + (size_t)l * 2560 * 1024 * 2, T, NCOLA, F.G, F.bid);
            pg8::EpiBf16 E{(bf16_t*)(F.ws + WS_U), NCOLA, nullptr, 0, 0.125f * LOG2E, 512};
            pg8::gemm_phase<pg8::EpiBf16, pg8::PlainOrder, true>(F.lds, (const char*)F.ws, F.tid, S, E);
            seam = false; } break;
        case 1: {
            Frame F = make_frame(lds, args.ws);
            pg8::PlainOrder S; S.init(WS_WINT + ((size_t)l * 2560 + 2048) * 1024 * 2, WS_XB, 512, T, F.G, F.bid);
            pg8::EpiVT E{(bf16_t*)(F.ws + WS_VT)};
            pg8::gemm_phase<pg8::EpiVT, pg8::PlainOrder, true>(F.lds, (const char*)F.ws, F.tid, S, E); } break;
        case 2: {
            { Frame F = make_frame(lds, args.ws); phase_attention(F, AV, l); }
#if PROBE_DUP == 1
            { Frame F = make_frame(lds, args.ws); phase_attention(F, AV, l); }
#endif
            { Frame F = make_frame(lds, args.ws); phase_lru_local(F, AV, l); }
            { Frame F = make_frame(lds, args.ws); phase_conformer(F, AV, l); } } break;
        case 3: { Frame F = make_frame(lds, args.ws); phase_lru_fix(F, AV, l); } break;
        case 4: {
            Frame F = make_frame(lds, args.ws);
            pg8::PlainOrder S; S.init(WS_MIX, WS_WOUTT + (size_t)l * 1024 * 1024 * 2, T, D, F.G, F.bid);
            pg8::EpiF32 E{(float*)(F.ws + WS_MIXO), D};
            pg8::gemm_phase<pg8::EpiF32, pg8::PlainOrder, true>(F.lds, (const char*)F.ws, F.tid, S, E); } break;
        case 5: { Frame F = make_frame(lds, args.ws); phase_ln1(F, AV, l); } break;
        case 6: { Frame F = make_frame(lds, args.ws); phase_router(F, AV, l); } break;
        case 7: {
            Frame F = make_frame(lds, args.ws);
            moe_tables(F, l, 8);
            pg8::MoeOrder S{(unsigned)WS_XB, (unsigned)(WS_W1T + (size_t)l * NE * 2048 * 1024 * 2), 2048u * 1024u * 2u, 8, 1, (const int*)(F.ws + WS_LIST), (const LAS int*)(F.lds + MISC_OFF), F.G, F.bid};
            pg8::EpiAct E{(bf16_t*)(F.ws + WS_ACT), AV.in[26] + (size_t)l * NE * 2048};
            pg8::gemm_phase<pg8::EpiAct, pg8::MoeOrder, true>(F.lds, (const char*)F.ws, F.tid, S, E); } break;
        case 8: {
            Frame F = make_frame(lds, args.ws);
            moe_tables(F, l, 4);
            pg8::MoeOrder S{(unsigned)WS_ACT, (unsigned)(WS_W2T + (size_t)l * NE * 1024 * 1024 * 2), 1024u * 1024u * 2u, 4, 0, nullptr, (const LAS int*)(F.lds + MISC_OFF), F.G, F.bid};
            pg8::EpiBf16 E{(bf16_t*)(F.ws + WS_Y), 1024, AV.in[28] + (size_t)l * NE * 1024, 1024, 1.0f, 0};
            pg8::gemm_phase<pg8::EpiBf16, pg8::MoeOrder, true>(F.lds, (const char*)F.ws, F.tid, S, E); } break;
        default: { Frame F = make_frame(lds, args.ws); phase_combine(F, AV, l, (l == NL - 1) ? args.out : nullptr); } break;
        }
        if (seam && ph + 1 < hi) xcd_barrier(bar);
    }
}

extern "C" void kernel_launch(void* const* d_in, const int* in_sizes, int n_in, void* d_out, int out_size, void* d_ws, size_t ws_size, hipStream_t stream) {
    static int grid = 0;
    if (grid == 0) {
        if (n_in != 31 || out_size != T * D || ws_size < WS_END) { fprintf(stderr, "kernel_launch: unexpected sizes n_in %d out %d ws %zu (need %zu)\n", n_in, out_size, ws_size, (size_t)WS_END); grid = -1; return; }
        int dev = 0, cus = 0, per_cu = 0;
        if (hipGetDevice(&dev) != hipSuccess || hipDeviceGetAttribute(&cus, hipDeviceAttributeMultiprocessorCount, dev) != hipSuccess) { grid = -1; return; }
        if (hipFuncSetAttribute((const void*)mk_fwd, hipFuncAttributeMaxDynamicSharedMemorySize, LDS_BYTES) != hipSuccess) { fprintf(stderr, "kernel_launch: hipFuncSetAttribute failed\n"); grid = -1; return; }
        if (hipOccupancyMaxActiveBlocksPerMultiprocessor(&per_cu, (const void*)mk_fwd, NTHREADS, LDS_BYTES) != hipSuccess || per_cu < 1) { fprintf(stderr, "kernel_launch: occupancy query says %d blocks per CU\n", per_cu); (void)hipGetLastError(); grid = -1; return; }
        grid = cus;
    }
    if (grid < 0) return;
    (void)hipMemsetAsync((char*)d_ws + WS_CTL, 0, CTL_ZERO_BYTES, stream);
    Args a{};
    for (int i = 0; i < 31; ++i) a.in[i] = (const float*)d_in[i];
    a.out = (float*)d_out; a.ws = (unsigned char*)d_ws;
#if MK_ONE_LAUNCH
    a.ph_lo = 0; a.ph_hi = N_PHASES;
    hipLaunchKernelGGL(mk_fwd, dim3(grid), dim3(NTHREADS), LDS_BYTES, stream, a);
#ifdef PROBE_LO
    a.ph_lo = PROBE_LO; a.ph_hi = PROBE_HI;
    hipLaunchKernelGGL(mk_fwd, dim3(grid), dim3(NTHREADS), LDS_BYTES, stream, a);
#endif
#else
    for (int p = 0; p < N_PHASES; ++p) { a.ph_lo = p; a.ph_hi = p + 1; hipLaunchKernelGGL(mk_fwd, dim3(grid), dim3(NTHREADS), LDS_BYTES, stream, a); }
#endif
}
```

```cpp
#include <hip/hip_runtime.h>
#include <cstdio>
#include <cstdint>

#ifndef PROBE_DUP
#define PROBE_DUP 0
#endif
#ifndef MK_ONE_LAUNCH
#define MK_ONE_LAUNCH 1
#endif

#define LAS __attribute__((address_space(3)))
#define GAS __attribute__((address_space(1)))
typedef unsigned short bf16_t;
typedef short bf16x8 __attribute__((ext_vector_type(8)));
typedef float f32x2 __attribute__((ext_vector_type(2)));
typedef float f32x4 __attribute__((ext_vector_type(4)));
typedef float f32x16 __attribute__((ext_vector_type(16)));
typedef unsigned u32x4 __attribute__((ext_vector_type(4)));
typedef unsigned u32x2 __attribute__((ext_vector_type(2)));

constexpr int T = 16384, D = 1024, NL = 2, NE = 32, KD = 1024;
constexpr int NCOLA = 2048;
constexpr int UQ = 0, UK = 512, ULX = 1024, ULY = 1280, UCA = 1536, UCB = 1792;
constexpr float LN_EPS = 1e-5f;
constexpr float ALPHA = 1.41421356237309515f;
constexpr float LOG2E = 1.44269504088896341f;
constexpr int NWAVES = 8, NTHREADS = 512;
constexpr int ACT_ROWS = 65536 + 32 * 256 + 256;

constexpr size_t MiB = 1u << 20;
constexpr size_t WS_CTL = 0, CTL_ZERO_BYTES = 1 * MiB;
constexpr size_t WS_WINT = 2 * MiB;
constexpr size_t WS_WOUTT = 12 * MiB;
constexpr size_t WS_W1T = 16 * MiB;
constexpr size_t WS_W2T = 272 * MiB;
constexpr size_t WS_HA = 400 * MiB;
constexpr size_t WS_HB = 464 * MiB;
constexpr size_t WS_XB = 528 * MiB;
constexpr size_t WS_U = 560 * MiB;
constexpr size_t WS_VT = 624 * MiB;
constexpr size_t WS_MIX = 640 * MiB;
constexpr size_t WS_MIXO = 672 * MiB;
constexpr size_t WS_HLOC = 736 * MiB;
constexpr size_t WS_CUMA = 752 * MiB;
constexpr size_t WS_AGG = 768 * MiB;
constexpr size_t WS_TKS = 769 * MiB;
constexpr size_t WS_TKG = 769 * MiB + 512 * 1024;
constexpr size_t WS_LIST = 770 * MiB;
constexpr size_t WS_ACT = 772 * MiB;
constexpr size_t WS_Y = 920 * MiB;
constexpr size_t WS_END = 1068 * MiB;
static_assert(WS_ACT + (size_t)ACT_ROWS * 2048 <= WS_Y && WS_Y + (size_t)ACT_ROWS * 2048 <= WS_END, "ws map");
constexpr int CW_BAR = 4096;
constexpr int CW_CNT = 16384;

constexpr int RING_BYTES = 135168;
constexpr int MISC_OFF = RING_BYTES;
constexpr int LDS_BYTES = 147456;
constexpr int VA_PARK_OFF = MISC_OFF + 4096;

__device__ __forceinline__ unsigned f2bf(float f) { unsigned u = __builtin_bit_cast(unsigned, f); return (u + 0x7fffu + ((u >> 16) & 1u)) >> 16; }
__device__ __forceinline__ unsigned pk2(float lo, float hi) { return f2bf(lo) | (f2bf(hi) << 16); }
__device__ __forceinline__ float bf2f(bf16_t v) { return __builtin_bit_cast(float, (unsigned)v << 16); }
__device__ __forceinline__ float bflo(unsigned w) { return __builtin_bit_cast(float, w << 16); }
__device__ __forceinline__ float bfhi(unsigned w) { return __builtin_bit_cast(float, w & 0xffff0000u); }
__device__ __forceinline__ unsigned cvt_pk_bf16(float lo, float hi) { unsigned r; asm volatile("v_cvt_pk_bf16_f32 %0, %1, %2" : "=v"(r) : "v"(lo), "v"(hi)); return r; }
__device__ __forceinline__ float wave_sum(float v) {
#pragma unroll
    for (int o = 1; o < 64; o <<= 1) v += __shfl_xor(v, o);
    return v;
}
__device__ __forceinline__ float ex2(float x) { return __builtin_amdgcn_exp2f(x); }
__device__ __forceinline__ float fexp(float x) { return __builtin_amdgcn_exp2f(x * LOG2E); }
__device__ __forceinline__ float frcp(float x) { return __builtin_amdgcn_rcpf(x); }
__device__ __forceinline__ float fsqrt(float x) { return __builtin_amdgcn_sqrtf(x); }
__device__ __forceinline__ float flog(float x) { return __builtin_amdgcn_logf(x) * 0.693147180559945f; }
__device__ __forceinline__ float sigmoidf_(float x) { return frcp(1.0f + fexp(-x)); }
#define LDS_WAIT() asm volatile("s_waitcnt lgkmcnt(0)" ::: "memory")
#define VM_WAIT() asm volatile("s_waitcnt vmcnt(0)" ::: "memory")

namespace pg8 {
constexpr int BM = 256, BK = 64, HALF = 128, HTB = HALF * BK * 2, STAGE_BYTES = 8 * HTB, NXCD = 8, WGM = 8;
__device__ __forceinline__ int lds_byte(int r, int c) { const int st = (r >> 4) * 2 + (c >> 5), rr = r & 15, cc = c & 31, ob = rr * 64 + cc * 2; return st * 1024 + (ob ^ (((ob >> 9) & 1) << 5)); }
__device__ __forceinline__ void stage_rc(int b, int& R, int& C) { const unsigned ub = (unsigned)b, st = ub >> 10, sb = ub & 1023u, swz = sb ^ (((sb >> 9) & 1u) << 5); R = (int)((st >> 1) * 16u + (swz >> 6)); C = (int)((st & 1u) * 32u + ((swz & 63u) >> 1)); }
__device__ __forceinline__ int perm32(int rho) { const int n = rho >> 4, i = rho & 15; return 8 * (i >> 2) + 4 * n + (i & 3); }

struct Unit { unsigned A, B; int pn, e, orow; unsigned va00, va01, va10, va11; };

struct PlainOrder {
    unsigned A, Bt; int nM, nN, nwg, G, c;
    __device__ void init(size_t A_, size_t Bt_, int M, int N, int G_, int c_) { A = (unsigned)A_; Bt = (unsigned)Bt_; nM = M / BM; nN = N / BM; nwg = nM * nN; G = G_; c = c_; }
    __device__ __forceinline__ bool next(int i, Unit& u, int tid) const {
        const long L = (long)i * G + c; if (L >= nwg) return false;
        int R0, C0, R1, C1; stage_rc(tid * 16, R0, C0); stage_rc(tid * 16 + 8192, R1, C1);
        int wgid = (int)L; { const int q = nwg / NXCD, r = nwg % NXCD, xcd = wgid % NXCD, off = wgid / NXCD; wgid = (xcd < r ? xcd * (q + 1) : r * (q + 1) + (xcd - r) * q) + off; }
        const int nig = WGM * nN, gid = wgid / nig, fm = gid * WGM, gsz = (nM - fm) < WGM ? (nM - fm) : WGM;
        const int pm = fm + ((wgid % nig) % gsz), pn = (wgid % nig) / gsz;
        u.A = A + (unsigned)pm * (BM * KD * 2); u.B = Bt + (unsigned)pn * (BM * KD * 2); u.pn = pn; u.e = 0; u.orow = pm * BM;
        u.va00 = (unsigned)(R0 * KD + C0) * 2u; u.va01 = (unsigned)(R1 * KD + C1) * 2u; u.va10 = (unsigned)((R0 + HALF) * KD + C0) * 2u; u.va11 = (unsigned)((R1 + HALF) * KD + C1) * 2u;
        return true;
    }
};

struct MoeOrder {
    unsigned Abase, Bt, bstride; int NT; int gather; const int* list; const LAS int* tab; int G, c;
    __device__ __forceinline__ bool next(int i, Unit& u, int tid) const {
        const int NU = __builtin_amdgcn_readfirstlane(tab[32]);
        int L;
        if ((G & 7) == 0) { const int g8 = G >> 3, per = (NU + 7) >> 3, idx = i * g8 + (c >> 3); if (idx >= per) return false; L = (c & 7) * per + idx; }
        else L = i * G + c;
        if (L >= NU) return false;
        int R0, C0, R1, C1; stage_rc(tid * 16, R0, C0); stage_rc(tid * 16 + 8192, R1, C1);
        const int ln_ = tid & 63;
        int e = __popcll(__ballot(ln_ >= 1 && ln_ < 32 && L >= tab[ln_ & 31]));
        e = __builtin_amdgcn_readfirstlane(e);
        const int ub = __builtin_amdgcn_readfirstlane(tab[e]), ub1 = __builtin_amdgcn_readfirstlane(tab[e + 1]);
        const int ps = __builtin_amdgcn_readfirstlane(tab[40 + e]), cnt = __builtin_amdgcn_readfirstlane(tab[80 + e]);
        const int tm = (ub1 - ub) / NT, r = L - ub, mt = r % tm, nt = r / tm;
        u.e = e; u.pn = nt; u.orow = ps + mt * BM;
        u.B = Bt + (unsigned)e * bstride + (unsigned)nt * (BM * KD * 2);
        if (gather) {
            u.A = Abase;
            const int* lp = list + (size_t)e * T + mt * BM; const int lim = cnt - mt * BM;
            const int t00 = (R0 < lim) ? lp[R0] : 0, t01 = (R1 < lim) ? lp[R1] : 0, t10 = (R0 + HALF < lim) ? lp[R0 + HALF] : 0, t11 = (R1 + HALF < lim) ? lp[R1 + HALF] : 0;
            u.va00 = (unsigned)(t00 * KD + C0) * 2u; u.va01 = (unsigned)(t01 * KD + C1) * 2u; u.va10 = (unsigned)(t10 * KD + C0) * 2u; u.va11 = (unsigned)(t11 * KD + C1) * 2u;
        } else {
            u.A = Abase + (unsigned)u.orow * (KD * 2);
            u.va00 = (unsigned)(R0 * KD + C0) * 2u; u.va01 = (unsigned)(R1 * KD + C1) * 2u; u.va10 = (unsigned)((R0 + HALF) * KD + C0) * 2u; u.va11 = (unsigned)((R1 + HALF) * KD + C1) * 2u;
        }
        return true;
    }
};

struct EpiBf16 {
    static constexpr bool PERM = true;
    bf16_t* O; int ldc; const float* bias; int bias_stride; float scale0; int scale_cols;
    __device__ __forceinline__ void operator()(const f32x4 (&acc)[2][2][4][2], const Unit& u, int wr, int wc, int fr, int fq) const {
        const int row0 = u.orow + wr * 64 + fr, colt = u.pn * BM, col0 = colt + wc * 32 + 8 * fq;
        const float sc = (colt < scale_cols) ? scale0 : 1.f;
        const float* bp = bias ? bias + (size_t)u.e * bias_stride : nullptr;
        f32x4 bv[2][2];
#pragma unroll
        for (int bj = 0; bj < 2; ++bj)
#pragma unroll
            for (int n = 0; n < 2; ++n) bv[bj][n] = bp ? *(const f32x4*)(bp + col0 + bj * HALF + 4 * n) : (f32x4){0.f, 0.f, 0.f, 0.f};
#pragma unroll
        for (int ai = 0; ai < 2; ++ai)
#pragma unroll
            for (int m = 0; m < 4; ++m) { bf16_t* rowp = O + (size_t)(row0 + ai * HALF + m * 16) * ldc + col0;
#pragma unroll
                for (int bj = 0; bj < 2; ++bj) { f32x4 v0 = (acc[ai][bj][m][0] + bv[bj][0]) * sc, v1 = (acc[ai][bj][m][1] + bv[bj][1]) * sc;
                    u32x4 w; w.x = cvt_pk_bf16(v0[0], v0[1]); w.y = cvt_pk_bf16(v0[2], v0[3]); w.z = cvt_pk_bf16(v1[0], v1[1]); w.w = cvt_pk_bf16(v1[2], v1[3]);
                    *(u32x4*)(rowp + bj * HALF) = w; } }
    }
};
struct EpiVT {
    static constexpr bool PERM = false;
    bf16_t* O;
    __device__ __forceinline__ void operator()(const f32x4 (&acc)[2][2][4][2], const Unit& u, int wr, int wc, int fr, int fq) const {
        const int sfq = (fq == 1) ? 2 : ((fq == 2) ? 1 : fq);
        const int row0 = u.orow + wr * 64 + fr, col0 = u.pn * BM + wc * 32 + 4 * sfq;
#pragma unroll
        for (int ai = 0; ai < 2; ++ai)
#pragma unroll
            for (int m = 0; m < 4; ++m) { bf16_t* rowp = O + (size_t)(row0 + ai * HALF + m * 16) * T + col0;
#pragma unroll
                for (int bj = 0; bj < 2; ++bj)
#pragma unroll
                    for (int n = 0; n < 2; ++n) { const f32x4 v = acc[ai][bj][m][n]; u32x2 w; w.x = cvt_pk_bf16(v[0], v[1]); w.y = cvt_pk_bf16(v[2], v[3]); *(u32x2*)(rowp + bj * HALF + n * 16) = w; } }
    }
};
struct EpiF32 {
    static constexpr bool PERM = false;
    float* O; int ldc;
    __device__ __forceinline__ void operator()(const f32x4 (&acc)[2][2][4][2], const Unit& u, int wr, int wc, int fr, int fq) const {
        const int row0 = u.orow + wr * 64 + fr, col0 = u.pn * BM + wc * 32 + 4 * fq;
#pragma unroll
        for (int ai = 0; ai < 2; ++ai)
#pragma unroll
            for (int m = 0; m < 4; ++m) { float* rowp = O + (size_t)(row0 + ai * HALF + m * 16) * ldc + col0;
#pragma unroll
                for (int bj = 0; bj < 2; ++bj)
#pragma unroll
                    for (int n = 0; n < 2; ++n) *(f32x4*)(rowp + bj * HALF + n * 16) = acc[ai][bj][m][n]; }
    }
};
struct EpiAct {
    static constexpr bool PERM = true;
    bf16_t* O; const float* b1;
    __device__ __forceinline__ void operator()(const f32x4 (&acc)[2][2][4][2], const Unit& u, int wr, int wc, int fr, int fq) const {
        const int row0 = u.orow + wr * 64 + fr, j0 = u.pn * HALF + wc * 32 + 8 * fq;
        const float* bp = b1 + (size_t)u.e * 2048;
        f32x4 bg[2], bl[2];
#pragma unroll
        for (int n = 0; n < 2; ++n) { bg[n] = *(const f32x4*)(bp + j0 + 4 * n); bl[n] = *(const f32x4*)(bp + 1024 + j0 + 4 * n); }
#pragma unroll
        for (int ai = 0; ai < 2; ++ai)
#pragma unroll
            for (int m = 0; m < 4; ++m) { bf16_t* rowp = O + (size_t)(row0 + ai * HALF + m * 16) * 1024 + j0;
                float o[8];
#pragma unroll
                for (int n = 0; n < 2; ++n)
#pragma unroll
                    for (int q = 0; q < 4; ++q) { float g = acc[ai][0][m][n][q] + bg[n][q], l = acc[ai][1][m][n][q] + bl[n][q];
                        g = fminf(g, 7.0f); l = fminf(fmaxf(l, -7.0f), 7.0f);
                        o[n * 4 + q] = g * (1.0f / (1.0f + __builtin_amdgcn_exp2f(-1.702f * LOG2E * g))) * (l + 1.0f); }
                u32x4 w; w.x = cvt_pk_bf16(o[0], o[1]); w.y = cvt_pk_bf16(o[2], o[3]); w.z = cvt_pk_bf16(o[4], o[5]); w.w = cvt_pk_bf16(o[6], o[7]);
                *(u32x4*)rowp = w; }
    }
};

template <class Epi, class Sched, bool ALIGN_EPI>
__device__ __forceinline__ void gemm_phase(LAS unsigned char* lds, const char* wsb, const int tid0, const Sched& S, const Epi& E) {
    Unit cur, nxt; int ui = 0;
    if (!S.next(0, cur, tid0)) return;
    int tid = tid0; asm volatile("" : "+v"(tid));
    const int wid = __builtin_amdgcn_readfirstlane(tid >> 6), lane = tid & 63, wr = wid >> 2, wc = wid & 3, fr = lane & 15, fq = lane >> 4;
    constexpr int K = KD, nt = K / BK;
    unsigned voffB[2];
    { int R0, C0, R1, C1; stage_rc(tid * 16, R0, C0); stage_rc(tid * 16 + 8192, R1, C1);
      const int Rb0 = Epi::PERM ? ((R0 & ~31) + perm32(R0 & 31)) : R0, Rb1 = Epi::PERM ? ((R1 & ~31) + perm32(R1 & 31)) : R1;
      voffB[0] = (unsigned)(Rb0 * K + C0) * 2u; voffB[1] = (unsigned)(Rb1 * K + C1) * 2u; }
    constexpr unsigned kstep = (unsigned)(BK * 2);
    constexpr unsigned hstep = (unsigned)HALF * K * 2;
    const unsigned ldsw = (unsigned)wid * 1024u;
    const int aoff = lds_byte(wr * 64 + fr, fq * 8), boff = lds_byte(wc * 32 + fr, fq * 8);
#define PG8_SA(b, h) (((b) * 2 + (h)) * HTB)
#define PG8_SB(b, h) ((4 + (b) * 2 + (h)) * HTB)
#define PG8_GLDS(gp, lp) __builtin_amdgcn_global_load_lds((const unsigned*)(gp), (LAS unsigned*)(lp), 16, 0, 0)
#define PG8_STB(bufoff, gbase) do { PG8_GLDS(wsb + (size_t)((gbase) + voffB[0]), lds + (bufoff) + ldsw); PG8_GLDS(wsb + (size_t)((gbase) + voffB[1]), lds + (bufoff) + ldsw + 8192); } while (0)
#define PG8_STA(bufoff, gbase, v0, v1) do { PG8_GLDS(wsb + (size_t)((gbase) + (v0)), lds + (bufoff) + ldsw); PG8_GLDS(wsb + (size_t)((gbase) + (v1)), lds + (bufoff) + ldsw + 8192); } while (0)
#define PG8_LDA(dst, b, h) do { _Pragma("unroll") for (int m = 0; m < 4; ++m) _Pragma("unroll") for (int k = 0; k < 2; ++k) dst[m][k] = *(const LAS bf16x8*)(lds + PG8_SA(b, h) + aoff + m * 2048 + k * 1024); } while (0)
#define PG8_LDB(dst, b, h) do { _Pragma("unroll") for (int n = 0; n < 2; ++n) _Pragma("unroll") for (int k = 0; k < 2; ++k) dst[n][k] = *(const LAS bf16x8*)(lds + PG8_SB(b, h) + boff + n * 2048 + k * 1024); } while (0)
#define PG8_MMA(ai, bj, At, Bt) do { __builtin_amdgcn_s_setprio(1); _Pragma("unroll") for (int m = 0; m < 4; ++m) _Pragma("unroll") for (int n = 0; n < 2; ++n) _Pragma("unroll") for (int k = 0; k < 2; ++k) \
        acc[ai][bj][m][n] = __builtin_amdgcn_mfma_f32_16x16x32_bf16(Bt[n][k], At[m][k], acc[ai][bj][m][n], 0, 0, 0); __builtin_amdgcn_s_setprio(0); } while (0)
#define PG8_WAIT_V(n) asm volatile("s_waitcnt vmcnt(" #n ")" ::: "memory")
#define PG8_WAIT_L(n) asm volatile("s_waitcnt lgkmcnt(" #n ")" ::: "memory")
#define PG8_BAR __builtin_amdgcn_s_barrier()
#define PG8_SCHED __builtin_amdgcn_sched_barrier(0)
    f32x4 acc[2][2][4][2];
#pragma unroll
    for (int a = 0; a < 2; ++a)
#pragma unroll
        for (int b = 0; b < 2; ++b)
#pragma unroll
            for (int m = 0; m < 4; ++m)
#pragma unroll
                for (int n = 0; n < 2; ++n) acc[a][b][m][n] = (f32x4){0.f, 0.f, 0.f, 0.f};
    bf16x8 At[4][2], B0[2][2], B1[2][2];
    unsigned cA = cur.A, cB = cur.B;
    unsigned c00 = cur.va00, c01 = cur.va01, c10 = cur.va10, c11 = cur.va11;
    PG8_STB(PG8_SB(0, 0), cB); PG8_STB(PG8_SB(0, 1), cB + hstep); PG8_STA(PG8_SA(0, 0), cA, c00, c01); PG8_STA(PG8_SA(0, 1), cA, c10, c11);
    if (wr == 1) PG8_BAR;
    PG8_WAIT_V(2); PG8_BAR;
    PG8_STB(PG8_SB(1, 0), cB + kstep); PG8_STA(PG8_SA(1, 0), cA + kstep, c00, c01); PG8_STB(PG8_SB(1, 1), cB + hstep + kstep);
    PG8_WAIT_V(6); PG8_BAR;
    for (;;) {
        const bool has_next = S.next(ui + 1, nxt, tid);
        const unsigned nA = has_next ? nxt.A : cA, nB = has_next ? nxt.B : cB;
        { u32x4 pv; pv.x = has_next ? nxt.va00 : c00; pv.y = has_next ? nxt.va01 : c01; pv.z = has_next ? nxt.va10 : c10; pv.w = has_next ? nxt.va11 : c11; *(LAS u32x4*)(lds + VA_PARK_OFF + tid * 16) = pv; }
        for (int t = 0; t < nt; t += 2) {
            const bool last = (t == nt - 2);
            const unsigned a1 = cA + (unsigned)(t + 1) * kstep;
            const unsigned a2 = last ? nA : cA + (unsigned)(t + 2) * kstep, b2 = last ? nB : cB + (unsigned)(t + 2) * kstep;
            const unsigned a3 = a2 + kstep, b3 = b2 + kstep;
            unsigned s00 = c00, s01 = c01, s10 = c10, s11 = c11;
            if (last) { const u32x4 pv = *(const LAS u32x4*)(lds + VA_PARK_OFF + tid * 16); s00 = pv.x; s01 = pv.y; s10 = pv.z; s11 = pv.w; }
            PG8_LDB(B0, 0, 0); PG8_LDB(B1, 0, 1); PG8_SCHED; PG8_LDA(At, 0, 0); PG8_STA(PG8_SA(1, 1), a1, c10, c11);
            PG8_WAIT_V(8); PG8_WAIT_L(0); PG8_BAR; PG8_MMA(0, 0, At, B0); PG8_MMA(0, 1, At, B1); PG8_BAR; PG8_SCHED;
            PG8_LDA(At, 0, 1); PG8_STB(PG8_SB(0, 0), b2); PG8_STB(PG8_SB(0, 1), b2 + hstep); PG8_STA(PG8_SA(0, 0), a2, s00, s01);
            PG8_WAIT_V(8); PG8_WAIT_L(0); PG8_BAR; PG8_MMA(1, 0, At, B0); PG8_MMA(1, 1, At, B1); PG8_BAR; PG8_SCHED;
            PG8_LDB(B0, 1, 0); PG8_LDB(B1, 1, 1); PG8_SCHED; PG8_LDA(At, 1, 0); PG8_STA(PG8_SA(0, 1), a2, s10, s11);
            PG8_WAIT_V(8); PG8_WAIT_L(0); PG8_BAR; PG8_MMA(0, 0, At, B0); PG8_MMA(0, 1, At, B1); PG8_BAR; PG8_SCHED;
            PG8_LDA(At, 1, 1); PG8_STB(PG8_SB(1, 0), b3); PG8_STB(PG8_SB(1, 1), b3 + hstep); PG8_STA(PG8_SA(1, 0), a3, s00, s01);
            PG8_WAIT_V(8); PG8_WAIT_L(0); PG8_BAR; PG8_MMA(1, 0, At, B0); PG8_MMA(1, 1, At, B1); PG8_BAR; PG8_SCHED;
        }
        if constexpr (ALIGN_EPI) { if (wr == 0) PG8_BAR; }
        E(acc, cur, wr, wc, fr, fq);
        if (!has_next) break;
#pragma unroll
        for (int a = 0; a < 2; ++a)
#pragma unroll
            for (int b = 0; b < 2; ++b)
#pragma unroll
                for (int m = 0; m < 4; ++m)
#pragma unroll
                    for (int n = 0; n < 2; ++n) acc[a][b][m][n] = (f32x4){0.f, 0.f, 0.f, 0.f};
        cur = nxt; cA = nA; cB = nB; { const u32x4 pv = *(const LAS u32x4*)(lds + VA_PARK_OFF + tid * 16); c00 = pv.x; c01 = pv.y; c10 = pv.z; c11 = pv.w; } ++ui;
        if constexpr (ALIGN_EPI) { if (wr == 1) PG8_BAR; }
    }
    PG8_WAIT_V(0);
    if constexpr (!ALIGN_EPI) { if (wr == 0) PG8_BAR; }
    PG8_BAR;
#undef PG8_SA
#undef PG8_SB
#undef PG8_GLDS
#undef PG8_STB
#undef PG8_STA
#undef PG8_LDA
#undef PG8_LDB
#undef PG8_MMA
#undef PG8_WAIT_V
#undef PG8_WAIT_L
#undef PG8_BAR
#undef PG8_SCHED
}
}

#define XB_TMO      128
#define XB_XCNT(j)  (256  + 64 * (j))
#define XB_XSUB(j)  (1280 + 64 * (j))
#define XB_XGEN(j)  (2304 + 64 * (j))
#define XB_TOP      3328
#define XB_TOPGEN   3392
#define XCD_BAR_WORDS 3456
#define XB_SPIN_CAP (1u << 22)
__device__ __forceinline__ unsigned xb_ld(unsigned* p)              { return __hip_atomic_load(p, __ATOMIC_RELAXED, __HIP_MEMORY_SCOPE_AGENT); }
__device__ __forceinline__ unsigned xb_add(unsigned* p, unsigned v) { return __hip_atomic_fetch_add(p, v, __ATOMIC_RELAXED, __HIP_MEMORY_SCOPE_AGENT); }
__device__ __forceinline__ unsigned xb_xcc_id() { return (unsigned)__builtin_amdgcn_s_getreg((3 << 11) | 20) & 0xFu; }
#define XB_SPIN(cond, bar) do { unsigned _sp = 0; while (cond) { __builtin_amdgcn_s_sleep(1); \
    if ((++_sp & 255u) == 0u) { if (xb_ld(&(bar)[XB_TMO])) break; if (_sp > XB_SPIN_CAP) { atomicAdd(&(bar)[XB_TMO], 1u); break; } } } } while (0)
struct XcdBarrier { unsigned* bar; unsigned x; volatile LAS unsigned* st; };
__device__ __forceinline__ XcdBarrier xcd_barrier_post(unsigned* bar, volatile LAS unsigned* st) {
    XcdBarrier b; b.bar = bar; b.x = xb_xcc_id(); b.st = st;
    if (threadIdx.x == 0) (void)xb_add(&bar[XB_XCNT(b.x)], 1u);
    return b;
}
__device__ __forceinline__ void xcd_barrier_complete(unsigned* bar, unsigned x, unsigned& nloc, unsigned& nx) {
    const unsigned G = gridDim.x * gridDim.y * gridDim.z;
    unsigned sum, cnt, mine, sp = 0u;
    for (;;) {
        sum = 0u; cnt = 0u; mine = 0u;
#pragma unroll 1
        for (unsigned j = 0; j < 16; ++j) { const unsigned c = xb_ld(&bar[XB_XCNT(j)]); sum += c; cnt += (c > 0u) ? 1u : 0u; mine = (j == x) ? c : mine; }
        if (sum == G) break;
        __builtin_amdgcn_s_sleep(1);
        if ((++sp & 255u) == 0u) { if (xb_ld(&bar[XB_TMO])) break; if (sp > XB_SPIN_CAP) { atomicAdd(&bar[XB_TMO], 1u); break; } }
    }
    nloc = mine > 0u ? mine : 1u; nx = cnt > 0u ? cnt : 1u;
}
__device__ __forceinline__ void xcd_barrier(const XcdBarrier& b) {
    asm volatile("s_waitcnt vmcnt(0)" ::: "memory");
    __syncthreads();
    if (threadIdx.x == 0) {
        unsigned* bar = b.bar;
        __builtin_amdgcn_s_waitcnt(0);
        unsigned nloc = b.st[0], nx = b.st[1];
        if (nloc == 0u) { xcd_barrier_complete(bar, b.x, nloc, nx); b.st[0] = nloc; b.st[1] = nx; }
        const unsigned old = xb_add(&bar[XB_XSUB(b.x)], 1u);
        const unsigned gen = old / nloc;
        if (old + 1u == (gen + 1u) * nloc) {
            __builtin_amdgcn_fence(__ATOMIC_RELEASE, "agent");
            asm volatile("s_waitcnt vmcnt(0)" ::: "memory");
            const unsigned og = xb_add(&bar[XB_TOP], 1u);
            const unsigned tg = og / nx;
            if (og + 1u == (tg + 1u) * nx) xb_add(&bar[XB_TOPGEN], 1u);
            else XB_SPIN(xb_ld(&bar[XB_TOPGEN]) == tg, bar);
            __builtin_amdgcn_fence(__ATOMIC_ACQUIRE, "agent");
            xb_add(&bar[XB_XGEN(b.x)], 1u);
            asm volatile("s_waitcnt vmcnt(0)" ::: "memory");
        } else {
            XB_SPIN(xb_ld(&bar[XB_XGEN(b.x)]) == gen, bar);
            __builtin_amdgcn_fence(__ATOMIC_ACQUIRE, "agent");
            asm volatile("s_waitcnt vmcnt(0)" ::: "memory");
        }
    }
    __syncthreads();
}

struct Args { const float* in[31]; float* out; unsigned char* ws; int ph_lo, ph_hi; };

struct Frame {
    LAS unsigned char* lds;
    int tid, lane, wave, G, bid;
    unsigned char* ws;
};
constexpr int PTAB_OFF = MISC_OFF + 3072;
struct InTab { LAS unsigned char* lds;
    __device__ __forceinline__ const float* operator[](int k) const {
        const LAS unsigned* p = (const LAS unsigned*)(lds + PTAB_OFF) + 2 * k;
        const unsigned lo = __builtin_amdgcn_readfirstlane(p[0]), hi = __builtin_amdgcn_readfirstlane(p[1]);
        return (const float*)(((unsigned long long)hi << 32) | lo); } };
struct ArgsV { InTab in; };
__device__ __forceinline__ Frame make_frame(LAS unsigned char* lds, unsigned char* ws) {
    Frame F; F.lds = lds;
    int tid = threadIdx.x; asm volatile("" : "+v"(tid));
    F.tid = tid; F.lane = tid & 63; F.wave = __builtin_amdgcn_readfirstlane(tid >> 6);
    F.G = gridDim.x; F.bid = blockIdx.x;
    unsigned long long w = (unsigned long long)ws; asm volatile("" : "+s"(w)); F.ws = (unsigned char*)w;
    return F;
}

__device__ __forceinline__ void transpose_item(const float* W, int N, bf16_t* WT, int k0, int n0, int drow0, LAS float* scr, int lane) {
    f32x4 v[16];
    const int lr = lane >> 4, lc = (lane & 15) * 4;
#pragma unroll
    for (int i = 0; i < 16; ++i) v[i] = __builtin_nontemporal_load((const f32x4*)(W + (size_t)(k0 + 4 * i + lr) * N + n0 + lc));
#pragma unroll
    for (int i = 0; i < 16; ++i) { LAS float* s = scr + (4 * i + lr) * 65 + lc; s[0] = v[i].x; s[1] = v[i].y; s[2] = v[i].z; s[3] = v[i].w; }
    LDS_WAIT(); asm volatile("" ::: "memory");
    const int c = lane & 7;
#pragma unroll
    for (int j = 0; j < 8; ++j) { const int n = (lane >> 3) + 8 * j; const LAS float* s = scr + (8 * c) * 65 + n;
        u32x4 o; o.x = pk2(s[0 * 65], s[1 * 65]); o.y = pk2(s[2 * 65], s[3 * 65]); o.z = pk2(s[4 * 65], s[5 * 65]); o.w = pk2(s[6 * 65], s[7 * 65]);
        *(u32x4*)(WT + (size_t)(drow0 + n) * KD + k0 + 8 * c) = o; }
    LDS_WAIT(); asm volatile("" ::: "memory");
}
__device__ __forceinline__ void ln_store(f32x4 (&v)[4], const float* g, const float* b, float* of32, bf16_t* obf, int lane) {
    float s = 0.f;
#pragma unroll
    for (int j = 0; j < 4; ++j) s += (v[j].x + v[j].y) + (v[j].z + v[j].w);
    const float mean = wave_sum(s) * (1.f / D); float s2 = 0.f;
#pragma unroll
    for (int j = 0; j < 4; ++j) { v[j] = v[j] - mean; s2 += (v[j].x * v[j].x + v[j].y * v[j].y) + (v[j].z * v[j].z + v[j].w * v[j].w); }
    const float rstd = __builtin_amdgcn_rsqf(wave_sum(s2) * (1.f / D) + LN_EPS);
#pragma unroll
    for (int j = 0; j < 4; ++j) {
        const f32x4 gv = *(const f32x4*)(g + 4 * lane + 256 * j), bv = *(const f32x4*)(b + 4 * lane + 256 * j);
        const f32x4 o = v[j] * rstd * gv + bv;
        if (of32) *(f32x4*)(of32 + 4 * lane + 256 * j) = o;
        if (obf) { u32x2 w; w.x = pk2(o.x, o.y); w.y = pk2(o.z, o.w); *(u32x2*)(obf + 4 * lane + 256 * j) = w; }
    }
}

__device__ __forceinline__ void phase_prologue(Frame& F, const ArgsV& A_) {
    LAS float* scr = (LAS float*)(F.lds + F.wave * 16640);
    const int gw = F.bid * NWAVES + F.wave, NGW = F.G * NWAVES;
    bf16_t* WINT = (bf16_t*)(F.ws + WS_WINT); bf16_t* WOUTT = (bf16_t*)(F.ws + WS_WOUTT); bf16_t* W1T = (bf16_t*)(F.ws + WS_W1T); bf16_t* W2T = (bf16_t*)(F.ws + WS_W2T);
    constexpr int I_IN = NL * 16 * 40, I_OUT = NL * 16 * 16, I_W1 = NL * NE * 16 * 32, I_W2 = NL * NE * 16 * 16;
    const float* w_in = A_.in[3]; const float* w_out = A_.in[20]; const float* w1 = A_.in[25]; const float* w2 = A_.in[27];
    for (int it = gw; it < I_IN + I_OUT + I_W1 + I_W2; it += NGW) {
        int r = it;
        if (r < I_W1) { const int le = r / (16 * 32), q = r % (16 * 32), kb = q / 32, nb = q % 32, n0 = nb * 64;
            const int drow = (n0 < 1024) ? ((n0 >> 7) * 256 + (n0 & 127)) : (((n0 - 1024) >> 7) * 256 + 128 + ((n0 - 1024) & 127));
            transpose_item(w1 + (size_t)le * 1024 * 2048, 2048, W1T + (size_t)le * 2048 * 1024, kb * 64, n0, drow, scr, F.lane); continue; }
        r -= I_W1;
        if (r < I_W2) { const int le = r / (16 * 16), q = r % (16 * 16), kb = q / 16, nb = q % 16;
            transpose_item(w2 + (size_t)le * 1024 * 1024, 1024, W2T + (size_t)le * 1024 * 1024, kb * 64, nb * 64, nb * 64, scr, F.lane); continue; }
        r -= I_W2;
        if (r < I_IN) { const int l = r / (16 * 40), q = r % (16 * 40), kb = q / 40, nb = q % 40, n0 = nb * 64;
            const int drow = (n0 < 1024) ? n0 : ((n0 < 1536) ? (2048 + n0 - 1024) : (n0 - 512));
            transpose_item(w_in + (size_t)l * 1024 * 2560, 2560, WINT + (size_t)l * 2560 * 1024, kb * 64, n0, drow, scr, F.lane); continue; }
        r -= I_IN;
        { const int l = r / (16 * 16), q = r % (16 * 16), kb = q / 16, nb = q % 16;
            transpose_item(w_out + (size_t)l * 1024 * 1024, 1024, WOUTT + (size_t)l * 1024 * 1024, kb * 64, nb * 64, nb * 64, scr, F.lane); }
    }
    float* HA = (float*)(F.ws + WS_HA); bf16_t* XB = (bf16_t*)(F.ws + WS_XB);
    for (int m = gw; m < T; m += NGW) {
        f32x4 v[4];
#pragma unroll
        for (int j = 0; j < 4; ++j) v[j] = *(const f32x4*)(A_.in[0] + (size_t)m * D + 4 * F.lane + 256 * j);
        ln_store(v, A_.in[1], A_.in[2], HA + (size_t)m * D, XB + (size_t)m * D, F.lane);
    }
}

constexpr int P2_KP = 110592;
constexpr int P2_ORD = 118784;
constexpr int P2_FLG = 119808;
constexpr int CW_QUEUE = 20480;
constexpr size_t WS_KN = 768 * MiB + 512 * 1024;

namespace attn {
__device__ __forceinline__ int crow(int r, int hi) { return (r & 3) + 8 * (r >> 2) + 4 * hi; }
__device__ __forceinline__ int swz(int row, int chunk) { return row * 128 + ((chunk ^ ((row >> 1) & 7)) << 4); }
#define MFMA32(a, b, c) __builtin_amdgcn_mfma_f32_32x32x16_bf16(a, b, c, 0, 0, 0)

__device__ __forceinline__ void attn_unit(LAS unsigned char* lds, const bf16_t* U, const bf16_t* VT, bf16_t* MIX, const float* subg, float lam, float outscale, int h, int qb, const int tid) {
    const int w = __builtin_amdgcn_readfirstlane(tid >> 6), lane = tid & 63, ln = lane & 31, hi = lane >> 5;
    const int c = w >> 2, rg = w & 3;
    const int i0 = qb * 128, rowmin = i0 + 32 * rg;
    const float slope2 = __builtin_amdgcn_exp2f(-2.0f * (float)(h + 1)) * LOG2E;
    const LAS float* kp = (const LAS float*)(lds + P2_KP) + (h * 2 + c) * 256;
    volatile LAS unsigned* flg = (volatile LAS unsigned*)(lds + P2_FLG);
    bf16x8 Qf[4];
    { const bf16_t* qp = U + (size_t)(rowmin + ln) * NCOLA + UQ + h * 128 + c * 64 + 8 * hi;
#pragma unroll
      for (int ks = 0; ks < 4; ++ks) Qf[ks] = *(const bf16x8*)(qp + 16 * ks); }
    float qn;
    { float ss = 0.f;
#pragma unroll
      for (int ks = 0; ks < 4; ++ks)
#pragma unroll
          for (int j = 0; j < 8; ++j) { const float v = bf2f((bf16_t)Qf[ks][j]); ss += v * v; }
      ss += __shfl_xor(ss, 32); qn = fsqrt(ss) * 1.001f; }
    const int kkey = tid >> 4, kcc = tid & 15, vdv = tid >> 3, vch = tid & 7;
    const bf16_t* kg = U + (size_t)kkey * NCOLA + UK + h * 128 + kcc * 8;
    const bf16_t* vg = VT + (size_t)(h * 128 + vdv) * T + vch * 8;
    const int klds0 = (kcc >> 3) * 8192 + swz(kkey, kcc & 7), klds1 = (kcc >> 3) * 8192 + swz(kkey + 32, kcc & 7);
    const int vlds0 = 16384 + swz(vdv, vch), vlds1 = 16384 + swz(vdv + 64, vch);
    f32x16 O[4];
#pragma unroll
    for (int db = 0; db < 4; ++db)
#pragma unroll
        for (int r = 0; r < 16; ++r) O[db][r] = 0.f;
    float m = -__builtin_inff(), lsum = 0.f;
    const int jt_hi = 2 * qb + 1;
    u32x4 pk0, pk1, pv0, pv1;
    { const size_t j0 = (size_t)jt_hi * 64;
      pk0 = *(const u32x4*)(kg + j0 * NCOLA); pk1 = *(const u32x4*)(kg + (j0 + 32) * NCOLA); pv0 = *(const u32x4*)(vg + j0); pv1 = *(const u32x4*)(vg + j0 + (size_t)64 * T);
      *(LAS u32x4*)(lds + klds0) = pk0; *(LAS u32x4*)(lds + klds1) = pk1; *(LAS u32x4*)(lds + vlds0) = pv0; *(LAS u32x4*)(lds + vlds1) = pv1; }
    __syncthreads();
    bool done = false;
    for (int jt = jt_hi; jt >= 0; --jt) {
        const int cur = (jt_hi - jt) & 1;
        LAS unsigned char* buf = lds + cur * 32768;
        LAS unsigned char* nbuf = lds + (cur ^ 1) * 32768;
        if (jt > 0) { const size_t j0 = (size_t)(jt - 1) * 64;
            pk0 = *(const u32x4*)(kg + j0 * NCOLA); pk1 = *(const u32x4*)(kg + (j0 + 32) * NCOLA); pv0 = *(const u32x4*)(vg + j0); pv1 = *(const u32x4*)(vg + j0 + (size_t)64 * T); }
        const int j0 = jt * 64;
        if (!done && j0 <= rowmin + 31) {
            const float bnd = qn * kp[jt] - m + slope2 * (float)(j0 + 63 - i0);
            if (__all(bnd < -48.0f)) done = true;
        }
        if (!done && j0 <= rowmin + 31) {
            f32x16 s0, s1;
            { const float b0 = slope2 * (float)(j0 + 4 * hi - i0);
#pragma unroll
              for (int r = 0; r < 16; ++r) { s0[r] = b0 + slope2 * (float)((r & 3) + 8 * (r >> 2)); s1[r] = s0[r] + slope2 * 32.0f; } }
#pragma unroll
            for (int ks = 0; ks < 4; ++ks) {
                const bf16x8 k0 = *(const LAS bf16x8*)(buf + c * 8192 + swz(ln, 2 * ks + hi));
                const bf16x8 k1 = *(const LAS bf16x8*)(buf + c * 8192 + swz(ln + 32, 2 * ks + hi));
                s0 = MFMA32(k0, Qf[ks], s0); s1 = MFMA32(k1, Qf[ks], s1);
            }
            if (j0 + 63 > rowmin) {
                const int qrow = rowmin + ln;
#pragma unroll
                for (int r = 0; r < 16; ++r) { const int key = j0 + crow(r, hi); if (key > qrow) s0[r] = -__builtin_inff(); if (key + 32 > qrow) s1[r] = -__builtin_inff(); }
            }
            float mx = fmaxf(s0[0], s1[0]);
#pragma unroll
            for (int r = 1; r < 16; ++r) mx = fmaxf(mx, fmaxf(s0[r], s1[r]));
            mx = fmaxf(mx, __shfl_xor(mx, 32));
            if (__any(mx > m)) {
                const float mn = fmaxf(m, mx), al = __builtin_amdgcn_exp2f(m - mn);
#pragma unroll
                for (int db = 0; db < 4; ++db)
#pragma unroll
                    for (int r = 0; r < 16; ++r) O[db][r] *= al;
                lsum *= al; m = mn;
            }
#pragma unroll
            for (int r = 0; r < 16; ++r) { s0[r] = __builtin_amdgcn_exp2f(s0[r] - m); s1[r] = __builtin_amdgcn_exp2f(s1[r] - m); lsum += s0[r] + s1[r]; }
            bf16x8 Pf[4];
#pragma unroll
            for (int s2 = 0; s2 < 2; ++s2) {
                u32x4 a, b;
                a.x = cvt_pk_bf16(s0[8 * s2 + 0], s0[8 * s2 + 1]); a.y = cvt_pk_bf16(s0[8 * s2 + 2], s0[8 * s2 + 3]); a.z = cvt_pk_bf16(s0[8 * s2 + 4], s0[8 * s2 + 5]); a.w = cvt_pk_bf16(s0[8 * s2 + 6], s0[8 * s2 + 7]);
                b.x = cvt_pk_bf16(s1[8 * s2 + 0], s1[8 * s2 + 1]); b.y = cvt_pk_bf16(s1[8 * s2 + 2], s1[8 * s2 + 3]); b.z = cvt_pk_bf16(s1[8 * s2 + 4], s1[8 * s2 + 5]); b.w = cvt_pk_bf16(s1[8 * s2 + 6], s1[8 * s2 + 7]);
                Pf[s2] = __builtin_bit_cast(bf16x8, a); Pf[2 + s2] = __builtin_bit_cast(bf16x8, b);
            }
#pragma unroll
            for (int db = 0; db < 4; ++db)
#pragma unroll
                for (int g = 0; g < 4; ++g) {
                    const bf16x8 vf = *(const LAS bf16x8*)(buf + 16384 + swz(32 * db + ln, 2 * g + hi));
                    O[db] = MFMA32(vf, Pf[g], O[db]);
                }
        }
        if (jt > 0) { *(LAS u32x4*)(nbuf + klds0) = pk0; *(LAS u32x4*)(nbuf + klds1) = pk1; *(LAS u32x4*)(nbuf + vlds0) = pv0; *(LAS u32x4*)(nbuf + vlds1) = pv1; }
        if (lane == 0) flg[cur * 8 + w] = done ? 1u : 0u;
        __syncthreads();
        { const u32x4 f0 = *(const LAS u32x4*)(lds + P2_FLG + cur * 32), f1 = *(const LAS u32x4*)(lds + P2_FLG + cur * 32 + 16);
          if ((f0.x & f0.y & f0.z & f0.w & f1.x & f1.y & f1.z & f1.w) != 0u) break; }
    }
    const float ltot = lsum + __shfl_xor(lsum, 32);
    LAS float* ex = (LAS float*)lds;
    if (c == 1) {
        const float sc = lam / ltot;
#pragma unroll
        for (int db = 0; db < 4; ++db)
#pragma unroll
            for (int r = 0; r < 16; ++r) ex[(rg * 64 + db * 16 + r) * 64 + lane] = O[db][r] * sc;
    }
    __syncthreads();
    if (c == 0) {
        const float inv = 1.0f / ltot; float ss = 0.f;
#pragma unroll
        for (int db = 0; db < 4; ++db)
#pragma unroll
            for (int r = 0; r < 16; ++r) { const float o = O[db][r] * inv - ex[(rg * 64 + db * 16 + r) * 64 + lane]; O[db][r] = o; ss += o * o; }
        ss += __shfl_xor(ss, 32);
        const float rn = __builtin_amdgcn_rsqf(ss * (1.0f / 128.0f) + LN_EPS) * outscale;
        bf16_t* op = MIX + (size_t)(rowmin + ln) * 1024 + h * 128 + 4 * hi;
#pragma unroll
        for (int db = 0; db < 4; ++db)
#pragma unroll
            for (int g = 0; g < 4; ++g) { const int dv0 = 32 * db + 8 * g;
                const f32x4 gv = *(const f32x4*)(subg + dv0 + 4 * hi);
                u32x2 wv; wv.x = cvt_pk_bf16(O[db][4 * g + 0] * rn * gv.x, O[db][4 * g + 1] * rn * gv.y); wv.y = cvt_pk_bf16(O[db][4 * g + 2] * rn * gv.z, O[db][4 * g + 3] * rn * gv.w);
                *(u32x2*)(op + dv0) = wv; }
    }
    __syncthreads();
}
#undef MFMA32
}

__device__ __forceinline__ void phase_knorm(Frame& F) {
    const bf16_t* U = (const bf16_t*)(F.ws + WS_U); float* KN = (float*)(F.ws + WS_KN);
    const int gw = F.bid * NWAVES + F.wave, NGW = F.G * NWAVES;
    for (int item = gw; item < 2048; item += NGW) {
        const int hc = item >> 8, jt = item & 255;
        const bf16_t* kr = U + (size_t)(jt * 64 + F.lane) * NCOLA + UK + hc * 64;
        float ss = 0.f;
#pragma unroll
        for (int q = 0; q < 8; ++q) { const u32x4 v = *(const u32x4*)(kr + 8 * q);
            ss += bflo(v.x) * bflo(v.x) + bfhi(v.x) * bfhi(v.x) + bflo(v.y) * bflo(v.y) + bfhi(v.y) * bfhi(v.y) + bflo(v.z) * bflo(v.z) + bfhi(v.z) * bfhi(v.z) + bflo(v.w) * bflo(v.w) + bfhi(v.w) * bfhi(v.w); }
#pragma unroll
        for (int o = 1; o < 64; o <<= 1) ss = fmaxf(ss, __shfl_xor(ss, o));
        if (F.lane == 0) KN[item] = ss;
    }
}

__device__ __forceinline__ void lru_unit(Frame& F, const ArgsV& A_, int l, int unit) {
    const bf16_t* U = (const bf16_t*)(F.ws + WS_U);
    float* HLOC = (float*)(F.ws + WS_HLOC); float* CUMA = (float*)(F.ws + WS_CUMA); float* AGG = (float*)(F.ws + WS_AGG);
    const float* cw = A_.in[9] + l * 4 * 256; const float* cb = A_.in[10] + l * 256;
    const float* wa = A_.in[11] + l * 4 * 4096; const float* ba = A_.in[12] + l * 256;
    const float* wx = A_.in[13] + l * 4 * 4096; const float* bx = A_.in[14] + l * 256; const float* lamp = A_.in[15] + l * 256;
    LAS float* wA = (LAS float*)F.lds; LAS float* wX = wA + 4096; LAS float* xc = wA + 8192; LAS float* wagg = wA + 8192 + 16384;
    const int w = F.wave, d = F.lane;
    const int chunk = unit >> 2, blk = unit & 3, t0 = chunk * 256, ch0 = blk * 64;
    for (int i = F.tid; i < 1024; i += NTHREADS) { *(LAS f32x4*)(wA + 4 * i) = *(const f32x4*)(wa + blk * 4096 + 4 * i); *(LAS f32x4*)(wX + 4 * i) = *(const f32x4*)(wx + blk * 4096 + 4 * i); }
    {
      const int g8 = F.tid & 7, chb = ch0 + 8 * g8;
      f32x4 wv[4][2], bv[2];
#pragma unroll
      for (int j = 0; j < 4; ++j) { wv[j][0] = *(const f32x4*)(cw + j * 256 + chb); wv[j][1] = *(const f32x4*)(cw + j * 256 + chb + 4); }
      bv[0] = *(const f32x4*)(cb + chb); bv[1] = *(const f32x4*)(cb + chb + 4);
#pragma unroll
      for (int k = 0; k < 4; ++k) { const int t = (F.tid >> 3) + 64 * k, tt = t0 + t;
          f32x4 a0 = bv[0], a1 = bv[1];
#pragma unroll
          for (int j = 0; j < 4; ++j) { const int ts = tt - 3 + j;
              if (ts >= 0) { const u32x4 x = *(const u32x4*)(U + (size_t)ts * NCOLA + ULX + chb);
                  a0.x += wv[j][0].x * bflo(x.x); a0.y += wv[j][0].y * bfhi(x.x); a0.z += wv[j][0].z * bflo(x.y); a0.w += wv[j][0].w * bfhi(x.y);
                  a1.x += wv[j][1].x * bflo(x.z); a1.y += wv[j][1].y * bfhi(x.z); a1.z += wv[j][1].z * bflo(x.w); a1.w += wv[j][1].w * bfhi(x.w); } }
          *(LAS f32x4*)(xc + t * 64 + 8 * g8) = a0; *(LAS f32x4*)(xc + t * 64 + 8 * g8 + 4) = a1; } }
    __syncthreads();
    float ga[32], gx[32];
#pragma unroll
    for (int tt = 0; tt < 32; ++tt) { ga[tt] = 0.f; gx[tt] = 0.f; }
    for (int c4 = 0; c4 < 16; ++c4) {
        const float wa0 = wA[(4 * c4 + 0) * 64 + d], wa1 = wA[(4 * c4 + 1) * 64 + d], wa2 = wA[(4 * c4 + 2) * 64 + d], wa3 = wA[(4 * c4 + 3) * 64 + d];
        const float wx0 = wX[(4 * c4 + 0) * 64 + d], wx1 = wX[(4 * c4 + 1) * 64 + d], wx2 = wX[(4 * c4 + 2) * 64 + d], wx3 = wX[(4 * c4 + 3) * 64 + d];
#pragma unroll
        for (int tt = 0; tt < 32; ++tt) { const f32x4 x = *(const LAS f32x4*)(xc + (32 * w + tt) * 64 + 4 * c4);
            ga[tt] += x.x * wa0 + x.y * wa1 + x.z * wa2 + x.w * wa3; gx[tt] += x.x * wx0 + x.y * wx1 + x.z * wx2 + x.w * wx3; } }
    const int ch = ch0 + d; const float bav = ba[ch], bxv = bx[ch];
    const float sp = flog(1.0f + fexp(-lamp[ch]));
    float hl = 0.f, ca = 1.f;
#pragma unroll
    for (int tt = 0; tt < 32; ++tt) {
        const float sa = sigmoidf_(ga[tt] + bav), sx = sigmoidf_(gx[tt] + bxv);
        const float log_a = -8.0f * sa * sp, a = fexp(log_a), mult = fsqrt(fmaxf(1.0f - a * a, 0.f));
        const float b = mult * sx * xc[(32 * w + tt) * 64 + d];
        hl = a * hl + b; ca *= a; ga[tt] = hl; gx[tt] = ca;
    }
    wagg[(w * 2 + 0) * 64 + d] = ca; wagg[(w * 2 + 1) * 64 + d] = hl;
    __syncthreads();
    float cin = 0.f, cprod = 1.f;
    for (int w2 = 0; w2 < w; ++w2) { const float A2 = wagg[(w2 * 2 + 0) * 64 + d], B2 = wagg[(w2 * 2 + 1) * 64 + d]; cin = A2 * cin + B2; cprod *= A2; }
#pragma unroll
    for (int tt = 0; tt < 32; ++tt) { const size_t o = (size_t)(t0 + 32 * w + tt) * 256 + ch; const float hh = ga[tt] + gx[tt] * cin, cA = gx[tt] * cprod; HLOC[o] = hh; CUMA[o] = cA;
        if (w == 7 && tt == 31) { AGG[(chunk * 2 + 0) * 256 + ch] = cA; AGG[(chunk * 2 + 1) * 256 + ch] = hh; } }
    __syncthreads();
}

__device__ __forceinline__ void conf_unit(Frame& F, const ArgsV& A_, int l, int unit) {
    const bf16_t* U = (const bf16_t*)(F.ws + WS_U); bf16_t* MIX = (bf16_t*)(F.ws + WS_MIX);
    const float* cw = A_.in[16] + l * 31 * 256; const float* cb = A_.in[17] + l * 256; const float* lg = A_.in[18] + l * 256; const float* lb = A_.in[19] + l * 256;
    LAS float* gin = (LAS float*)F.lds; LAS float* cout = gin + 62 * 256;
    const int ch = F.tid & 255, half = F.tid >> 8, t0 = unit * 32;
    for (int it = F.tid; it < 62 * 32; it += NTHREADS) { const int r = it >> 5, g8 = it & 31, ts = t0 - 30 + r;
        f32x4 v0 = (f32x4){0.f, 0.f, 0.f, 0.f}, v1 = v0;
        if (ts >= 0) { const u32x4 a = *(const u32x4*)(U + (size_t)ts * NCOLA + UCA + 8 * g8), b = *(const u32x4*)(U + (size_t)ts * NCOLA + UCB + 8 * g8);
            v0.x = bflo(a.x) * sigmoidf_(bflo(b.x)); v0.y = bfhi(a.x) * sigmoidf_(bfhi(b.x)); v0.z = bflo(a.y) * sigmoidf_(bflo(b.y)); v0.w = bfhi(a.y) * sigmoidf_(bfhi(b.y));
            v1.x = bflo(a.z) * sigmoidf_(bflo(b.z)); v1.y = bfhi(a.z) * sigmoidf_(bfhi(b.z)); v1.z = bflo(a.w) * sigmoidf_(bflo(b.w)); v1.w = bfhi(a.w) * sigmoidf_(bfhi(b.w)); }
        *(LAS f32x4*)(gin + r * 256 + 8 * g8) = v0; *(LAS f32x4*)(gin + r * 256 + 8 * g8 + 4) = v1; }
    float wreg[31];
#pragma unroll
    for (int j = 0; j < 31; ++j) wreg[j] = cw[j * 256 + ch];
    const float bb = cb[ch];
    __syncthreads();
    { float x[46];
#pragma unroll
      for (int k = 0; k < 46; ++k) x[k] = gin[(half * 16 + k) * 256 + ch];
#pragma unroll
      for (int tt = 0; tt < 16; ++tt) { float a = bb;
#pragma unroll
          for (int j = 0; j < 31; ++j) a += wreg[j] * x[tt + j];
          cout[(half * 16 + tt) * 256 + ch] = a; } }
    __syncthreads();
#pragma unroll
    for (int q = 0; q < 4; ++q) { const int t = 4 * F.wave + q;
        f32x4 v = *(const LAS f32x4*)(cout + t * 256 + 4 * F.lane);
        const float mean = wave_sum((v.x + v.y) + (v.z + v.w)) * (1.f / 256.f); v = v - mean;
        const float var = wave_sum((v.x * v.x + v.y * v.y) + (v.z * v.z + v.w * v.w)) * (1.f / 256.f), rstd = __builtin_amdgcn_rsqf(var + LN_EPS);
        const f32x4 gv = *(const f32x4*)(lg + 4 * F.lane), bv = *(const f32x4*)(lb + 4 * F.lane);
        f32x4 y = v * rstd * gv + bv;
        y.x = y.x * sigmoidf_(y.x); y.y = y.y * sigmoidf_(y.y); y.z = y.z * sigmoidf_(y.z); y.w = y.w * sigmoidf_(y.w);
        u32x2 wv; wv.x = pk2(y.x, y.y); wv.y = pk2(y.z, y.w);
        *(u32x2*)(MIX + (size_t)(t0 + t) * 1024 + 768 + 4 * F.lane) = wv; }
    __syncthreads();
}

__device__ __forceinline__ void phase_mixers(Frame& F, const ArgsV& A_, int l) {
    const bf16_t* U = (const bf16_t*)(F.ws + WS_U); const bf16_t* VT = (const bf16_t*)(F.ws + WS_VT); bf16_t* MIX = (bf16_t*)(F.ws + WS_MIX);
    { const float* KN = (const float*)(F.ws + WS_KN); LAS float* kp = (LAS float*)(F.lds + P2_KP);
      const int tb = F.wave, ln = F.lane;
      const f32x4 v = *(const f32x4*)(KN + tb * 256 + 4 * ln);
      const float p0 = v.x, p1 = fmaxf(p0, v.y), p2 = fmaxf(p1, v.z), p3 = fmaxf(p2, v.w);
      float run = p3;
#pragma unroll
      for (int o = 1; o < 64; o <<= 1) { const float t = __shfl_up(run, o); if (ln >= o) run = fmaxf(run, t); }
      float ex = __shfl_up(run, 1); if (ln == 0) ex = 0.f;
      f32x4 o4; o4.x = fsqrt(fmaxf(ex, p0)); o4.y = fsqrt(fmaxf(ex, p1)); o4.z = fsqrt(fmaxf(ex, p2)); o4.w = fsqrt(fmaxf(ex, p3));
      *(LAS f32x4*)(kp + tb * 256 + 4 * ln) = o4;
      LAS unsigned short* ord = (LAS unsigned short*)(F.lds + P2_ORD);
      const int u = F.tid, uq = u >> 2, uh = u & 3;
      const int West = (uh == 0) ? 6 : ((uh == 1) ? 14 : ((uh == 2) ? 46 : 176));
      const int mycost = min(2 * uq + 2, West);
      int rank = 0;
      for (int v2 = 0; v2 < 512; ++v2) { const int vq = v2 >> 2, vh = v2 & 3; const int Wv = (vh == 0) ? 6 : ((vh == 1) ? 14 : ((vh == 2) ? 46 : 176)); const int cv = min(2 * vq + 2, Wv);
          rank += (cv > mycost || (cv == mycost && v2 < u)) ? 1 : 0; }
      ord[rank] = (unsigned short)u;
    }
    float d1 = 0.f, d2 = 0.f;
    { const float* lq1 = A_.in[4] + l * 64; const float* lk1 = A_.in[5] + l * 64; const float* lq2 = A_.in[6] + l * 64; const float* lk2 = A_.in[7] + l * 64;
      d1 = wave_sum(lq1[F.lane] * lk1[F.lane]); d2 = wave_sum(lq2[F.lane] * lk2[F.lane]); }
    const float lam_init = 0.8f - 0.6f * fexp(-0.3f * (float)l);
    const float lam = fexp(d1) - fexp(d2) + lam_init;
    const float* subg = A_.in[8] + l * 128;
    unsigned* qhead = (unsigned*)(F.ws + WS_CTL) + CW_QUEUE + 64 * l;
    volatile LAS unsigned* slot = (volatile LAS unsigned*)(F.lds + P2_FLG) + 16;
    __syncthreads();
    for (;;) {
        if (F.tid == 0) slot[0] = atomicAdd(qhead, 1u);
        __syncthreads();
        const int q = (int)__builtin_amdgcn_readfirstlane(slot[0]);
        __syncthreads();
        if (q >= 512 + 256 + 512) break;
        if (q < 512) { const int u = ((const LAS unsigned short*)(F.lds + P2_ORD))[q]; attn::attn_unit(F.lds, U, VT, MIX, subg, lam, 1.0f - lam_init, u & 3, u >> 2, F.tid); }
        else if (q < 768) lru_unit(F, A_, l, q - 512);
        else conf_unit(F, A_, l, q - 768);
    }
}

__device__ __forceinline__ void phase_lru_fix(Frame& F, const ArgsV& A_, int l) {
    const bf16_t* U = (const bf16_t*)(F.ws + WS_U); bf16_t* MIX = (bf16_t*)(F.ws + WS_MIX);
    const float* HLOC = (const float*)(F.ws + WS_HLOC); const float* CUMA = (const float*)(F.ws + WS_CUMA); const float* AGG = (const float*)(F.ws + WS_AGG);
    LAS float* ag = (LAS float*)F.lds;
    const int ch = F.tid & 255, half = F.tid >> 8;
    for (int unit = F.bid; unit < 256; unit += F.G) {
        const int chunk = unit >> 2, qt = unit & 3, t0 = chunk * 256 + qt * 64 + half * 32;
        for (int i = F.tid; i < chunk * 128; i += NTHREADS) *(LAS f32x4*)(ag + 4 * i) = *(const f32x4*)(AGG + 4 * i);
        __syncthreads();
        float cin = 0.f;
        for (int k = 0; k < chunk; ++k) cin = ag[(k * 2 + 0) * 256 + ch] * cin + ag[(k * 2 + 1) * 256 + ch];
        for (int t = 0; t < 32; ++t) { const size_t tt = (size_t)(t0 + t);
            const float hh = HLOC[tt * 256 + ch] + CUMA[tt * 256 + ch] * cin;
            const float y = bf2f(U[tt * NCOLA + ULY + ch]);
            const float gl = y * frcp(1.0f + fexp(-2.0f * 0.7978845608028654f * (y + 0.044715f * y * y * y)));
            MIX[tt * 1024 + 512 + ch] = (bf16_t)f2bf(hh * gl); }
        __syncthreads();
    }
}

__device__ __forceinline__ void phase_ln1(Frame& F, const ArgsV& A_, int l) {
    const float* HA = (const float*)(F.ws + WS_HA); const float* MO = (const float*)(F.ws + WS_MIXO); float* HB = (float*)(F.ws + WS_HB); bf16_t* XB = (bf16_t*)(F.ws + WS_XB);
    const int gw = F.bid * NWAVES + F.wave, NGW = F.G * NWAVES;
    for (int m = gw; m < T; m += NGW) {
        f32x4 v[4];
#pragma unroll
        for (int j = 0; j < 4; ++j) v[j] = *(const f32x4*)(HA + (size_t)m * D + 4 * F.lane + 256 * j) * ALPHA + *(const f32x4*)(MO + (size_t)m * D + 4 * F.lane + 256 * j);
        ln_store(v, A_.in[21] + l * D, A_.in[22] + l * D, HB + (size_t)m * D, XB + (size_t)m * D, F.lane);
    }
}

__device__ __forceinline__ void phase_router(Frame& F, const ArgsV& A_, int l) {
    const float* HB = (const float*)(F.ws + WS_HB); const float* rw = A_.in[23] + (size_t)l * 1024 * 32; const float* rb = A_.in[24] + l * 32;
    int* TKS = (int*)(F.ws + WS_TKS); float* TKG = (float*)(F.ws + WS_TKG); int* LIST = (int*)(F.ws + WS_LIST);
    unsigned* gcnt = (unsigned*)(F.ws + WS_CTL) + CW_CNT + l * 64;
    LAS float* part = (LAS float*)F.lds;
    LAS float* lg = (LAS float*)(F.lds + 65536);
    LAS unsigned* lcnt = (LAS unsigned*)(F.lds + 81920);
    const int ln = F.lane & 31, hf = F.lane >> 5, kb = F.wave * 128;
    float rwv[16][4];
#pragma unroll
    for (int i = 0; i < 16; ++i)
#pragma unroll
        for (int s = 0; s < 4; ++s) rwv[i][s] = rw[(size_t)(kb + 8 * i + 4 * hf + s) * 32 + ln];
    for (int base = F.bid * 64; base < T; base += F.G * 64) {
        if (F.tid < 64) lcnt[F.tid] = 0u;
#pragma unroll
        for (int g = 0; g < 2; ++g) {
            f32x4 hv[16];
            const float* hp = HB + (size_t)(base + 32 * g + ln) * D + kb + 4 * hf;
#pragma unroll
            for (int i = 0; i < 16; ++i) hv[i] = *(const f32x4*)(hp + 8 * i);
            f32x16 acc;
#pragma unroll
            for (int r = 0; r < 16; ++r) acc[r] = 0.f;
#pragma unroll
            for (int i = 0; i < 16; ++i) {
                acc = __builtin_amdgcn_mfma_f32_32x32x2f32(rwv[i][0], hv[i].x, acc, 0, 0, 0);
                acc = __builtin_amdgcn_mfma_f32_32x32x2f32(rwv[i][1], hv[i].y, acc, 0, 0, 0);
                acc = __builtin_amdgcn_mfma_f32_32x32x2f32(rwv[i][2], hv[i].z, acc, 0, 0, 0);
                acc = __builtin_amdgcn_mfma_f32_32x32x2f32(rwv[i][3], hv[i].w, acc, 0, 0, 0);
            }
#pragma unroll
            for (int r = 0; r < 16; ++r) { const int e = (r & 3) + 8 * (r >> 2) + 4 * hf; part[((F.wave * 2 + g) * 32 + e) * 32 + ln] = acc[r]; }
        }
        __syncthreads();
        { const int tt = F.tid & 63, eg = F.tid >> 6;
#pragma unroll
          for (int q = 0; q < 4; ++q) { const int e = 4 * eg + q; float s = rb[e];
#pragma unroll
              for (int w2 = 0; w2 < 8; ++w2) s += part[((w2 * 2 + (tt >> 5)) * 32 + e) * 32 + (tt & 31)];
              lg[tt * 33 + e] = s; } }
        __syncthreads();
        int sel[4]; float sv[4]; int pos[4];
        if (F.tid < 64) {
            float v[32];
#pragma unroll
            for (int e = 0; e < 32; ++e) v[e] = lg[F.tid * 33 + e];
#pragma unroll
            for (int k = 0; k < 4; ++k) { float best = -__builtin_inff(); int bi = 0;
#pragma unroll
                for (int e = 0; e < 32; ++e) { if (v[e] > best) { best = v[e]; bi = e; } }
                sel[k] = bi; sv[k] = best;
#pragma unroll
                for (int e = 0; e < 32; ++e) if (e == bi) v[e] = -__builtin_inff(); }
            const float e1 = fexp(sv[1] - sv[0]), e2 = fexp(sv[2] - sv[0]), e3 = fexp(sv[3] - sv[0]), inv = 1.0f / (1.0f + e1 + e2 + e3);
            sv[0] = inv; sv[1] = e1 * inv; sv[2] = e2 * inv; sv[3] = e3 * inv;
#pragma unroll
            for (int k = 0; k < 4; ++k) pos[k] = (int)atomicAdd((unsigned*)&lcnt[sel[k]], 1u);
        }
        __syncthreads();
        if (F.tid < 32) lcnt[32 + F.tid] = atomicAdd(&gcnt[F.tid], lcnt[F.tid]);
        __syncthreads();
        if (F.tid < 64) {
            const int t = base + F.tid;
#pragma unroll
            for (int k = 0; k < 4; ++k) { const int p = pos[k] + (int)lcnt[32 + sel[k]]; TKS[t * 4 + k] = sel[k] * T + p; TKG[t * 4 + k] = sv[k]; LIST[(size_t)sel[k] * T + p] = t; }
        }
        __syncthreads();
    }
}

__device__ __forceinline__ void moe_tables(Frame& F, int l, int NT) {
    LAS int* tab = (LAS int*)(F.lds + MISC_OFF);
    if (F.wave == 0) {
        const unsigned* gcnt = (const unsigned*)(F.ws + WS_CTL) + CW_CNT + l * 64;
        const int e = F.lane & 31;
        const int c = (int)__hip_atomic_load(&gcnt[e], __ATOMIC_RELAXED, __HIP_MEMORY_SCOPE_AGENT);
        const int tm = (c + 255) >> 8;
        int incl = tm;
#pragma unroll
        for (int o = 1; o < 32; o <<= 1) { const int v = __shfl_up(incl, o, 32); if (e >= o) incl += v; }
        if (F.lane < 32) { tab[e] = (incl - tm) * NT; tab[40 + e] = (incl - tm) * 256; tab[80 + e] = c; if (e == 31) tab[32] = incl * NT; }
    }
    __syncthreads();
}

__device__ __forceinline__ void phase_combine(Frame& F, const ArgsV& A_, int l, float* outp) {
    moe_tables(F, l, 1);
    const LAS int* tab = (const LAS int*)(F.lds + MISC_OFF);
    const float* HB = (const float*)(F.ws + WS_HB); const bf16_t* Y = (const bf16_t*)(F.ws + WS_Y);
    const int* TKS = (const int*)(F.ws + WS_TKS); const float* TKG = (const float*)(F.ws + WS_TKG);
    float* HA = outp ? outp : (float*)(F.ws + WS_HA); bf16_t* XB = outp ? nullptr : (bf16_t*)(F.ws + WS_XB);
    const int gw = F.bid * NWAVES + F.wave, NGW = F.G * NWAVES;
    for (int m = gw; m < T; m += NGW) {
        f32x4 v[4];
#pragma unroll
        for (int j = 0; j < 4; ++j) v[j] = *(const f32x4*)(HB + (size_t)m * D + 4 * F.lane + 256 * j) * ALPHA;
#pragma unroll
        for (int k = 0; k < 4; ++k) { const int code = TKS[m * 4 + k]; const float g = TKG[m * 4 + k]; const int e = code >> 14, p = code & (T - 1);
            const bf16_t* yr = Y + (size_t)(tab[40 + e] + p) * 1024 + 4 * F.lane;
#pragma unroll
            for (int j = 0; j < 4; ++j) { const u32x2 wv = *(const u32x2*)(yr + 256 * j); v[j].x += g * bflo(wv.x); v[j].y += g * bfhi(wv.x); v[j].z += g * bflo(wv.y); v[j].w += g * bfhi(wv.y); } }
        ln_store(v, A_.in[29] + l * D, A_.in[30] + l * D, HA + (size_t)m * D, XB ? XB + (size_t)m * D : nullptr, F.lane);
    }
    __syncthreads();
}

constexpr int PH_PER_LAYER = 10, N_PHASES = 1 + NL * PH_PER_LAYER;

__global__ void __launch_bounds__(NTHREADS, 2) mk_fwd(Args args) {
    extern __shared__ __attribute__((aligned(16))) unsigned char lds_raw[];
    LAS unsigned char* const lds = (LAS unsigned char*)lds_raw;
    const int lo = args.ph_lo, hi = args.ph_hi;
    volatile LAS unsigned* bst = (volatile LAS unsigned*)(lds + MISC_OFF + 2048);
    if (threadIdx.x < 2) bst[threadIdx.x] = 0u;
    if (threadIdx.x == 0) {
        LAS unsigned long long* pt = (LAS unsigned long long*)(lds + PTAB_OFF);
#pragma unroll
        for (int k = 0; k < 31; ++k) pt[k] = (unsigned long long)args.in[k];
    }
    __syncthreads();
    XcdBarrier bar; bar.bar = (unsigned*)(args.ws + WS_CTL) + CW_BAR; bar.x = 0; bar.st = bst;
    if (hi - lo > 1) bar = xcd_barrier_post((unsigned*)(args.ws + WS_CTL) + CW_BAR, bst);
    const ArgsV AV{InTab{lds}};
#ifdef ONLY_SUB
    const int only_sub = ONLY_SUB;
#else
    const int only_sub = -2;
#endif
#pragma unroll 1
    for (int ph = lo; ph < hi; ++ph) {
        const int l = (ph > 0) ? (ph - 1) / PH_PER_LAYER : 0;
        int sub = (ph > 0) ? (ph - 1) % PH_PER_LAYER : -1;
        if (only_sub != -2 && sub != only_sub) continue;
        bool seam = true;
        switch (sub) {
        case -1: { Frame F = make_frame(lds, args.ws); phase_prologue(F, AV); } break;
        case 0: {
            Frame F = make_frame(lds, args.ws);
            pg8::PlainOrder S; S.init(WS_XB, WS_WINT + (size_t)l * 2560 * 1024 * 2, T, NCOLA, F.G, F.bid);
            pg8::EpiBf16 E{(bf16_t*)(F.ws + WS_U), NCOLA, nullptr, 0, 0.125f * LOG2E, 512};
            pg8::gemm_phase<pg8::EpiBf16, pg8::PlainOrder, true>(F.lds, (const char*)F.ws, F.tid, S, E); } break;
        case 1: {
            Frame F = make_frame(lds, args.ws);
            pg8::PlainOrder S; S.init(WS_WINT + ((size_t)l * 2560 + 2048) * 1024 * 2, WS_XB, 512, T, F.G, F.bid);
            pg8::EpiVT E{(bf16_t*)(F.ws + WS_VT)};
            pg8::gemm_phase<pg8::EpiVT, pg8::PlainOrder, true>(F.lds, (const char*)F.ws, F.tid, S, E);
            phase_knorm(F); } break;
        case 2: { Frame F = make_frame(lds, args.ws); phase_mixers(F, AV, l); } break;
        case 3: { Frame F = make_frame(lds, args.ws); phase_lru_fix(F, AV, l); } break;
        case 4: {
            Frame F = make_frame(lds, args.ws);
            pg8::PlainOrder S; S.init(WS_MIX, WS_WOUTT + (size_t)l * 1024 * 1024 * 2, T, D, F.G, F.bid);
            pg8::EpiF32 E{(float*)(F.ws + WS_MIXO), D};
            pg8::gemm_phase<pg8::EpiF32, pg8::PlainOrder, true>(F.lds, (const char*)F.ws, F.tid, S, E); } break;
        case 5: { Frame F = make_frame(lds, args.ws); phase_ln1(F, AV, l); } break;
        case 6: { Frame F = make_frame(lds, args.ws); phase_router(F, AV, l); } break;
        case 7: {
            Frame F = make_frame(lds, args.ws);
            moe_tables(F, l, 8);
            pg8::MoeOrder S{(unsigned)WS_XB, (unsigned)(WS_W1T + (size_t)l * NE * 2048 * 1024 * 2), 2048u * 1024u * 2u, 8, 1, (const int*)(F.ws + WS_LIST), (const LAS int*)(F.lds + MISC_OFF), F.G, F.bid};
            pg8::EpiAct E{(bf16_t*)(F.ws + WS_ACT), AV.in[26] + (size_t)l * NE * 2048};
            pg8::gemm_phase<pg8::EpiAct, pg8::MoeOrder, true>(F.lds, (const char*)F.ws, F.tid, S, E); } break;
        case 8: {
            Frame F = make_frame(lds, args.ws);
            moe_tables(F, l, 4);
            pg8::MoeOrder S{(unsigned)WS_ACT, (unsigned)(WS_W2T + (size_t)l * NE * 1024 * 1024 * 2), 1024u * 1024u * 2u, 4, 0, nullptr, (const LAS int*)(F.lds + MISC_OFF), F.G, F.bid};
            pg8::EpiBf16 E{(bf16_t*)(F.ws + WS_Y), 1024, AV.in[28] + (size_t)l * NE * 1024, 1024, 1.0f, 0};
            pg8::gemm_phase<pg8::EpiBf16, pg8::MoeOrder, true>(F.lds, (const char*)F.ws, F.tid, S, E); } break;
        default: { Frame F = make_frame(lds, args.ws); phase_combine(F, AV, l, (l == NL - 1) ? args.out : nullptr); } break;
        }
        if (seam && ph + 1 < hi) xcd_barrier(bar);
    }
}

extern "C" void kernel_launch(void* const* d_in, const int* in_sizes, int n_in, void* d_out, int out_size, void* d_ws, size_t ws_size, hipStream_t stream) {
    static int grid = 0;
    if (grid == 0) {
        if (n_in != 31 || out_size != T * D || ws_size < WS_END) { fprintf(stderr, "kernel_launch: unexpected sizes n_in %d out %d ws %zu (need %zu)\n", n_in, out_size, ws_size, (size_t)WS_END); grid = -1; return; }
        int dev = 0, cus = 0, per_cu = 0;
        if (hipGetDevice(&dev) != hipSuccess || hipDeviceGetAttribute(&cus, hipDeviceAttributeMultiprocessorCount, dev) != hipSuccess) { grid = -1; return; }
        if (hipFuncSetAttribute((const void*)mk_fwd, hipFuncAttributeMaxDynamicSharedMemorySize, LDS_BYTES) != hipSuccess) { fprintf(stderr, "kernel_launch: hipFuncSetAttribute failed\n"); grid = -1; return; }
        if (hipOccupancyMaxActiveBlocksPerMultiprocessor(&per_cu, (const void*)mk_fwd, NTHREADS, LDS_BYTES) != hipSuccess || per_cu < 1) { fprintf(stderr, "kernel_launch: occupancy query says %d blocks per CU\n", per_cu); (void)hipGetLastError(); grid = -1; return; }
        grid = cus;
    }
    if (grid < 0) return;
    (void)hipMemsetAsync((char*)d_ws + WS_CTL, 0, CTL_ZERO_BYTES, stream);
    Args a{};
    for (int i = 0; i < 31; ++i) a.in[i] = (const float*)d_in[i];
    a.out = (float*)d_out; a.ws = (unsigned char*)d_ws;
#if MK_ONE_LAUNCH
    a.ph_lo = 0; a.ph_hi = N_PHASES;
    hipLaunchKernelGGL(mk_fwd, dim3(grid), dim3(NTHREADS), LDS_BYTES, stream, a);
#ifdef PROBE_LO
    a.ph_lo = PROBE_LO; a.ph_hi = PROBE_HI;
    hipLaunchKernelGGL(mk_fwd, dim3(grid), dim3(NTHREADS), LDS_BYTES, stream, a);
#endif
#else
    for (int p = 0; p < N_PHASES; ++p) { a.ph_lo = p; a.ph_hi = p + 1; hipLaunchKernelGGL(mk_fwd, dim3(grid), dim3(NTHREADS), LDS_BYTES, stream, a); }
#endif
}
```

```cpp
#include <hip/hip_runtime.h>
#include <cstdio>
#include <cstdint>

#ifndef PROBE_DUP
#define PROBE_DUP 0
#endif
#ifndef MK_ONE_LAUNCH
#define MK_ONE_LAUNCH 1
#endif

#define LAS __attribute__((address_space(3)))
#define GAS __attribute__((address_space(1)))
typedef unsigned short bf16_t;
typedef short bf16x8 __attribute__((ext_vector_type(8)));
typedef float f32x2 __attribute__((ext_vector_type(2)));
typedef float f32x4 __attribute__((ext_vector_type(4)));
typedef float f32x16 __attribute__((ext_vector_type(16)));
typedef unsigned u32x4 __attribute__((ext_vector_type(4)));
typedef unsigned u32x2 __attribute__((ext_vector_type(2)));

constexpr int T = 16384, D = 1024, NL = 2, NE = 32, KD = 1024;
constexpr int NCOLA = 2048;
constexpr int UQ = 0, UK = 512, ULX = 1024, ULY = 1280, UCA = 1536, UCB = 1792;
constexpr float LN_EPS = 1e-5f;
constexpr float ALPHA = 1.41421356237309515f;
constexpr float LOG2E = 1.44269504088896341f;
constexpr int NWAVES = 8, NTHREADS = 512;
constexpr int ACT_ROWS = 65536 + 32 * 256 + 256;

constexpr size_t MiB = 1u << 20;
constexpr size_t WS_CTL = 0, CTL_ZERO_BYTES = 1 * MiB;
constexpr size_t WS_WINT = 2 * MiB;
constexpr size_t WS_WOUTT = 12 * MiB;
constexpr size_t WS_W1T = 16 * MiB;
constexpr size_t WS_W2T = 272 * MiB;
constexpr size_t WS_HA = 400 * MiB;
constexpr size_t WS_HB = 464 * MiB;
constexpr size_t WS_XB = 528 * MiB;
constexpr size_t WS_U = 560 * MiB;
constexpr size_t WS_VT = 624 * MiB;
constexpr size_t WS_MIX = 640 * MiB;
constexpr size_t WS_MIXO = 672 * MiB;
constexpr size_t WS_HLOC = 736 * MiB;
constexpr size_t WS_CUMA = 752 * MiB;
constexpr size_t WS_AGG = 768 * MiB;
constexpr size_t WS_TKS = 769 * MiB;
constexpr size_t WS_TKG = 769 * MiB + 512 * 1024;
constexpr size_t WS_LIST = 770 * MiB;
constexpr size_t WS_ACT = 772 * MiB;
constexpr size_t WS_Y = 920 * MiB;
constexpr size_t WS_END = 1068 * MiB;
static_assert(WS_ACT + (size_t)ACT_ROWS * 2048 <= WS_Y && WS_Y + (size_t)ACT_ROWS * 2048 <= WS_END, "ws map");
constexpr int CW_BAR = 4096;
constexpr int CW_CNT = 16384;

constexpr int RING_BYTES = 135168;
constexpr int MISC_OFF = RING_BYTES;
constexpr int LDS_BYTES = 147456;
constexpr int VA_PARK_OFF = MISC_OFF + 4096;

__device__ __forceinline__ unsigned f2bf(float f) { unsigned u = __builtin_bit_cast(unsigned, f); return (u + 0x7fffu + ((u >> 16) & 1u)) >> 16; }
__device__ __forceinline__ unsigned pk2(float lo, float hi) { return f2bf(lo) | (f2bf(hi) << 16); }
__device__ __forceinline__ float bf2f(bf16_t v) { return __builtin_bit_cast(float, (unsigned)v << 16); }
__device__ __forceinline__ float bflo(unsigned w) { return __builtin_bit_cast(float, w << 16); }
__device__ __forceinline__ float bfhi(unsigned w) { return __builtin_bit_cast(float, w & 0xffff0000u); }
__device__ __forceinline__ unsigned cvt_pk_bf16(float lo, float hi) { unsigned r; asm volatile("v_cvt_pk_bf16_f32 %0, %1, %2" : "=v"(r) : "v"(lo), "v"(hi)); return r; }
__device__ __forceinline__ float shx(float v, int lane4, int mask) { return __builtin_bit_cast(float, __builtin_amdgcn_ds_bpermute(lane4 ^ (mask << 2), __builtin_bit_cast(int, v))); }
__device__ __forceinline__ float shup(float v, int lane4, int d) { return __builtin_bit_cast(float, __builtin_amdgcn_ds_bpermute(lane4 - (d << 2), __builtin_bit_cast(int, v))); }
__device__ __forceinline__ int shupi(int v, int lane4, int d) { return __builtin_amdgcn_ds_bpermute(lane4 - (d << 2), v); }
__device__ __forceinline__ float wave_sum(float v, int lane4) {
#pragma unroll
    for (int o = 1; o < 64; o <<= 1) v += shx(v, lane4, o);
    return v;
}
__device__ __forceinline__ float ex2(float x) { return __builtin_amdgcn_exp2f(x); }
__device__ __forceinline__ float fexp(float x) { return __builtin_amdgcn_exp2f(x * LOG2E); }
__device__ __forceinline__ float frcp(float x) { return __builtin_amdgcn_rcpf(x); }
__device__ __forceinline__ float fsqrt(float x) { return __builtin_amdgcn_sqrtf(x); }
__device__ __forceinline__ float flog(float x) { return __builtin_amdgcn_logf(x) * 0.693147180559945f; }
__device__ __forceinline__ float sigmoidf_(float x) { return frcp(1.0f + fexp(-x)); }
#define LDS_WAIT() asm volatile("s_waitcnt lgkmcnt(0)" ::: "memory")
#define VM_WAIT() asm volatile("s_waitcnt vmcnt(0)" ::: "memory")

namespace pg8 {
constexpr int BM = 256, BK = 64, HALF = 128, HTB = HALF * BK * 2, STAGE_BYTES = 8 * HTB, NXCD = 8, WGM = 8;
__device__ __forceinline__ int lds_byte(int r, int c) { const int st = (r >> 4) * 2 + (c >> 5), rr = r & 15, cc = c & 31, ob = rr * 64 + cc * 2; return st * 1024 + (ob ^ (((ob >> 9) & 1) << 5)); }
__device__ __forceinline__ void stage_rc(int b, int& R, int& C) { const unsigned ub = (unsigned)b, st = ub >> 10, sb = ub & 1023u, swz = sb ^ (((sb >> 9) & 1u) << 5); R = (int)((st >> 1) * 16u + (swz >> 6)); C = (int)((st & 1u) * 32u + ((swz & 63u) >> 1)); }
__device__ __forceinline__ int perm32(int rho) { const int n = rho >> 4, i = rho & 15; return 8 * (i >> 2) + 4 * n + (i & 3); }

struct Unit { unsigned A, B; int pn, e, orow; unsigned va00, va01, va10, va11; };

struct PlainOrder {
    unsigned A, Bt; int nM, nN, nwg, G, c;
    __device__ void init(size_t A_, size_t Bt_, int M, int N, int G_, int c_) { A = (unsigned)A_; Bt = (unsigned)Bt_; nM = M / BM; nN = N / BM; nwg = nM * nN; G = G_; c = c_; }
    __device__ __forceinline__ bool next(int i, Unit& u, int tid) const {
        const long L = (long)i * G + c; if (L >= nwg) return false;
        int R0, C0, R1, C1; stage_rc(tid * 16, R0, C0); stage_rc(tid * 16 + 8192, R1, C1);
        int wgid = (int)L; { const int q = nwg / NXCD, r = nwg % NXCD, xcd = wgid % NXCD, off = wgid / NXCD; wgid = (xcd < r ? xcd * (q + 1) : r * (q + 1) + (xcd - r) * q) + off; }
        const int nig = WGM * nN, gid = wgid / nig, fm = gid * WGM, gsz = (nM - fm) < WGM ? (nM - fm) : WGM;
        const int pm = fm + ((wgid % nig) % gsz), pn = (wgid % nig) / gsz;
        u.A = A + (unsigned)pm * (BM * KD * 2); u.B = Bt + (unsigned)pn * (BM * KD * 2); u.pn = pn; u.e = 0; u.orow = pm * BM;
        u.va00 = (unsigned)(R0 * KD + C0) * 2u; u.va01 = (unsigned)(R1 * KD + C1) * 2u; u.va10 = (unsigned)((R0 + HALF) * KD + C0) * 2u; u.va11 = (unsigned)((R1 + HALF) * KD + C1) * 2u;
        return true;
    }
};

struct MoeOrder {
    unsigned Abase, Bt, bstride; int NT; int gather; const int* list; const LAS int* tab; int G, c;
    __device__ __forceinline__ bool next(int i, Unit& u, int tid) const {
        const int NU = __builtin_amdgcn_readfirstlane(tab[32]);
        int L;
        if ((G & 7) == 0) { const int g8 = G >> 3, per = (NU + 7) >> 3, idx = i * g8 + (c >> 3); if (idx >= per) return false; L = (c & 7) * per + idx; }
        else L = i * G + c;
        if (L >= NU) return false;
        int R0, C0, R1, C1; stage_rc(tid * 16, R0, C0); stage_rc(tid * 16 + 8192, R1, C1);
        const int ln_ = tid & 63;
        int e = __popcll(__ballot(ln_ >= 1 && ln_ < 32 && L >= tab[ln_ & 31]));
        e = __builtin_amdgcn_readfirstlane(e);
        const int ub = __builtin_amdgcn_readfirstlane(tab[e]), ub1 = __builtin_amdgcn_readfirstlane(tab[e + 1]);
        const int ps = __builtin_amdgcn_readfirstlane(tab[40 + e]), cnt = __builtin_amdgcn_readfirstlane(tab[80 + e]);
        const int tm = (ub1 - ub) / NT, r = L - ub, mt = r % tm, nt = r / tm;
        u.e = e; u.pn = nt; u.orow = ps + mt * BM;
        u.B = Bt + (unsigned)e * bstride + (unsigned)nt * (BM * KD * 2);
        if (gather) {
            u.A = Abase;
            const int* lp = list + (size_t)e * T + mt * BM; const int lim = cnt - mt * BM;
            const int t00 = (R0 < lim) ? lp[R0] : 0, t01 = (R1 < lim) ? lp[R1] : 0, t10 = (R0 + HALF < lim) ? lp[R0 + HALF] : 0, t11 = (R1 + HALF < lim) ? lp[R1 + HALF] : 0;
            u.va00 = (unsigned)(t00 * KD + C0) * 2u; u.va01 = (unsigned)(t01 * KD + C1) * 2u; u.va10 = (unsigned)(t10 * KD + C0) * 2u; u.va11 = (unsigned)(t11 * KD + C1) * 2u;
        } else {
            u.A = Abase + (unsigned)u.orow * (KD * 2);
            u.va00 = (unsigned)(R0 * KD + C0) * 2u; u.va01 = (unsigned)(R1 * KD + C1) * 2u; u.va10 = (unsigned)((R0 + HALF) * KD + C0) * 2u; u.va11 = (unsigned)((R1 + HALF) * KD + C1) * 2u;
        }
        return true;
    }
};

struct EpiBf16 {
    static constexpr bool PERM = true;
    bf16_t* O; int ldc; const float* bias; int bias_stride; float scale0; int scale_cols;
    __device__ __forceinline__ void operator()(const f32x4 (&acc)[2][2][4][2], const Unit& u, int wr, int wc, int fr, int fq) const {
        const int row0 = u.orow + wr * 64 + fr, colt = u.pn * BM, col0 = colt + wc * 32 + 8 * fq;
        const float sc = (colt < scale_cols) ? scale0 : 1.f;
        const float* bp = bias ? bias + (size_t)u.e * bias_stride : nullptr;
        f32x4 bv[2][2];
#pragma unroll
        for (int bj = 0; bj < 2; ++bj)
#pragma unroll
            for (int n = 0; n < 2; ++n) bv[bj][n] = bp ? *(const f32x4*)(bp + col0 + bj * HALF + 4 * n) : (f32x4){0.f, 0.f, 0.f, 0.f};
#pragma unroll
        for (int ai = 0; ai < 2; ++ai)
#pragma unroll
            for (int m = 0; m < 4; ++m) { bf16_t* rowp = O + (size_t)(row0 + ai * HALF + m * 16) * ldc + col0;
#pragma unroll
                for (int bj = 0; bj < 2; ++bj) { f32x4 v0 = (acc[ai][bj][m][0] + bv[bj][0]) * sc, v1 = (acc[ai][bj][m][1] + bv[bj][1]) * sc;
                    u32x4 w; w.x = cvt_pk_bf16(v0[0], v0[1]); w.y = cvt_pk_bf16(v0[2], v0[3]); w.z = cvt_pk_bf16(v1[0], v1[1]); w.w = cvt_pk_bf16(v1[2], v1[3]);
                    *(u32x4*)(rowp + bj * HALF) = w; } }
    }
};
struct EpiVT {
    static constexpr bool PERM = false;
    bf16_t* O;
    __device__ __forceinline__ void operator()(const f32x4 (&acc)[2][2][4][2], const Unit& u, int wr, int wc, int fr, int fq) const {
        const int sfq = (fq == 1) ? 2 : ((fq == 2) ? 1 : fq);
        const int row0 = u.orow + wr * 64 + fr, col0 = u.pn * BM + wc * 32 + 4 * sfq;
#pragma unroll
        for (int ai = 0; ai < 2; ++ai)
#pragma unroll
            for (int m = 0; m < 4; ++m) { bf16_t* rowp = O + (size_t)(row0 + ai * HALF + m * 16) * T + col0;
#pragma unroll
                for (int bj = 0; bj < 2; ++bj)
#pragma unroll
                    for (int n = 0; n < 2; ++n) { const f32x4 v = acc[ai][bj][m][n]; u32x2 w; w.x = cvt_pk_bf16(v[0], v[1]); w.y = cvt_pk_bf16(v[2], v[3]); *(u32x2*)(rowp + bj * HALF + n * 16) = w; } }
    }
};
struct EpiF32 {
    static constexpr bool PERM = false;
    float* O; int ldc;
    __device__ __forceinline__ void operator()(const f32x4 (&acc)[2][2][4][2], const Unit& u, int wr, int wc, int fr, int fq) const {
        const int row0 = u.orow + wr * 64 + fr, col0 = u.pn * BM + wc * 32 + 4 * fq;
#pragma unroll
        for (int ai = 0; ai < 2; ++ai)
#pragma unroll
            for (int m = 0; m < 4; ++m) { float* rowp = O + (size_t)(row0 + ai * HALF + m * 16) * ldc + col0;
#pragma unroll
                for (int bj = 0; bj < 2; ++bj)
#pragma unroll
                    for (int n = 0; n < 2; ++n) *(f32x4*)(rowp + bj * HALF + n * 16) = acc[ai][bj][m][n]; }
    }
};
struct EpiAct {
    static constexpr bool PERM = true;
    bf16_t* O; const float* b1;
    __device__ __forceinline__ void operator()(const f32x4 (&acc)[2][2][4][2], const Unit& u, int wr, int wc, int fr, int fq) const {
        const int row0 = u.orow + wr * 64 + fr, j0 = u.pn * HALF + wc * 32 + 8 * fq;
        const float* bp = b1 + (size_t)u.e * 2048;
        f32x4 bg[2], bl[2];
#pragma unroll
        for (int n = 0; n < 2; ++n) { bg[n] = *(const f32x4*)(bp + j0 + 4 * n); bl[n] = *(const f32x4*)(bp + 1024 + j0 + 4 * n); }
#pragma unroll
        for (int ai = 0; ai < 2; ++ai)
#pragma unroll
            for (int m = 0; m < 4; ++m) { bf16_t* rowp = O + (size_t)(row0 + ai * HALF + m * 16) * 1024 + j0;
                float o[8];
#pragma unroll
                for (int n = 0; n < 2; ++n)
#pragma unroll
                    for (int q = 0; q < 4; ++q) { float g = acc[ai][0][m][n][q] + bg[n][q], l = acc[ai][1][m][n][q] + bl[n][q];
                        g = fminf(g, 7.0f); l = fminf(fmaxf(l, -7.0f), 7.0f);
                        o[n * 4 + q] = g * (1.0f / (1.0f + __builtin_amdgcn_exp2f(-1.702f * LOG2E * g))) * (l + 1.0f); }
                u32x4 w; w.x = cvt_pk_bf16(o[0], o[1]); w.y = cvt_pk_bf16(o[2], o[3]); w.z = cvt_pk_bf16(o[4], o[5]); w.w = cvt_pk_bf16(o[6], o[7]);
                *(u32x4*)rowp = w; }
    }
};

template <class Epi, class Sched, bool ALIGN_EPI>
__device__ __forceinline__ void gemm_phase(LAS unsigned char* lds, const char* wsb, const int tid0, const Sched& S, const Epi& E) {
    Unit cur, nxt; int ui = 0;
    if (!S.next(0, cur, tid0)) return;
    int tid = tid0; asm volatile("" : "+v"(tid));
    const int wid = __builtin_amdgcn_readfirstlane(tid >> 6), lane = tid & 63, wr = wid >> 2, wc = wid & 3, fr = lane & 15, fq = lane >> 4;
    constexpr int K = KD, nt = K / BK;
    unsigned voffB[2];
    { int R0, C0, R1, C1; stage_rc(tid * 16, R0, C0); stage_rc(tid * 16 + 8192, R1, C1);
      const int Rb0 = Epi::PERM ? ((R0 & ~31) + perm32(R0 & 31)) : R0, Rb1 = Epi::PERM ? ((R1 & ~31) + perm32(R1 & 31)) : R1;
      voffB[0] = (unsigned)(Rb0 * K + C0) * 2u; voffB[1] = (unsigned)(Rb1 * K + C1) * 2u; }
    constexpr unsigned kstep = (unsigned)(BK * 2);
    constexpr unsigned hstep = (unsigned)HALF * K * 2;
    const unsigned ldsw = (unsigned)wid * 1024u;
    const int aoff = lds_byte(wr * 64 + fr, fq * 8), boff = lds_byte(wc * 32 + fr, fq * 8);
#define PG8_SA(b, h) (((b) * 2 + (h)) * HTB)
#define PG8_SB(b, h) ((4 + (b) * 2 + (h)) * HTB)
#define PG8_GLDS(gp, lp) __builtin_amdgcn_global_load_lds((const unsigned*)(gp), (LAS unsigned*)(lp), 16, 0, 0)
#define PG8_STB(bufoff, gbase) do { PG8_GLDS(wsb + (size_t)((gbase) + voffB[0]), lds + (bufoff) + ldsw); PG8_GLDS(wsb + (size_t)((gbase) + voffB[1]), lds + (bufoff) + ldsw + 8192); } while (0)
#define PG8_STA(bufoff, gbase, v0, v1) do { PG8_GLDS(wsb + (size_t)((gbase) + (v0)), lds + (bufoff) + ldsw); PG8_GLDS(wsb + (size_t)((gbase) + (v1)), lds + (bufoff) + ldsw + 8192); } while (0)
#define PG8_LDA(dst, b, h) do { _Pragma("unroll") for (int m = 0; m < 4; ++m) _Pragma("unroll") for (int k = 0; k < 2; ++k) dst[m][k] = *(const LAS bf16x8*)(lds + PG8_SA(b, h) + aoff + m * 2048 + k * 1024); } while (0)
#define PG8_LDB(dst, b, h) do { _Pragma("unroll") for (int n = 0; n < 2; ++n) _Pragma("unroll") for (int k = 0; k < 2; ++k) dst[n][k] = *(const LAS bf16x8*)(lds + PG8_SB(b, h) + boff + n * 2048 + k * 1024); } while (0)
#define PG8_MMA(ai, bj, At, Bt) do { __builtin_amdgcn_s_setprio(1); _Pragma("unroll") for (int m = 0; m < 4; ++m) _Pragma("unroll") for (int n = 0; n < 2; ++n) _Pragma("unroll") for (int k = 0; k < 2; ++k) \
        acc[ai][bj][m][n] = __builtin_amdgcn_mfma_f32_16x16x32_bf16(Bt[n][k], At[m][k], acc[ai][bj][m][n], 0, 0, 0); __builtin_amdgcn_s_setprio(0); } while (0)
#define PG8_WAIT_V(n) asm volatile("s_waitcnt vmcnt(" #n ")" ::: "memory")
#define PG8_WAIT_L(n) asm volatile("s_waitcnt lgkmcnt(" #n ")" ::: "memory")
#define PG8_BAR __builtin_amdgcn_s_barrier()
#define PG8_SCHED __builtin_amdgcn_sched_barrier(0)
    f32x4 acc[2][2][4][2];
#pragma unroll
    for (int a = 0; a < 2; ++a)
#pragma unroll
        for (int b = 0; b < 2; ++b)
#pragma unroll
            for (int m = 0; m < 4; ++m)
#pragma unroll
                for (int n = 0; n < 2; ++n) acc[a][b][m][n] = (f32x4){0.f, 0.f, 0.f, 0.f};
    bf16x8 At[4][2], B0[2][2], B1[2][2];
    unsigned cA = cur.A, cB = cur.B;
    unsigned c00 = cur.va00, c01 = cur.va01, c10 = cur.va10, c11 = cur.va11;
    PG8_STB(PG8_SB(0, 0), cB); PG8_STB(PG8_SB(0, 1), cB + hstep); PG8_STA(PG8_SA(0, 0), cA, c00, c01); PG8_STA(PG8_SA(0, 1), cA, c10, c11);
    if (wr == 1) PG8_BAR;
    PG8_WAIT_V(2); PG8_BAR;
    PG8_STB(PG8_SB(1, 0), cB + kstep); PG8_STA(PG8_SA(1, 0), cA + kstep, c00, c01); PG8_STB(PG8_SB(1, 1), cB + hstep + kstep);
    PG8_WAIT_V(6); PG8_BAR;
    for (;;) {
        const bool has_next = S.next(ui + 1, nxt, tid);
        const unsigned nA = has_next ? nxt.A : cA, nB = has_next ? nxt.B : cB;
        { u32x4 pv; pv.x = has_next ? nxt.va00 : c00; pv.y = has_next ? nxt.va01 : c01; pv.z = has_next ? nxt.va10 : c10; pv.w = has_next ? nxt.va11 : c11; *(LAS u32x4*)(lds + VA_PARK_OFF + tid * 16) = pv; }
        for (int t = 0; t < nt; t += 2) {
            const bool last = (t == nt - 2);
            const unsigned a1 = cA + (unsigned)(t + 1) * kstep;
            const unsigned a2 = last ? nA : cA + (unsigned)(t + 2) * kstep, b2 = last ? nB : cB + (unsigned)(t + 2) * kstep;
            const unsigned a3 = a2 + kstep, b3 = b2 + kstep;
            unsigned s00 = c00, s01 = c01, s10 = c10, s11 = c11;
            if (last) { const u32x4 pv = *(const LAS u32x4*)(lds + VA_PARK_OFF + tid * 16); s00 = pv.x; s01 = pv.y; s10 = pv.z; s11 = pv.w; }
            PG8_LDB(B0, 0, 0); PG8_LDB(B1, 0, 1); PG8_SCHED; PG8_LDA(At, 0, 0); PG8_STA(PG8_SA(1, 1), a1, c10, c11);
            PG8_WAIT_V(8); PG8_WAIT_L(0); PG8_BAR; PG8_MMA(0, 0, At, B0); PG8_MMA(0, 1, At, B1); PG8_BAR; PG8_SCHED;
            PG8_LDA(At, 0, 1); PG8_STB(PG8_SB(0, 0), b2); PG8_STB(PG8_SB(0, 1), b2 + hstep); PG8_STA(PG8_SA(0, 0), a2, s00, s01);
            PG8_WAIT_V(8); PG8_WAIT_L(0); PG8_BAR; PG8_MMA(1, 0, At, B0); PG8_MMA(1, 1, At, B1); PG8_BAR; PG8_SCHED;
            PG8_LDB(B0, 1, 0); PG8_LDB(B1, 1, 1); PG8_SCHED; PG8_LDA(At, 1, 0); PG8_STA(PG8_SA(0, 1), a2, s10, s11);
            PG8_WAIT_V(8); PG8_WAIT_L(0); PG8_BAR; PG8_MMA(0, 0, At, B0); PG8_MMA(0, 1, At, B1); PG8_BAR; PG8_SCHED;
            PG8_LDA(At, 1, 1); PG8_STB(PG8_SB(1, 0), b3); PG8_STB(PG8_SB(1, 1), b3 + hstep); PG8_STA(PG8_SA(1, 0), a3, s00, s01);
            PG8_WAIT_V(8); PG8_WAIT_L(0); PG8_BAR; PG8_MMA(1, 0, At, B0); PG8_MMA(1, 1, At, B1); PG8_BAR; PG8_SCHED;
        }
        if constexpr (ALIGN_EPI) { if (wr == 0) PG8_BAR; }
        E(acc, cur, wr, wc, fr, fq);
        if (!has_next) break;
#pragma unroll
        for (int a = 0; a < 2; ++a)
#pragma unroll
            for (int b = 0; b < 2; ++b)
#pragma unroll
                for (int m = 0; m < 4; ++m)
#pragma unroll
                    for (int n = 0; n < 2; ++n) acc[a][b][m][n] = (f32x4){0.f, 0.f, 0.f, 0.f};
        cur = nxt; cA = nA; cB = nB; { const u32x4 pv = *(const LAS u32x4*)(lds + VA_PARK_OFF + tid * 16); c00 = pv.x; c01 = pv.y; c10 = pv.z; c11 = pv.w; } ++ui;
        if constexpr (ALIGN_EPI) { if (wr == 1) PG8_BAR; }
    }
    PG8_WAIT_V(0);
    if constexpr (!ALIGN_EPI) { if (wr == 0) PG8_BAR; }
    PG8_BAR;
#undef PG8_SA
#undef PG8_SB
#undef PG8_GLDS
#undef PG8_STB
#undef PG8_STA
#undef PG8_LDA
#undef PG8_LDB
#undef PG8_MMA
#undef PG8_WAIT_V
#undef PG8_WAIT_L
#undef PG8_BAR
#undef PG8_SCHED
}
}

#define XB_TMO      128
#define XB_XCNT(j)  (256  + 64 * (j))
#define XB_XSUB(j)  (1280 + 64 * (j))
#define XB_XGEN(j)  (2304 + 64 * (j))
#define XB_TOP      3328
#define XB_TOPGEN   3392
#define XCD_BAR_WORDS 3456
#define XB_SPIN_CAP (1u << 22)
__device__ __forceinline__ unsigned xb_ld(unsigned* p)              { return __hip_atomic_load(p, __ATOMIC_RELAXED, __HIP_MEMORY_SCOPE_AGENT); }
__device__ __forceinline__ unsigned xb_add(unsigned* p, unsigned v) { return __hip_atomic_fetch_add(p, v, __ATOMIC_RELAXED, __HIP_MEMORY_SCOPE_AGENT); }
__device__ __forceinline__ unsigned xb_xcc_id() { return (unsigned)__builtin_amdgcn_s_getreg((3 << 11) | 20) & 0xFu; }
#define XB_SPIN(cond, bar) do { unsigned _sp = 0; while (cond) { __builtin_amdgcn_s_sleep(1); \
    if ((++_sp & 255u) == 0u) { if (xb_ld(&(bar)[XB_TMO])) break; if (_sp > XB_SPIN_CAP) { atomicAdd(&(bar)[XB_TMO], 1u); break; } } } } while (0)
struct XcdBarrier { unsigned* bar; unsigned x; volatile LAS unsigned* st; };
__device__ __forceinline__ XcdBarrier xcd_barrier_post(unsigned* bar, volatile LAS unsigned* st) {
    XcdBarrier b; b.bar = bar; b.x = xb_xcc_id(); b.st = st;
    if (threadIdx.x == 0) (void)xb_add(&bar[XB_XCNT(b.x)], 1u);
    return b;
}
__device__ __forceinline__ void xcd_barrier_complete(unsigned* bar, unsigned x, unsigned& nloc, unsigned& nx) {
    const unsigned G = gridDim.x * gridDim.y * gridDim.z;
    unsigned sum, cnt, mine, sp = 0u;
    for (;;) {
        sum = 0u; cnt = 0u; mine = 0u;
#pragma unroll 1
        for (unsigned j = 0; j < 16; ++j) { const unsigned c = xb_ld(&bar[XB_XCNT(j)]); sum += c; cnt += (c > 0u) ? 1u : 0u; mine = (j == x) ? c : mine; }
        if (sum == G) break;
        __builtin_amdgcn_s_sleep(1);
        if ((++sp & 255u) == 0u) { if (xb_ld(&bar[XB_TMO])) break; if (sp > XB_SPIN_CAP) { atomicAdd(&bar[XB_TMO], 1u); break; } }
    }
    nloc = mine > 0u ? mine : 1u; nx = cnt > 0u ? cnt : 1u;
}
__device__ __forceinline__ void xcd_barrier(const XcdBarrier& b) {
    asm volatile("s_waitcnt vmcnt(0)" ::: "memory");
    __syncthreads();
    if (threadIdx.x == 0) {
        unsigned* bar = b.bar;
        __builtin_amdgcn_s_waitcnt(0);
        unsigned nloc = b.st[0], nx = b.st[1];
        if (nloc == 0u) { xcd_barrier_complete(bar, b.x, nloc, nx); b.st[0] = nloc; b.st[1] = nx; }
        const unsigned old = xb_add(&bar[XB_XSUB(b.x)], 1u);
        const unsigned gen = old / nloc;
        if (old + 1u == (gen + 1u) * nloc) {
            __builtin_amdgcn_fence(__ATOMIC_RELEASE, "agent");
            asm volatile("s_waitcnt vmcnt(0)" ::: "memory");
            const unsigned og = xb_add(&bar[XB_TOP], 1u);
            const unsigned tg = og / nx;
            if (og + 1u == (tg + 1u) * nx) xb_add(&bar[XB_TOPGEN], 1u);
            else XB_SPIN(xb_ld(&bar[XB_TOPGEN]) == tg, bar);
            __builtin_amdgcn_fence(__ATOMIC_ACQUIRE, "agent");
            xb_add(&bar[XB_XGEN(b.x)], 1u);
            asm volatile("s_waitcnt vmcnt(0)" ::: "memory");
        } else {
            XB_SPIN(xb_ld(&bar[XB_XGEN(b.x)]) == gen, bar);
            __builtin_amdgcn_fence(__ATOMIC_ACQUIRE, "agent");
            asm volatile("s_waitcnt vmcnt(0)" ::: "memory");
        }
    }
    __syncthreads();
}

struct Args { const float* in[31]; float* out; unsigned char* ws; int ph_lo, ph_hi, probe, pad; };

struct Frame {
    LAS unsigned char* lds;
    int tid, lane, wave, G, bid;
    unsigned char* ws;
};
constexpr int PTAB_OFF = MISC_OFF + 3072;
struct InTab { LAS unsigned char* lds;
    __device__ __forceinline__ const float* operator[](int k) const {
        const LAS unsigned* p = (const LAS unsigned*)(lds + PTAB_OFF) + 2 * k;
        const unsigned lo = __builtin_amdgcn_readfirstlane(p[0]), hi = __builtin_amdgcn_readfirstlane(p[1]);
        return (const float*)(((unsigned long long)hi << 32) | lo); } };
struct ArgsV { InTab in; };
__device__ __forceinline__ Frame make_frame(LAS unsigned char* lds, unsigned char* ws) {
    Frame F; F.lds = lds;
    int tid = threadIdx.x; asm volatile("" : "+v"(tid));
    F.tid = tid; F.lane = tid & 63; F.wave = __builtin_amdgcn_readfirstlane(tid >> 6);
    F.G = gridDim.x; F.bid = blockIdx.x;
    unsigned long long w = (unsigned long long)ws; asm volatile("" : "+s"(w)); F.ws = (unsigned char*)w;
    return F;
}

__device__ __forceinline__ void transpose_item(const float* W, int N, bf16_t* WT, int k0, int n0, int drow0, LAS float* scr, int lane) {
    f32x4 v[16];
    const int lr = lane >> 4, lc = (lane & 15) * 4;
#pragma unroll
    for (int i = 0; i < 16; ++i) v[i] = __builtin_nontemporal_load((const f32x4*)(W + (size_t)(k0 + 4 * i + lr) * N + n0 + lc));
#pragma unroll
    for (int i = 0; i < 16; ++i) { LAS float* s = scr + (4 * i + lr) * 65 + lc; s[0] = v[i].x; s[1] = v[i].y; s[2] = v[i].z; s[3] = v[i].w; }
    LDS_WAIT(); asm volatile("" ::: "memory");
    const int c = lane & 7;
#pragma unroll
    for (int j = 0; j < 8; ++j) { const int n = (lane >> 3) + 8 * j; const LAS float* s = scr + (8 * c) * 65 + n;
        u32x4 o; o.x = pk2(s[0 * 65], s[1 * 65]); o.y = pk2(s[2 * 65], s[3 * 65]); o.z = pk2(s[4 * 65], s[5 * 65]); o.w = pk2(s[6 * 65], s[7 * 65]);
        *(u32x4*)(WT + (size_t)(drow0 + n) * KD + k0 + 8 * c) = o; }
    LDS_WAIT(); asm volatile("" ::: "memory");
}
__device__ __forceinline__ void ln_store(f32x4 (&v)[4], const float* g, const float* b, float* of32, bf16_t* obf, int lane) {
    float s = 0.f;
#pragma unroll
    for (int j = 0; j < 4; ++j) s += (v[j].x + v[j].y) + (v[j].z + v[j].w);
    const float mean = wave_sum(s, lane << 2) * (1.f / D); float s2 = 0.f;
#pragma unroll
    for (int j = 0; j < 4; ++j) { v[j] = v[j] - mean; s2 += (v[j].x * v[j].x + v[j].y * v[j].y) + (v[j].z * v[j].z + v[j].w * v[j].w); }
    const float rstd = __builtin_amdgcn_rsqf(wave_sum(s2, lane << 2) * (1.f / D) + LN_EPS);
#pragma unroll
    for (int j = 0; j < 4; ++j) {
        const f32x4 gv = *(const f32x4*)(g + 4 * lane + 256 * j), bv = *(const f32x4*)(b + 4 * lane + 256 * j);
        const f32x4 o = v[j] * rstd * gv + bv;
        if (of32) *(f32x4*)(of32 + 4 * lane + 256 * j) = o;
        if (obf) { u32x2 w; w.x = pk2(o.x, o.y); w.y = pk2(o.z, o.w); *(u32x2*)(obf + 4 * lane + 256 * j) = w; }
    }
}

__device__ __forceinline__ void phase_prologue(Frame& F, const ArgsV& A_) {
    LAS float* scr = (LAS float*)(F.lds + F.wave * 16640);
    const int gw = F.bid * NWAVES + F.wave, NGW = F.G * NWAVES;
    bf16_t* WINT = (bf16_t*)(F.ws + WS_WINT); bf16_t* WOUTT = (bf16_t*)(F.ws + WS_WOUTT); bf16_t* W1T = (bf16_t*)(F.ws + WS_W1T); bf16_t* W2T = (bf16_t*)(F.ws + WS_W2T);
    constexpr int I_IN = NL * 16 * 40, I_OUT = NL * 16 * 16, I_W1 = NL * NE * 16 * 32, I_W2 = NL * NE * 16 * 16;
    const float* w_in = A_.in[3]; const float* w_out = A_.in[20]; const float* w1 = A_.in[25]; const float* w2 = A_.in[27];
    for (int it = gw; it < I_IN + I_OUT + I_W1 + I_W2; it += NGW) {
        int r = it;
        if (r < I_W1) { const int le = r / (16 * 32), q = r % (16 * 32), kb = q / 32, nb = q % 32, n0 = nb * 64;
            const int drow = (n0 < 1024) ? ((n0 >> 7) * 256 + (n0 & 127)) : (((n0 - 1024) >> 7) * 256 + 128 + ((n0 - 1024) & 127));
            transpose_item(w1 + (size_t)le * 1024 * 2048, 2048, W1T + (size_t)le * 2048 * 1024, kb * 64, n0, drow, scr, F.lane); continue; }
        r -= I_W1;
        if (r < I_W2) { const int le = r / (16 * 16), q = r % (16 * 16), kb = q / 16, nb = q % 16;
            transpose_item(w2 + (size_t)le * 1024 * 1024, 1024, W2T + (size_t)le * 1024 * 1024, kb * 64, nb * 64, nb * 64, scr, F.lane); continue; }
        r -= I_W2;
        if (r < I_IN) { const int l = r / (16 * 40), q = r % (16 * 40), kb = q / 40, nb = q % 40, n0 = nb * 64;
            const int drow = (n0 < 1024) ? n0 : ((n0 < 1536) ? (2048 + n0 - 1024) : (n0 - 512));
            transpose_item(w_in + (size_t)l * 1024 * 2560, 2560, WINT + (size_t)l * 2560 * 1024, kb * 64, n0, drow, scr, F.lane); continue; }
        r -= I_IN;
        { const int l = r / (16 * 16), q = r % (16 * 16), kb = q / 16, nb = q % 16;
            transpose_item(w_out + (size_t)l * 1024 * 1024, 1024, WOUTT + (size_t)l * 1024 * 1024, kb * 64, nb * 64, nb * 64, scr, F.lane); }
    }
    float* HA = (float*)(F.ws + WS_HA); bf16_t* XB = (bf16_t*)(F.ws + WS_XB);
    for (int m = gw; m < T; m += NGW) {
        f32x4 v[4];
#pragma unroll
        for (int j = 0; j < 4; ++j) v[j] = *(const f32x4*)(A_.in[0] + (size_t)m * D + 4 * F.lane + 256 * j);
        ln_store(v, A_.in[1], A_.in[2], HA + (size_t)m * D, XB + (size_t)m * D, F.lane);
    }
}

constexpr int P2_KP = VA_PARK_OFF;
constexpr int P2_ORD = MISC_OFF + 1024;
constexpr int P2_FLG = MISC_OFF + 2304;
constexpr int CW_QUEUE = 20480;
constexpr size_t WS_KN = 768 * MiB + 512 * 1024;


constexpr int SEGT = 32, N_UNSPLIT = 400, N_SPLIT = 560, N_ITEMS = N_UNSPLIT + N_SPLIT;
struct ItemTabs { unsigned short item[1024]; unsigned short order[1024]; unsigned short segstart[128]; };
constexpr int west_of(int h) { return h == 0 ? 6 : (h == 1 ? 14 : (h == 2 ? 46 : 1000)); }
constexpr ItemTabs make_item_tabs() {
    ItemTabs t{}; int cost[1024] = {};
    for (int i = 0; i < 1024; ++i) { t.item[i] = 0; t.order[i] = 0; }
    for (int i = 0; i < 384; ++i) { const int h = i >> 7, qb = i & 127; t.item[i] = (unsigned short)(h | (qb << 2)); const int c = 2 * qb + 2; cost[i] = c < west_of(h) ? c : west_of(h); }
    for (int i = 384; i < 400; ++i) { const int qb = i - 384; t.item[i] = (unsigned short)(3 | (qb << 2)); cost[i] = 2 * qb + 2; }
    int n = 400;
    for (int qb = 0; qb < 128; ++qb) { t.segstart[qb] = (unsigned short)(n - 400);
        if (qb >= 16) { const int ns = (qb + 16) >> 4; for (int s = 0; s < ns; ++s) { t.item[n] = (unsigned short)(3 | (qb << 2) | (s << 9) | 0x8000); const int rem = 2 * qb + 2 - SEGT * s; cost[n] = rem < SEGT ? rem : SEGT; ++n; } } }
    int k = 0;
    for (int c = 64; c >= 1; --c) for (int i = 0; i < n; ++i) if (cost[i] == c) t.order[k++] = (unsigned short)i;
    return t;
}
__device__ const ItemTabs g_tabs = make_item_tabs();
constexpr size_t WS_PART = WS_END;
constexpr size_t PART_WAVE = 16896, PART_SLOT = 8 * PART_WAVE;
constexpr size_t WS_END2 = WS_PART + (size_t)N_SPLIT * PART_SLOT + MiB;

namespace attn {
__device__ __forceinline__ int crow(int r, int hi) { return (r & 3) + 8 * (r >> 2) + 4 * hi; }
__device__ __forceinline__ int swz(int row, int chunk) { return row * 128 + ((chunk ^ ((row >> 1) & 7)) << 4); }
#define MFMA32(a, b, c) __builtin_amdgcn_mfma_f32_32x32x16_bf16(a, b, c, 0, 0, 0)

__device__ __forceinline__ void attn_finish(LAS unsigned char* lds, f32x16 (&O)[4], float lsum, bf16_t* MIX, const float* subg, float lam, float outscale, int h, int rowmin, int c, int rg, int lane) {
    const int ln = lane & 31, hi = lane >> 5;
    const float ltot = lsum + shx(lsum, lane << 2, 32);
    LAS float* ex = (LAS float*)lds;
    if (c == 1) {
        const float sc = lam / ltot;
#pragma unroll
        for (int db = 0; db < 4; ++db)
#pragma unroll
            for (int r = 0; r < 16; ++r) ex[(rg * 64 + db * 16 + r) * 64 + lane] = O[db][r] * sc;
    }
    __syncthreads();
    if (c == 0) {
        const float inv = 1.0f / ltot; float ss = 0.f;
#pragma unroll
        for (int db = 0; db < 4; ++db)
#pragma unroll
            for (int r = 0; r < 16; ++r) { const float o = O[db][r] * inv - ex[(rg * 64 + db * 16 + r) * 64 + lane]; O[db][r] = o; ss += o * o; }
        ss += shx(ss, lane << 2, 32);
        const float rn = __builtin_amdgcn_rsqf(ss * (1.0f / 128.0f) + LN_EPS) * outscale;
        bf16_t* op = MIX + (size_t)(rowmin + ln) * 1024 + h * 128 + 4 * hi;
#pragma unroll
        for (int db = 0; db < 4; ++db)
#pragma unroll
            for (int g = 0; g < 4; ++g) { const int dv0 = 32 * db + 8 * g;
                const f32x4 gv = *(const f32x4*)(subg + dv0 + 4 * hi);
                u32x2 wv; wv.x = cvt_pk_bf16(O[db][4 * g + 0] * rn * gv.x, O[db][4 * g + 1] * rn * gv.y); wv.y = cvt_pk_bf16(O[db][4 * g + 2] * rn * gv.z, O[db][4 * g + 3] * rn * gv.w);
                *(u32x2*)(op + dv0) = wv; }
    }
    __syncthreads();
}
__device__ __forceinline__ void attn_unit(LAS unsigned char* lds, const unsigned char* wsb, bf16_t* MIX, const float* subg, float lam, float outscale, int h, int qb, int jt_top, int jt_bot, float* part, const int tid) {
    const int w = __builtin_amdgcn_readfirstlane(tid >> 6), lane = tid & 63, ln = lane & 31, hi = lane >> 5;
    const int c = w >> 2, rg = w & 3;
    const int i0 = qb * 128, rowmin = i0 + 32 * rg;
    const float slope2 = __builtin_amdgcn_exp2f(-2.0f * (float)(h + 1)) * LOG2E;
    const LAS float* kp = (const LAS float*)(lds + P2_KP) + (h * 2 + c) * 256;
    volatile LAS unsigned* flg = (volatile LAS unsigned*)(lds + P2_FLG);
    const bf16_t* U = (const bf16_t*)(wsb + WS_U);
    bf16x8 Qf[4];
    { const bf16_t* qp = U + (size_t)(rowmin + ln) * NCOLA + UQ + h * 128 + c * 64 + 8 * hi;
#pragma unroll
      for (int ks = 0; ks < 4; ++ks) Qf[ks] = *(const bf16x8*)(qp + 16 * ks); }
    float qn;
    { float ss = 0.f;
#pragma unroll
      for (int ks = 0; ks < 4; ++ks)
#pragma unroll
          for (int j = 0; j < 8; ++j) { const float v = bf2f((bf16_t)Qf[ks][j]); ss += v * v; }
      ss += shx(ss, lane << 2, 32); qn = fsqrt(ss) * 1.001f; }
    float mlb = -__builtin_inff();
    if (jt_top < 2 * qb + 1) { const bf16_t* kd = U + (size_t)(rowmin + ln) * NCOLA + UK + h * 128 + c * 64 + 8 * hi; float dd = 0.f;
#pragma unroll
        for (int ks = 0; ks < 4; ++ks) { const bf16x8 kv = *(const bf16x8*)(kd + 16 * ks);
#pragma unroll
            for (int j = 0; j < 8; ++j) dd += bf2f((bf16_t)Qf[ks][j]) * bf2f((bf16_t)kv[j]); }
        dd += shx(dd, lane << 2, 32); mlb = dd + slope2 * (float)(rowmin + ln - i0) - 0.01f; }
    unsigned kso0, kso1, vso0, vso1;
    { const int r8 = lane >> 3, cp = lane & 7;
      { const int key = 8 * ((2 * w) & 7) + r8, ch = cp ^ ((key >> 1) & 7); kso0 = (unsigned)WS_U + (unsigned)(key * NCOLA + UK + h * 128 + c * 64 + ch * 8) * 2u; }
      { const int key = 8 * ((2 * w + 1) & 7) + r8, ch = cp ^ ((key >> 1) & 7); kso1 = (unsigned)WS_U + (unsigned)(key * NCOLA + UK + h * 128 + c * 64 + ch * 8) * 2u; }
      { const int dv = 8 * (2 * w) + r8, ch = cp ^ ((dv >> 1) & 7); vso0 = (unsigned)WS_VT + (unsigned)((h * 128 + dv) * T + ch * 8) * 2u; }
      { const int dv = 8 * (2 * w + 1) + r8, ch = cp ^ ((dv >> 1) & 7); vso1 = (unsigned)WS_VT + (unsigned)((h * 128 + dv) * T + ch * 8) * 2u; } }
    int o4[4];
#pragma unroll
    for (int j = 0; j < 4; ++j) o4[j] = ln * 128 + (((2 * j + hi) ^ ((ln >> 1) & 7)) << 4);
    f32x16 O[4];
#pragma unroll
    for (int db = 0; db < 4; ++db)
#pragma unroll
        for (int r = 0; r < 16; ++r) O[db][r] = 0.f;
    float m = -__builtin_inff(), lsum = 0.f, al_pend = 1.0f;
    const int jt_hi = jt_top;
#define AB(t) (((jt_hi - (t)) & 3) * 32768)
#define A_GLDS(gp, lp) __builtin_amdgcn_global_load_lds((const unsigned*)(gp), (LAS unsigned*)(lp), 16, 0, 0)
#define A_GL(t) do { const unsigned kb_ = (unsigned)(t) * (unsigned)(64 * NCOLA * 2), vb_ = (unsigned)(t) * 128u; LAS unsigned char* d_ = lds + AB(t) + w * 2048; \
        A_GLDS(wsb + (size_t)(kso0 + kb_), d_); A_GLDS(wsb + (size_t)(kso1 + kb_), d_ + 1024); A_GLDS(wsb + (size_t)(vso0 + vb_), d_ + 16384); A_GLDS(wsb + (size_t)(vso1 + vb_), d_ + 16384 + 1024); } while (0)
#define A_BAR() do { asm volatile("s_waitcnt lgkmcnt(0)" ::: "memory"); __builtin_amdgcn_s_barrier(); asm volatile("" ::: "memory"); } while (0)
#define SB0 __builtin_amdgcn_sched_barrier(0)
#define A_QK(t) do { const LAS unsigned char* b_ = lds + AB(t) + c * 8192; float sl_ = slope2; asm volatile("" : "+v"(sl_)); const float b0_ = sl_ * (float)((t) * 64 + 4 * hi - i0), b1_ = __builtin_fmaf(sl_, 32.0f, b0_); \
        _Pragma("unroll") for (int r = 0; r < 16; ++r) { s0[r] = __builtin_fmaf(sl_, (float)((r & 3) + 8 * (r >> 2)), b0_); s1[r] = __builtin_fmaf(sl_, (float)((r & 3) + 8 * (r >> 2)), b1_); } \
        _Pragma("unroll") for (int ks = 0; ks < 4; ++ks) { const bf16x8 k0_ = *(const LAS bf16x8*)(b_ + o4[ks]); const bf16x8 k1_ = *(const LAS bf16x8*)(b_ + o4[ks] + 4096); \
            s0 = MFMA32(k0_, Qf[ks], s0); s1 = MFMA32(k1_, Qf[ks], s1); } } while (0)
#define A_PVG(b_, db) do { _Pragma("unroll") for (int g = 0; g < 4; ++g) { const bf16x8 vf_ = *(const LAS bf16x8*)((b_) + o4[g] + (db) * 4096); O[db] = MFMA32(vf_, Pf[g], O[db]); } } while (0)
#define A_PV(t) do { const LAS unsigned char* b_ = lds + AB(t) + 16384; A_PVG(b_, 0); SB0; A_PVG(b_, 1); SB0; A_PVG(b_, 2); SB0; A_PVG(b_, 3); SB0; } while (0)
#define A_MASK(t) do { const int j0_ = (t) * 64; if (j0_ + 63 > rowmin) { const int qrow_ = rowmin + ln; \
            _Pragma("unroll") for (int r = 0; r < 16; ++r) { const int key_ = j0_ + crow(r, hi); if (key_ > qrow_) s0[r] = -__builtin_inff(); if (key_ + 32 > qrow_) s1[r] = -__builtin_inff(); } } } while (0)
#define A_SM_MAX() float mx_ = fmaxf(s0[0], s1[0]); \
        _Pragma("unroll") for (int r = 1; r < 16; ++r) mx_ = fmaxf(mx_, fmaxf(s0[r], s1[r])); \
        mx_ = fmaxf(mx_, shx(mx_, lane << 2, 32));
#define A_SM_NEWMAX() const float mn_ = fmaxf(m, mx_); const float al_ = __builtin_amdgcn_exp2f(m - mn_); al_pend = al_; m = mn_;
#define A_SM_EXP(sv) _Pragma("unroll") for (int r = 0; r < 16; ++r) sv[r] = __builtin_amdgcn_exp2f(sv[r] - mn_);
#define A_SM_FIN() float ps_ = 0.f; \
        _Pragma("unroll") for (int r = 0; r < 16; ++r) ps_ += s0[r] + s1[r]; \
        lsum = lsum * al_ + ps_; \
        _Pragma("unroll") for (int s2 = 0; s2 < 2; ++s2) { u32x4 a_, b2_; \
            a_.x = cvt_pk_bf16(s0[8 * s2 + 0], s0[8 * s2 + 1]); a_.y = cvt_pk_bf16(s0[8 * s2 + 2], s0[8 * s2 + 3]); a_.z = cvt_pk_bf16(s0[8 * s2 + 4], s0[8 * s2 + 5]); a_.w = cvt_pk_bf16(s0[8 * s2 + 6], s0[8 * s2 + 7]); \
            b2_.x = cvt_pk_bf16(s1[8 * s2 + 0], s1[8 * s2 + 1]); b2_.y = cvt_pk_bf16(s1[8 * s2 + 2], s1[8 * s2 + 3]); b2_.z = cvt_pk_bf16(s1[8 * s2 + 4], s1[8 * s2 + 5]); b2_.w = cvt_pk_bf16(s1[8 * s2 + 6], s1[8 * s2 + 7]); \
            Pn[s2] = __builtin_bit_cast(bf16x8, a_); Pn[2 + s2] = __builtin_bit_cast(bf16x8, b2_); }
#define A_SOFTMAX(t) do { A_MASK(t); A_SM_MAX(); A_SM_NEWMAX(); A_SM_EXP(s0); A_SM_EXP(s1); A_SM_FIN(); } while (0)
#define A_FUSED(t) do { A_QK((t) - 1); SB0; const LAS unsigned char* vb2_ = lds + AB(t) + 16384; \
        A_PVG(vb2_, 0); A_SM_MAX(); SB0; \
        A_PVG(vb2_, 1); A_SM_NEWMAX(); A_SM_EXP(s0); SB0; \
        A_PVG(vb2_, 2); A_SM_EXP(s1); SB0; \
        A_PVG(vb2_, 3); A_SM_FIN(); SB0; } while (0)
    A_GL(jt_hi); A_GL(jt_hi - 1);
    if (jt_hi - 2 >= jt_bot) { A_GL(jt_hi - 2); asm volatile("s_waitcnt vmcnt(4)" ::: "memory"); } else asm volatile("s_waitcnt vmcnt(0)" ::: "memory");
    A_BAR();
    bool done = false, hasP = false;
    bf16x8 Pf[4], Pn[4];
    f32x16 s0, s1;
    if (jt_hi * 64 <= rowmin + 31) { A_QK(jt_hi); A_SOFTMAX(jt_hi); hasP = true;
#pragma unroll
        for (int g = 0; g < 4; ++g) Pf[g] = Pn[g]; }
    for (int jt = jt_hi; jt >= jt_bot; --jt) {
        const int cur = (jt_hi - jt) & 1;
        if (jt - 3 >= jt_bot) A_GL(jt - 3);
        if (__any(al_pend != 1.0f)) {
#pragma unroll
            for (int db = 0; db < 4; ++db)
#pragma unroll
                for (int r = 0; r < 16; ++r) O[db][r] *= al_pend;
        }
        al_pend = 1.0f;
        bool nvalid = (jt - 1 >= jt_bot) && !done && ((jt - 1) * 64 <= rowmin + 31);
        if (nvalid) {
            const float bnd = qn * kp[jt - 1] - fmaxf(m, mlb) + slope2 * (float)((jt - 1) * 64 + 63 - i0);
            if (__all(bnd < -48.0f)) { done = true; nvalid = false; }
        }
        if (hasP && nvalid) { if ((jt - 1) * 64 + 63 > rowmin) { A_PV(jt); A_QK(jt - 1); A_SOFTMAX(jt - 1); } else { A_FUSED(jt); } }
        else if (hasP) { A_PV(jt); }
        else if (nvalid) { A_QK(jt - 1); A_SOFTMAX(jt - 1); }
        hasP = nvalid;
        if (nvalid) {
#pragma unroll
            for (int g = 0; g < 4; ++g) Pf[g] = Pn[g]; }
        if (lane == 0) flg[cur * 8 + w] = done ? 1u : 0u;
        if (jt - 3 >= jt_bot) asm volatile("s_waitcnt vmcnt(4)" ::: "memory"); else asm volatile("s_waitcnt vmcnt(0)" ::: "memory");
        A_BAR();
        { const u32x4 f0 = *(const LAS u32x4*)(lds + P2_FLG + cur * 32), f1 = *(const LAS u32x4*)(lds + P2_FLG + cur * 32 + 16);
          if ((f0.x & f0.y & f0.z & f0.w & f1.x & f1.y & f1.z & f1.w) != 0u) break; }
    }
    asm volatile("s_waitcnt vmcnt(0)" ::: "memory");
    A_BAR();
#undef AB
#undef A_GLDS
#undef A_GL
#undef A_BAR
#undef SB0
#undef A_QK
#undef A_PVG
#undef A_PV
#undef A_MASK
#undef A_SM_MAX
#undef A_SM_NEWMAX
#undef A_SM_EXP
#undef A_SM_FIN
#undef A_SOFTMAX
#undef A_FUSED
    if (part) {
        float* pw = part + (size_t)w * (PART_WAVE / 4);
#pragma unroll
        for (int db = 0; db < 4; ++db)
#pragma unroll
            for (int r = 0; r < 16; ++r) pw[(db * 16 + r) * 64 + lane] = O[db][r];
        pw[4096 + lane] = m; pw[4160 + lane] = lsum;
    } else attn_finish(lds, O, lsum, MIX, subg, lam, outscale, h, rowmin, c, rg, lane);
}
__device__ __forceinline__ void attn_combine(LAS unsigned char* lds, const unsigned char* wsb, bf16_t* MIX, const float* subg, float lam, float outscale, int qb, const int tid) {
    const int w = __builtin_amdgcn_readfirstlane(tid >> 6), lane = tid & 63, c = w >> 2, rg = w & 3;
    const int nseg = (qb + 16) >> 4, slot0 = g_tabs.segstart[qb];
    const float* pb = (const float*)(wsb + WS_PART) + (size_t)slot0 * (PART_SLOT / 4) + (size_t)w * (PART_WAVE / 4);
    float M = -__builtin_inff();
    for (int s = 0; s < nseg; ++s) M = fmaxf(M, pb[(size_t)s * (PART_SLOT / 4) + 4096 + lane]);
    f32x16 O[4];
#pragma unroll
    for (int db = 0; db < 4; ++db)
#pragma unroll
        for (int r = 0; r < 16; ++r) O[db][r] = 0.f;
    float lsum = 0.f;
    for (int s = 0; s < nseg; ++s) { const float* ps = pb + (size_t)s * (PART_SLOT / 4);
        const float sc = __builtin_amdgcn_exp2f(ps[4096 + lane] - M); lsum += sc * ps[4160 + lane];
#pragma unroll
        for (int db = 0; db < 4; ++db)
#pragma unroll
            for (int r = 0; r < 16; ++r) O[db][r] += sc * ps[(db * 16 + r) * 64 + lane]; }
    attn_finish(lds, O, lsum, MIX, subg, lam, outscale, 3, qb * 128 + 32 * rg, c, rg, lane);
}
#undef MFMA32
}

__device__ __forceinline__ void phase_knorm(Frame& F) {
    const bf16_t* U = (const bf16_t*)(F.ws + WS_U); float* KN = (float*)(F.ws + WS_KN);
    const int gw = F.bid * NWAVES + F.wave, NGW = F.G * NWAVES;
    for (int item = gw; item < 2048; item += NGW) {
        const int hc = item >> 8, jt = item & 255;
        const bf16_t* kr = U + (size_t)(jt * 64 + F.lane) * NCOLA + UK + hc * 64;
        float ss = 0.f;
#pragma unroll
        for (int q = 0; q < 8; ++q) { const u32x4 v = *(const u32x4*)(kr + 8 * q);
            ss += bflo(v.x) * bflo(v.x) + bfhi(v.x) * bfhi(v.x) + bflo(v.y) * bflo(v.y) + bfhi(v.y) * bfhi(v.y) + bflo(v.z) * bflo(v.z) + bfhi(v.z) * bfhi(v.z) + bflo(v.w) * bflo(v.w) + bfhi(v.w) * bfhi(v.w); }
#pragma unroll
        for (int o = 1; o < 64; o <<= 1) ss = fmaxf(ss, shx(ss, F.lane << 2, o));
        if (F.lane == 0) KN[item] = ss;
    }
}

__device__ __forceinline__ void lru_unit(Frame& F, const ArgsV& A_, int l, int unit) {
    const bf16_t* U = (const bf16_t*)(F.ws + WS_U);
    float* HLOC = (float*)(F.ws + WS_HLOC); float* CUMA = (float*)(F.ws + WS_CUMA); float* AGG = (float*)(F.ws + WS_AGG);
    const float* cw = A_.in[9] + l * 4 * 256; const float* cb = A_.in[10] + l * 256;
    const float* wa = A_.in[11] + l * 4 * 4096; const float* ba = A_.in[12] + l * 256;
    const float* wx = A_.in[13] + l * 4 * 4096; const float* bx = A_.in[14] + l * 256; const float* lamp = A_.in[15] + l * 256;
    LAS float* wA = (LAS float*)F.lds; LAS float* wX = wA + 4096; LAS float* xc = wA + 8192; LAS float* wagg = wA + 8192 + 16384;
    const int w = F.wave, d = F.lane;
    const int chunk = unit >> 2, blk = unit & 3, t0 = chunk * 256, ch0 = blk * 64;
    for (int i = F.tid; i < 1024; i += NTHREADS) { *(LAS f32x4*)(wA + 4 * i) = *(const f32x4*)(wa + blk * 4096 + 4 * i); *(LAS f32x4*)(wX + 4 * i) = *(const f32x4*)(wx + blk * 4096 + 4 * i); }
    {
      const int g8 = F.tid & 7, chb = ch0 + 8 * g8;
      f32x4 wv[4][2], bv[2];
#pragma unroll
      for (int j = 0; j < 4; ++j) { wv[j][0] = *(const f32x4*)(cw + j * 256 + chb); wv[j][1] = *(const f32x4*)(cw + j * 256 + chb + 4); }
      bv[0] = *(const f32x4*)(cb + chb); bv[1] = *(const f32x4*)(cb + chb + 4);
#pragma unroll
      for (int k = 0; k < 4; ++k) { const int t = (F.tid >> 3) + 64 * k, tt = t0 + t;
          f32x4 a0 = bv[0], a1 = bv[1];
#pragma unroll
          for (int j = 0; j < 4; ++j) { const int ts = tt - 3 + j;
              if (ts >= 0) { const u32x4 x = *(const u32x4*)(U + (size_t)ts * NCOLA + ULX + chb);
                  a0.x += wv[j][0].x * bflo(x.x); a0.y += wv[j][0].y * bfhi(x.x); a0.z += wv[j][0].z * bflo(x.y); a0.w += wv[j][0].w * bfhi(x.y);
                  a1.x += wv[j][1].x * bflo(x.z); a1.y += wv[j][1].y * bfhi(x.z); a1.z += wv[j][1].z * bflo(x.w); a1.w += wv[j][1].w * bfhi(x.w); } }
          *(LAS f32x4*)(xc + t * 64 + 8 * g8) = a0; *(LAS f32x4*)(xc + t * 64 + 8 * g8 + 4) = a1; } }
    __syncthreads();
    float ga[32], gx[32];
#pragma unroll
    for (int tt = 0; tt < 32; ++tt) { ga[tt] = 0.f; gx[tt] = 0.f; }
    for (int c4 = 0; c4 < 16; ++c4) {
        const float wa0 = wA[(4 * c4 + 0) * 64 + d], wa1 = wA[(4 * c4 + 1) * 64 + d], wa2 = wA[(4 * c4 + 2) * 64 + d], wa3 = wA[(4 * c4 + 3) * 64 + d];
        const float wx0 = wX[(4 * c4 + 0) * 64 + d], wx1 = wX[(4 * c4 + 1) * 64 + d], wx2 = wX[(4 * c4 + 2) * 64 + d], wx3 = wX[(4 * c4 + 3) * 64 + d];
#pragma unroll
        for (int tt = 0; tt < 32; ++tt) { const f32x4 x = *(const LAS f32x4*)(xc + (32 * w + tt) * 64 + 4 * c4);
            ga[tt] += x.x * wa0 + x.y * wa1 + x.z * wa2 + x.w * wa3; gx[tt] += x.x * wx0 + x.y * wx1 + x.z * wx2 + x.w * wx3; } }
    const int ch = ch0 + d; const float bav = ba[ch], bxv = bx[ch];
    const float sp = flog(1.0f + fexp(-lamp[ch]));
    float hl = 0.f, ca = 1.f;
#pragma unroll
    for (int tt = 0; tt < 32; ++tt) {
        const float sa = sigmoidf_(ga[tt] + bav), sx = sigmoidf_(gx[tt] + bxv);
        const float log_a = -8.0f * sa * sp, a = fexp(log_a), mult = fsqrt(fmaxf(1.0f - a * a, 0.f));
        const float b = mult * sx * xc[(32 * w + tt) * 64 + d];
        hl = a * hl + b; ca *= a; ga[tt] = hl; gx[tt] = ca;
    }
    wagg[(w * 2 + 0) * 64 + d] = ca; wagg[(w * 2 + 1) * 64 + d] = hl;
    __syncthreads();
    float cin = 0.f, cprod = 1.f;
    for (int w2 = 0; w2 < w; ++w2) { const float A2 = wagg[(w2 * 2 + 0) * 64 + d], B2 = wagg[(w2 * 2 + 1) * 64 + d]; cin = A2 * cin + B2; cprod *= A2; }
#pragma unroll
    for (int tt = 0; tt < 32; ++tt) { const size_t o = (size_t)(t0 + 32 * w + tt) * 256 + ch; const float hh = ga[tt] + gx[tt] * cin, cA = gx[tt] * cprod; HLOC[o] = hh; CUMA[o] = cA;
        if (w == 7 && tt == 31) { AGG[(chunk * 2 + 0) * 256 + ch] = cA; AGG[(chunk * 2 + 1) * 256 + ch] = hh; } }
    __syncthreads();
}

__device__ __forceinline__ void conf_unit(Frame& F, const ArgsV& A_, int l, int unit) {
    const bf16_t* U = (const bf16_t*)(F.ws + WS_U); bf16_t* MIX = (bf16_t*)(F.ws + WS_MIX);
    const float* cw = A_.in[16] + l * 31 * 256; const float* cb = A_.in[17] + l * 256; const float* lg = A_.in[18] + l * 256; const float* lb = A_.in[19] + l * 256;
    LAS float* gin = (LAS float*)F.lds; LAS float* cout = gin + 62 * 256;
    const int ch = F.tid & 255, half = F.tid >> 8, t0 = unit * 32;
    for (int it = F.tid; it < 62 * 32; it += NTHREADS) { const int r = it >> 5, g8 = it & 31, ts = t0 - 30 + r;
        f32x4 v0 = (f32x4){0.f, 0.f, 0.f, 0.f}, v1 = v0;
        if (ts >= 0) { const u32x4 a = *(const u32x4*)(U + (size_t)ts * NCOLA + UCA + 8 * g8), b = *(const u32x4*)(U + (size_t)ts * NCOLA + UCB + 8 * g8);
            v0.x = bflo(a.x) * sigmoidf_(bflo(b.x)); v0.y = bfhi(a.x) * sigmoidf_(bfhi(b.x)); v0.z = bflo(a.y) * sigmoidf_(bflo(b.y)); v0.w = bfhi(a.y) * sigmoidf_(bfhi(b.y));
            v1.x = bflo(a.z) * sigmoidf_(bflo(b.z)); v1.y = bfhi(a.z) * sigmoidf_(bfhi(b.z)); v1.z = bflo(a.w) * sigmoidf_(bflo(b.w)); v1.w = bfhi(a.w) * sigmoidf_(bfhi(b.w)); }
        *(LAS f32x4*)(gin + r * 256 + 8 * g8) = v0; *(LAS f32x4*)(gin + r * 256 + 8 * g8 + 4) = v1; }
    float wreg[31];
#pragma unroll
    for (int j = 0; j < 31; ++j) wreg[j] = cw[j * 256 + ch];
    const float bb = cb[ch];
    __syncthreads();
    { float x[46];
#pragma unroll
      for (int k = 0; k < 46; ++k) x[k] = gin[(half * 16 + k) * 256 + ch];
#pragma unroll
      for (int tt = 0; tt < 16; ++tt) { float a = bb;
#pragma unroll
          for (int j = 0; j < 31; ++j) a += wreg[j] * x[tt + j];
          cout[(half * 16 + tt) * 256 + ch] = a; } }
    __syncthreads();
#pragma unroll
    for (int q = 0; q < 4; ++q) { const int t = 4 * F.wave + q;
        f32x4 v = *(const LAS f32x4*)(cout + t * 256 + 4 * F.lane);
        const float mean = wave_sum((v.x + v.y) + (v.z + v.w), F.lane << 2) * (1.f / 256.f); v = v - mean;
        const float var = wave_sum((v.x * v.x + v.y * v.y) + (v.z * v.z + v.w * v.w), F.lane << 2) * (1.f / 256.f), rstd = __builtin_amdgcn_rsqf(var + LN_EPS);
        const f32x4 gv = *(const f32x4*)(lg + 4 * F.lane), bv = *(const f32x4*)(lb + 4 * F.lane);
        f32x4 y = v * rstd * gv + bv;
        y.x = y.x * sigmoidf_(y.x); y.y = y.y * sigmoidf_(y.y); y.z = y.z * sigmoidf_(y.z); y.w = y.w * sigmoidf_(y.w);
        u32x2 wv; wv.x = pk2(y.x, y.y); wv.y = pk2(y.z, y.w);
        *(u32x2*)(MIX + (size_t)(t0 + t) * 1024 + 768 + 4 * F.lane) = wv; }
    __syncthreads();
}

__device__ __forceinline__ void phase_mixers(Frame& F, const ArgsV& A_, int l, int probe) {
    const bf16_t* U = (const bf16_t*)(F.ws + WS_U); const bf16_t* VT = (const bf16_t*)(F.ws + WS_VT); bf16_t* MIX = (bf16_t*)(F.ws + WS_MIX);
    { const float* KN = (const float*)(F.ws + WS_KN); LAS float* kp = (LAS float*)(F.lds + P2_KP);
      const int tb = F.wave, ln = F.lane;
      const f32x4 v = *(const f32x4*)(KN + tb * 256 + 4 * ln);
      const float p0 = v.x, p1 = fmaxf(p0, v.y), p2 = fmaxf(p1, v.z), p3 = fmaxf(p2, v.w);
      float run = p3;
#pragma unroll
      for (int o = 1; o < 64; o <<= 1) { const float t = shup(run, ln << 2, o); if (ln >= o) run = fmaxf(run, t); }
      float ex = shup(run, ln << 2, 1); if (ln == 0) ex = 0.f;
      f32x4 o4; o4.x = fsqrt(fmaxf(ex, p0)); o4.y = fsqrt(fmaxf(ex, p1)); o4.z = fsqrt(fmaxf(ex, p2)); o4.w = fsqrt(fmaxf(ex, p3));
      *(LAS f32x4*)(kp + tb * 256 + 4 * ln) = o4;
    }
    float d1 = 0.f, d2 = 0.f;
    { const float* lq1 = A_.in[4] + l * 64; const float* lk1 = A_.in[5] + l * 64; const float* lq2 = A_.in[6] + l * 64; const float* lk2 = A_.in[7] + l * 64;
      d1 = wave_sum(lq1[F.lane] * lk1[F.lane], F.lane << 2); d2 = wave_sum(lq2[F.lane] * lk2[F.lane], F.lane << 2); }
    const float lam_init = 0.8f - 0.6f * fexp(-0.3f * (float)l);
    const float lam = fexp(d1) - fexp(d2) + lam_init;
    const float* subg = A_.in[8] + l * 128;
    unsigned* qhead = (unsigned*)(F.ws + WS_CTL) + CW_QUEUE + 64 * l;
    volatile LAS unsigned* slot = (volatile LAS unsigned*)(F.lds + P2_FLG) + 16;
    __syncthreads();
    for (;;) {
        if (F.tid == 0) slot[0] = atomicAdd(qhead, 1u);
        __syncthreads();
        const int q = (int)__builtin_amdgcn_readfirstlane(slot[0]);
        __syncthreads();
        if (q >= N_ITEMS + 256 + 512) break;
        if (probe) {
            if (probe == 1 && q >= N_ITEMS) continue;
            if (probe == 2 && (q < N_ITEMS || q >= N_ITEMS + 256)) continue;
            if (probe == 3 && q < N_ITEMS + 256) continue;
            if (probe >= 4 && probe <= 7 && (q >= N_ITEMS || (g_tabs.item[g_tabs.order[q]] & 3) != probe - 4)) continue;
        }
        Frame Fu = make_frame(F.lds, F.ws);
        if (q < N_ITEMS) { const int idx = g_tabs.order[q], it = g_tabs.item[idx]; const int h = it & 3, qb = (it >> 2) & 127;
            if (it & 0x8000) { const int seg = (it >> 9) & 7, jt_top = 2 * qb + 1 - SEGT * seg; const int jb = jt_top - (SEGT - 1);
                attn::attn_unit(Fu.lds, (const unsigned char*)Fu.ws, (bf16_t*)(Fu.ws + WS_MIX), subg, lam, 1.0f - lam_init, h, qb, jt_top, jb > 0 ? jb : 0, (float*)(Fu.ws + WS_PART) + (size_t)(idx - N_UNSPLIT) * (PART_SLOT / 4), Fu.tid); }
            else attn::attn_unit(Fu.lds, (const unsigned char*)Fu.ws, (bf16_t*)(Fu.ws + WS_MIX), subg, lam, 1.0f - lam_init, h, qb, 2 * qb + 1, 0, nullptr, Fu.tid); }
        else if (q < N_ITEMS + 256) lru_unit(Fu, A_, l, q - N_ITEMS);
        else conf_unit(Fu, A_, l, q - N_ITEMS - 256);
    }
}

__device__ __forceinline__ void phase_lru_fix(Frame& F, const ArgsV& A_, int l) {
    const bf16_t* U = (const bf16_t*)(F.ws + WS_U); bf16_t* MIX = (bf16_t*)(F.ws + WS_MIX);
    const float* HLOC = (const float*)(F.ws + WS_HLOC); const float* CUMA = (const float*)(F.ws + WS_CUMA); const float* AGG = (const float*)(F.ws + WS_AGG);
    LAS float* ag = (LAS float*)F.lds;
    const int ch = F.tid & 255, half = F.tid >> 8;
    for (int unit = F.bid; unit < 256; unit += F.G) {
        const int chunk = unit >> 2, qt = unit & 3, t0 = chunk * 256 + qt * 64 + half * 32;
        for (int i = F.tid; i < chunk * 128; i += NTHREADS) *(LAS f32x4*)(ag + 4 * i) = *(const f32x4*)(AGG + 4 * i);
        __syncthreads();
        float cin = 0.f;
        for (int k = 0; k < chunk; ++k) cin = ag[(k * 2 + 0) * 256 + ch] * cin + ag[(k * 2 + 1) * 256 + ch];
        for (int t = 0; t < 32; ++t) { const size_t tt = (size_t)(t0 + t);
            const float hh = HLOC[tt * 256 + ch] + CUMA[tt * 256 + ch] * cin;
            const float y = bf2f(U[tt * NCOLA + ULY + ch]);
            const float gl = y * frcp(1.0f + fexp(-2.0f * 0.7978845608028654f * (y + 0.044715f * y * y * y)));
            MIX[tt * 1024 + 512 + ch] = (bf16_t)f2bf(hh * gl); }
        __syncthreads();
    }
    { const float* lq1 = A_.in[4] + l * 64; const float* lk1 = A_.in[5] + l * 64; const float* lq2 = A_.in[6] + l * 64; const float* lk2 = A_.in[7] + l * 64;
      const float d1 = wave_sum(lq1[F.lane] * lk1[F.lane], F.lane << 2), d2 = wave_sum(lq2[F.lane] * lk2[F.lane], F.lane << 2);
      const float lam_init = 0.8f - 0.6f * fexp(-0.3f * (float)l), lam = fexp(d1) - fexp(d2) + lam_init;
      for (int unit = F.bid; unit < 112; unit += F.G) attn::attn_combine(F.lds, (const unsigned char*)F.ws, MIX, A_.in[8] + l * 128, lam, 1.0f - lam_init, 16 + unit, F.tid); }
}

__device__ __forceinline__ void phase_ln1(Frame& F, const ArgsV& A_, int l) {
    const float* HA = (const float*)(F.ws + WS_HA); const float* MO = (const float*)(F.ws + WS_MIXO); float* HB = (float*)(F.ws + WS_HB); bf16_t* XB = (bf16_t*)(F.ws + WS_XB);
    const int gw = F.bid * NWAVES + F.wave, NGW = F.G * NWAVES;
    for (int m = gw; m < T; m += NGW) {
        f32x4 v[4];
#pragma unroll
        for (int j = 0; j < 4; ++j) v[j] = *(const f32x4*)(HA + (size_t)m * D + 4 * F.lane + 256 * j) * ALPHA + *(const f32x4*)(MO + (size_t)m * D + 4 * F.lane + 256 * j);
        ln_store(v, A_.in[21] + l * D, A_.in[22] + l * D, HB + (size_t)m * D, XB + (size_t)m * D, F.lane);
    }
}

__device__ __forceinline__ void phase_router(Frame& F, const ArgsV& A_, int l) {
    const float* HB = (const float*)(F.ws + WS_HB); const float* rw = A_.in[23] + (size_t)l * 1024 * 32; const float* rb = A_.in[24] + l * 32;
    int* TKS = (int*)(F.ws + WS_TKS); float* TKG = (float*)(F.ws + WS_TKG); int* LIST = (int*)(F.ws + WS_LIST);
    unsigned* gcnt = (unsigned*)(F.ws + WS_CTL) + CW_CNT + l * 64;
    LAS float* part = (LAS float*)F.lds;
    LAS float* lg = (LAS float*)(F.lds + 65536);
    LAS unsigned* lcnt = (LAS unsigned*)(F.lds + 81920);
    const int ln = F.lane & 31, hf = F.lane >> 5, kb = F.wave * 128;
    float rwv[16][4];
#pragma unroll
    for (int i = 0; i < 16; ++i)
#pragma unroll
        for (int s = 0; s < 4; ++s) rwv[i][s] = rw[(size_t)(kb + 8 * i + 4 * hf + s) * 32 + ln];
    for (int base = F.bid * 64; base < T; base += F.G * 64) {
        if (F.tid < 64) lcnt[F.tid] = 0u;
#pragma unroll
        for (int g = 0; g < 2; ++g) {
            f32x4 hv[16];
            const float* hp = HB + (size_t)(base + 32 * g + ln) * D + kb + 4 * hf;
#pragma unroll
            for (int i = 0; i < 16; ++i) hv[i] = *(const f32x4*)(hp + 8 * i);
            f32x16 acc;
#pragma unroll
            for (int r = 0; r < 16; ++r) acc[r] = 0.f;
#pragma unroll
            for (int i = 0; i < 16; ++i) {
                acc = __builtin_amdgcn_mfma_f32_32x32x2f32(rwv[i][0], hv[i].x, acc, 0, 0, 0);
                acc = __builtin_amdgcn_mfma_f32_32x32x2f32(rwv[i][1], hv[i].y, acc, 0, 0, 0);
                acc = __builtin_amdgcn_mfma_f32_32x32x2f32(rwv[i][2], hv[i].z, acc, 0, 0, 0);
                acc = __builtin_amdgcn_mfma_f32_32x32x2f32(rwv[i][3], hv[i].w, acc, 0, 0, 0);
            }
#pragma unroll
            for (int r = 0; r < 16; ++r) { const int e = (r & 3) + 8 * (r >> 2) + 4 * hf; part[((F.wave * 2 + g) * 32 + e) * 32 + ln] = acc[r]; }
        }
        __syncthreads();
        { const int tt = F.tid & 63, eg = F.tid >> 6;
#pragma unroll
          for (int q = 0; q < 4; ++q) { const int e = 4 * eg + q; float s = rb[e];
#pragma unroll
              for (int w2 = 0; w2 < 8; ++w2) s += part[((w2 * 2 + (tt >> 5)) * 32 + e) * 32 + (tt & 31)];
              lg[tt * 33 + e] = s; } }
        __syncthreads();
        int sel[4]; float sv[4]; int pos[4];
        if (F.tid < 64) {
            float v[32];
#pragma unroll
            for (int e = 0; e < 32; ++e) v[e] = lg[F.tid * 33 + e];
#pragma unroll
            for (int k = 0; k < 4; ++k) { float best = -__builtin_inff(); int bi = 0;
#pragma unroll
                for (int e = 0; e < 32; ++e) { if (v[e] > best) { best = v[e]; bi = e; } }
                sel[k] = bi; sv[k] = best;
#pragma unroll
                for (int e = 0; e < 32; ++e) if (e == bi) v[e] = -__builtin_inff(); }
            const float e1 = fexp(sv[1] - sv[0]), e2 = fexp(sv[2] - sv[0]), e3 = fexp(sv[3] - sv[0]), inv = 1.0f / (1.0f + e1 + e2 + e3);
            sv[0] = inv; sv[1] = e1 * inv; sv[2] = e2 * inv; sv[3] = e3 * inv;
#pragma unroll
            for (int k = 0; k < 4; ++k) pos[k] = (int)atomicAdd((unsigned*)&lcnt[sel[k]], 1u);
        }
        __syncthreads();
        if (F.tid < 32) lcnt[32 + F.tid] = atomicAdd(&gcnt[F.tid], lcnt[F.tid]);
        __syncthreads();
        if (F.tid < 64) {
            const int t = base + F.tid;
#pragma unroll
            for (int k = 0; k < 4; ++k) { const int p = pos[k] + (int)lcnt[32 + sel[k]]; TKS[t * 4 + k] = sel[k] * T + p; TKG[t * 4 + k] = sv[k]; LIST[(size_t)sel[k] * T + p] = t; }
        }
        __syncthreads();
    }
}

__device__ __forceinline__ void moe_tables(Frame& F, int l, int NT) {
    LAS int* tab = (LAS int*)(F.lds + MISC_OFF);
    if (F.wave == 0) {
        const unsigned* gcnt = (const unsigned*)(F.ws + WS_CTL) + CW_CNT + l * 64;
        const int e = F.lane & 31;
        const int c = (int)__hip_atomic_load(&gcnt[e], __ATOMIC_RELAXED, __HIP_MEMORY_SCOPE_AGENT);
        const int tm = (c + 255) >> 8;
        int incl = tm;
#pragma unroll
        for (int o = 1; o < 32; o <<= 1) { const int v = shupi(incl, F.lane << 2, o); if (e >= o) incl += v; }
        if (F.lane < 32) { tab[e] = (incl - tm) * NT; tab[40 + e] = (incl - tm) * 256; tab[80 + e] = c; if (e == 31) tab[32] = incl * NT; }
    }
    __syncthreads();
}

__device__ __forceinline__ void phase_combine(Frame& F, const ArgsV& A_, int l, float* outp) {
    moe_tables(F, l, 1);
    const LAS int* tab = (const LAS int*)(F.lds + MISC_OFF);
    const float* HB = (const float*)(F.ws + WS_HB); const bf16_t* Y = (const bf16_t*)(F.ws + WS_Y);
    const int* TKS = (const int*)(F.ws + WS_TKS); const float* TKG = (const float*)(F.ws + WS_TKG);
    float* HA = outp ? outp : (float*)(F.ws + WS_HA); bf16_t* XB = outp ? nullptr : (bf16_t*)(F.ws + WS_XB);
    const int gw = F.bid * NWAVES + F.wave, NGW = F.G * NWAVES;
    for (int m = gw; m < T; m += NGW) {
        f32x4 v[4];
#pragma unroll
        for (int j = 0; j < 4; ++j) v[j] = *(const f32x4*)(HB + (size_t)m * D + 4 * F.lane + 256 * j) * ALPHA;
#pragma unroll
        for (int k = 0; k < 4; ++k) { const int code = TKS[m * 4 + k]; const float g = TKG[m * 4 + k]; const int e = code >> 14, p = code & (T - 1);
            const bf16_t* yr = Y + (size_t)(tab[40 + e] + p) * 1024 + 4 * F.lane;
#pragma unroll
            for (int j = 0; j < 4; ++j) { const u32x2 wv = *(const u32x2*)(yr + 256 * j); v[j].x += g * bflo(wv.x); v[j].y += g * bfhi(wv.x); v[j].z += g * bflo(wv.y); v[j].w += g * bfhi(wv.y); } }
        ln_store(v, A_.in[29] + l * D, A_.in[30] + l * D, HA + (size_t)m * D, XB ? XB + (size_t)m * D : nullptr, F.lane);
    }
    __syncthreads();
}

constexpr int PH_PER_LAYER = 10, N_PHASES = 1 + NL * PH_PER_LAYER;

__global__ void __launch_bounds__(NTHREADS, 2) mk_fwd(Args args) {
    extern __shared__ __attribute__((aligned(16))) unsigned char lds_raw[];
    LAS unsigned char* const lds = (LAS unsigned char*)lds_raw;
    const int lo = args.ph_lo, hi = args.ph_hi;
    volatile LAS unsigned* bst = (volatile LAS unsigned*)(lds + MISC_OFF + 2048);
    if (threadIdx.x < 2) bst[threadIdx.x] = 0u;
    if (threadIdx.x == 0) {
        LAS unsigned long long* pt = (LAS unsigned long long*)(lds + PTAB_OFF);
#pragma unroll
        for (int k = 0; k < 31; ++k) pt[k] = (unsigned long long)args.in[k];
    }
    __syncthreads();
    XcdBarrier bar; bar.bar = (unsigned*)(args.ws + WS_CTL) + CW_BAR; bar.x = 0; bar.st = bst;
    if (hi - lo > 1) bar = xcd_barrier_post((unsigned*)(args.ws + WS_CTL) + CW_BAR, bst);
    const ArgsV AV{InTab{lds}};
#ifdef ONLY_SUB
    const int only_sub = ONLY_SUB;
#else
    const int only_sub = -2;
#endif
#pragma unroll 1
    for (int ph = lo; ph < hi; ++ph) {
        const int l = (ph > 0) ? (ph - 1) / PH_PER_LAYER : 0;
        int sub = (ph > 0) ? (ph - 1) % PH_PER_LAYER : -1;
        if (only_sub != -2 && sub != only_sub) continue;
        bool seam = true;
        switch (sub) {
        case -1: { Frame F = make_frame(lds, args.ws); phase_prologue(F, AV); } break;
        case 0: {
            Frame F = make_frame(lds, args.ws);
            pg8::PlainOrder S; S.init(WS_XB, WS_WINT + (size_t)l * 2560 * 1024 * 2, T, NCOLA, F.G, F.bid);
            pg8::EpiBf16 E{(bf16_t*)(F.ws + WS_U), NCOLA, nullptr, 0, 0.125f * LOG2E, 512};
            pg8::gemm_phase<pg8::EpiBf16, pg8::PlainOrder, true>(F.lds, (const char*)F.ws, F.tid, S, E); } break;
        case 1: {
            Frame F = make_frame(lds, args.ws);
            pg8::PlainOrder S; S.init(WS_WINT + ((size_t)l * 2560 + 2048) * 1024 * 2, WS_XB, 512, T, F.G, F.bid);
            pg8::EpiVT E{(bf16_t*)(F.ws + WS_VT)};
            pg8::gemm_phase<pg8::EpiVT, pg8::PlainOrder, true>(F.lds, (const char*)F.ws, F.tid, S, E);
            phase_knorm(F); } break;
        case 2: { Frame F = make_frame(lds, args.ws); phase_mixers(F, AV, l, args.probe); } break;
        case 3: { Frame F = make_frame(lds, args.ws); phase_lru_fix(F, AV, l); } break;
        case 4: {
            Frame F = make_frame(lds, args.ws);
            pg8::PlainOrder S; S.init(WS_MIX, WS_WOUTT + (size_t)l * 1024 * 1024 * 2, T, D, F.G, F.bid);
            pg8::EpiF32 E{(float*)(F.ws + WS_MIXO), D};
            pg8::gemm_phase<pg8::EpiF32, pg8::PlainOrder, true>(F.lds, (const char*)F.ws, F.tid, S, E); } break;
        case 5: { Frame F = make_frame(lds, args.ws); phase_ln1(F, AV, l); } break;
        case 6: { Frame F = make_frame(lds, args.ws); phase_router(F, AV, l); } break;
        case 7: {
            Frame F = make_frame(lds, args.ws);
            moe_tables(F, l, 8);
            pg8::MoeOrder S{(unsigned)WS_XB, (unsigned)(WS_W1T + (size_t)l * NE * 2048 * 1024 * 2), 2048u * 1024u * 2u, 8, 1, (const int*)(F.ws + WS_LIST), (const LAS int*)(F.lds + MISC_OFF), F.G, F.bid};
            pg8::EpiAct E{(bf16_t*)(F.ws + WS_ACT), AV.in[26] + (size_t)l * NE * 2048};
            pg8::gemm_phase<pg8::EpiAct, pg8::MoeOrder, true>(F.lds, (const char*)F.ws, F.tid, S, E); } break;
        case 8: {
            Frame F = make_frame(lds, args.ws);
            moe_tables(F, l, 4);
            pg8::MoeOrder S{(unsigned)WS_ACT, (unsigned)(WS_W2T + (size_t)l * NE * 1024 * 1024 * 2), 1024u * 1024u * 2u, 4, 0, nullptr, (const LAS int*)(F.lds + MISC_OFF), F.G, F.bid};
            pg8::EpiBf16 E{(bf16_t*)(F.ws + WS_Y), 1024, AV.in[28] + (size_t)l * NE * 1024, 1024, 1.0f, 0};
            pg8::gemm_phase<pg8::EpiBf16, pg8::MoeOrder, true>(F.lds, (const char*)F.ws, F.tid, S, E); } break;
        default: { Frame F = make_frame(lds, args.ws); phase_combine(F, AV, l, (l == NL - 1) ? args.out : nullptr); } break;
        }
        if (seam && ph + 1 < hi) xcd_barrier(bar);
    }
}

extern "C" void kernel_launch(void* const* d_in, const int* in_sizes, int n_in, void* d_out, int out_size, void* d_ws, size_t ws_size, hipStream_t stream) {
    static int grid = 0;
    if (grid == 0) {
        if (n_in != 31 || out_size != T * D || ws_size < WS_END2) { fprintf(stderr, "kernel_launch: unexpected sizes n_in %d out %d ws %zu (need %zu)\n", n_in, out_size, ws_size, (size_t)WS_END); grid = -1; return; }
        int dev = 0, cus = 0, per_cu = 0;
        if (hipGetDevice(&dev) != hipSuccess || hipDeviceGetAttribute(&cus, hipDeviceAttributeMultiprocessorCount, dev) != hipSuccess) { grid = -1; return; }
        if (hipFuncSetAttribute((const void*)mk_fwd, hipFuncAttributeMaxDynamicSharedMemorySize, LDS_BYTES) != hipSuccess) { fprintf(stderr, "kernel_launch: hipFuncSetAttribute failed\n"); grid = -1; return; }
        if (hipOccupancyMaxActiveBlocksPerMultiprocessor(&per_cu, (const void*)mk_fwd, NTHREADS, LDS_BYTES) != hipSuccess || per_cu < 1) { fprintf(stderr, "kernel_launch: occupancy query says %d blocks per CU\n", per_cu); (void)hipGetLastError(); grid = -1; return; }
        grid = cus;
    }
    if (grid < 0) return;
    (void)hipMemsetAsync((char*)d_ws + WS_CTL, 0, CTL_ZERO_BYTES, stream);
    Args a{};
    for (int i = 0; i < 31; ++i) a.in[i] = (const float*)d_in[i];
    a.out = (float*)d_out; a.ws = (unsigned char*)d_ws;
#if MK_ONE_LAUNCH
    a.ph_lo = 0; a.ph_hi = N_PHASES;
    hipLaunchKernelGGL(mk_fwd, dim3(grid), dim3(NTHREADS), LDS_BYTES, stream, a);
#ifdef PROBE_LO
    (void)hipMemsetAsync((char*)d_ws + WS_CTL + CW_BAR * 4, 0, XCD_BAR_WORDS * 4, stream);
    (void)hipMemsetAsync((char*)d_ws + WS_CTL + CW_QUEUE * 4, 0, 1024, stream);
    a.probe = PROBE_MODE;
    a.ph_lo = PROBE_LO; a.ph_hi = PROBE_HI;
    hipLaunchKernelGGL(mk_fwd, dim3(grid), dim3(NTHREADS), LDS_BYTES, stream, a);
#endif
#else
    for (int p = 0; p < N_PHASES; ++p) { a.ph_lo = p; a.ph_hi = p + 1; hipLaunchKernelGGL(mk_fwd, dim3(grid), dim3(NTHREADS), LDS_BYTES, stream, a); }
#endif
}
```

```cpp
#include <hip/hip_runtime.h>
#include <cstdio>
#include <cstdint>

#ifndef PROBE_DUP
#define PROBE_DUP 0
#endif
#ifndef MK_ONE_LAUNCH
#define MK_ONE_LAUNCH 1
#endif

#define LAS __attribute__((address_space(3)))
#define GAS __attribute__((address_space(1)))
typedef unsigned short bf16_t;
typedef short bf16x8 __attribute__((ext_vector_type(8)));
typedef float f32x2 __attribute__((ext_vector_type(2)));
typedef float f32x4 __attribute__((ext_vector_type(4)));
typedef float f32x16 __attribute__((ext_vector_type(16)));
typedef unsigned u32x4 __attribute__((ext_vector_type(4)));
typedef unsigned u32x2 __attribute__((ext_vector_type(2)));
typedef int i32x8 __attribute__((ext_vector_type(8)));
typedef int i32x4 __attribute__((ext_vector_type(4)));

constexpr int T = 16384, D = 1024, NL = 2, NE = 32, KD = 1024;
constexpr int NCOLA = 2048;
constexpr int UQ = 0, UK = 512, ULX = 1024, ULY = 1280, UCA = 1536, UCB = 1792;
constexpr float LN_EPS = 1e-5f;
constexpr float ALPHA = 1.41421356237309515f;
constexpr float LOG2E = 1.44269504088896341f;
constexpr int NWAVES = 8, NTHREADS = 512;
constexpr int ACT_ROWS = 65536 + 32 * 256 + 256;

constexpr size_t MiB = 1u << 20;
constexpr size_t WS_CTL = 0, CTL_ZERO_BYTES = 1 * MiB;
constexpr size_t WS_WINT = 2 * MiB;
constexpr size_t WS_WOUTT = 12 * MiB;
constexpr size_t WS_W1T = 16 * MiB;
constexpr size_t WS_W2T = 272 * MiB;
constexpr size_t WS_HA = 400 * MiB;
constexpr size_t WS_HB = 464 * MiB;
constexpr size_t WS_XB = 528 * MiB;
constexpr size_t WS_U = 560 * MiB;
constexpr size_t WS_VT = 624 * MiB;
constexpr size_t WS_MIX = 640 * MiB;
constexpr size_t WS_MIXO = 672 * MiB;
constexpr size_t WS_HLOC = 736 * MiB;
constexpr size_t WS_CUMA = 752 * MiB;
constexpr size_t WS_AGG = 768 * MiB;
constexpr size_t WS_TKS = 769 * MiB;
constexpr size_t WS_TKG = 769 * MiB + 512 * 1024;
constexpr size_t WS_LIST = 770 * MiB;
constexpr size_t WS_ACT = 772 * MiB;
constexpr size_t WS_Y = 920 * MiB;
constexpr size_t WS_END = 1068 * MiB;
static_assert(WS_ACT + (size_t)ACT_ROWS * 2048 <= WS_Y && WS_Y + (size_t)ACT_ROWS * 2048 <= WS_END, "ws map");
constexpr int CW_BAR = 4096;
constexpr int CW_CNT = 16384;

constexpr int RING_BYTES = 135168;
constexpr int MISC_OFF = RING_BYTES;
constexpr int LDS_BYTES = 147456;
constexpr int VA_PARK_OFF = MISC_OFF + 4096;

__device__ __forceinline__ unsigned f2bf(float f) { unsigned u = __builtin_bit_cast(unsigned, f); return (u + 0x7fffu + ((u >> 16) & 1u)) >> 16; }
__device__ __forceinline__ unsigned pk2(float lo, float hi) { return f2bf(lo) | (f2bf(hi) << 16); }
__device__ __forceinline__ float bf2f(bf16_t v) { return __builtin_bit_cast(float, (unsigned)v << 16); }
__device__ __forceinline__ float bflo(unsigned w) { return __builtin_bit_cast(float, w << 16); }
__device__ __forceinline__ float bfhi(unsigned w) { return __builtin_bit_cast(float, w & 0xffff0000u); }
__device__ __forceinline__ unsigned cvt_pk_bf16(float lo, float hi) { unsigned r; asm volatile("v_cvt_pk_bf16_f32 %0, %1, %2" : "=v"(r) : "v"(lo), "v"(hi)); return r; }
__device__ __forceinline__ float shx(float v, int lane4, int mask) { return __builtin_bit_cast(float, __builtin_amdgcn_ds_bpermute(lane4 ^ (mask << 2), __builtin_bit_cast(int, v))); }
__device__ __forceinline__ float shup(float v, int lane4, int d) { return __builtin_bit_cast(float, __builtin_amdgcn_ds_bpermute(lane4 - (d << 2), __builtin_bit_cast(int, v))); }
__device__ __forceinline__ int shupi(int v, int lane4, int d) { return __builtin_amdgcn_ds_bpermute(lane4 - (d << 2), v); }
__device__ __forceinline__ float wave_sum(float v, int lane4) {
#pragma unroll
    for (int o = 1; o < 64; o <<= 1) v += shx(v, lane4, o);
    return v;
}
__device__ __forceinline__ float ex2(float x) { return __builtin_amdgcn_exp2f(x); }
__device__ __forceinline__ float fexp(float x) { return __builtin_amdgcn_exp2f(x * LOG2E); }
__device__ __forceinline__ float frcp(float x) { return __builtin_amdgcn_rcpf(x); }
__device__ __forceinline__ float fsqrt(float x) { return __builtin_amdgcn_sqrtf(x); }
__device__ __forceinline__ float flog(float x) { return __builtin_amdgcn_logf(x) * 0.693147180559945f; }
__device__ __forceinline__ float sigmoidf_(float x) { return frcp(1.0f + fexp(-x)); }
#define LDS_WAIT() asm volatile("s_waitcnt lgkmcnt(0)" ::: "memory")
#define VM_WAIT() asm volatile("s_waitcnt vmcnt(0)" ::: "memory")

namespace pg8 {
constexpr int BM = 256, BK = 64, HALF = 128, HTB = HALF * BK * 2, STAGE_BYTES = 8 * HTB, NXCD = 8, WGM = 8;
__device__ __forceinline__ int lds_byte(int r, int c) { const int st = (r >> 4) * 2 + (c >> 5), rr = r & 15, cc = c & 31, ob = rr * 64 + cc * 2; return st * 1024 + (ob ^ (((ob >> 9) & 1) << 5)); }
__device__ __forceinline__ void stage_rc(int b, int& R, int& C) { const unsigned ub = (unsigned)b, st = ub >> 10, sb = ub & 1023u, swz = sb ^ (((sb >> 9) & 1u) << 5); R = (int)((st >> 1) * 16u + (swz >> 6)); C = (int)((st & 1u) * 32u + ((swz & 63u) >> 1)); }
__device__ __forceinline__ int perm32(int rho) { const int n = rho >> 4, i = rho & 15; return 8 * (i >> 2) + 4 * n + (i & 3); }

struct Unit { unsigned A, B; int pn, e, orow; unsigned va00, va01, va10, va11; };

struct PlainOrder {
    unsigned A, Bt; int nM, nN, nwg, G, c, rowb;
    __device__ void init(size_t A_, size_t Bt_, int M, int N, int G_, int c_, int rowb_ = KD * 2) { rowb = rowb_; A = (unsigned)A_; Bt = (unsigned)Bt_; nM = M / BM; nN = N / BM; nwg = nM * nN; G = G_; c = c_; }
    __device__ __forceinline__ bool next(int i, Unit& u, int tid) const {
        const long L = (long)i * G + c; if (L >= nwg) return false;
        int R0, C0, R1, C1; stage_rc(tid * 16, R0, C0); stage_rc(tid * 16 + 8192, R1, C1);
        int wgid = (int)L; { const int q = nwg / NXCD, r = nwg % NXCD, xcd = wgid % NXCD, off = wgid / NXCD; wgid = (xcd < r ? xcd * (q + 1) : r * (q + 1) + (xcd - r) * q) + off; }
        const int nig = WGM * nN, gid = wgid / nig, fm = gid * WGM, gsz = (nM - fm) < WGM ? (nM - fm) : WGM;
        const int pm = fm + ((wgid % nig) % gsz), pn = (wgid % nig) / gsz;
        u.A = A + (unsigned)pm * (unsigned)(BM * rowb); u.B = Bt + (unsigned)pn * (unsigned)(BM * rowb); u.pn = pn; u.e = 0; u.orow = pm * BM;
        u.va00 = (unsigned)(R0 * rowb + C0 * 2); u.va01 = (unsigned)(R1 * rowb + C1 * 2); u.va10 = (unsigned)((R0 + HALF) * rowb + C0 * 2); u.va11 = (unsigned)((R1 + HALF) * rowb + C1 * 2);
        return true;
    }
};

struct MoeOrder {
    unsigned Abase, Bt, bstride; int NT; int gather; const int* list; const LAS int* tab; int G, c, rowb;
    __device__ __forceinline__ bool next(int i, Unit& u, int tid) const {
        const int NU = __builtin_amdgcn_readfirstlane(tab[32]);
        int L;
        if ((G & 7) == 0) { const int g8 = G >> 3, per = (NU + 7) >> 3, idx = i * g8 + (c >> 3); if (idx >= per) return false; L = (c & 7) * per + idx; }
        else L = i * G + c;
        if (L >= NU) return false;
        int R0, C0, R1, C1; stage_rc(tid * 16, R0, C0); stage_rc(tid * 16 + 8192, R1, C1);
        const int ln_ = tid & 63;
        int e = __popcll(__ballot(ln_ >= 1 && ln_ < 32 && L >= tab[ln_ & 31]));
        e = __builtin_amdgcn_readfirstlane(e);
        const int ub = __builtin_amdgcn_readfirstlane(tab[e]), ub1 = __builtin_amdgcn_readfirstlane(tab[e + 1]);
        const int ps = __builtin_amdgcn_readfirstlane(tab[40 + e]), cnt = __builtin_amdgcn_readfirstlane(tab[80 + e]);
        const int tm = (ub1 - ub) / NT, r = L - ub, mt = r % tm, nt = r / tm;
        u.e = e; u.pn = nt; u.orow = ps + mt * BM;
        u.B = Bt + (unsigned)e * bstride + (unsigned)nt * (unsigned)(BM * rowb);
        if (gather) {
            u.A = Abase;
            const int* lp = list + (size_t)e * T + mt * BM; const int lim = cnt - mt * BM;
            const int t00 = (R0 < lim) ? lp[R0] : 0, t01 = (R1 < lim) ? lp[R1] : 0, t10 = (R0 + HALF < lim) ? lp[R0 + HALF] : 0, t11 = (R1 + HALF < lim) ? lp[R1 + HALF] : 0;
            u.va00 = (unsigned)(t00 * rowb + C0 * 2); u.va01 = (unsigned)(t01 * rowb + C1 * 2); u.va10 = (unsigned)(t10 * rowb + C0 * 2); u.va11 = (unsigned)(t11 * rowb + C1 * 2);
        } else {
            u.A = Abase + (unsigned)u.orow * (unsigned)rowb;
            u.va00 = (unsigned)(R0 * rowb + C0 * 2); u.va01 = (unsigned)(R1 * rowb + C1 * 2); u.va10 = (unsigned)((R0 + HALF) * rowb + C0 * 2); u.va11 = (unsigned)((R1 + HALF) * rowb + C1 * 2);
        }
        return true;
    }
};

struct EpiBf16 {
    static constexpr bool PERM = true;
    bf16_t* O; int ldc; const float* bias; int bias_stride; float scale0; int scale_cols;
    __device__ __forceinline__ void operator()(const f32x4 (&acc)[2][2][4][2], const Unit& u, int wr, int wc, int fr, int fq) const {
        const int row0 = u.orow + wr * 64 + fr, colt = u.pn * BM, col0 = colt + wc * 32 + 8 * fq;
        const float sc = (colt < scale_cols) ? scale0 : 1.f;
        const float* bp = bias ? bias + (size_t)u.e * bias_stride : nullptr;
        f32x4 bv[2][2];
#pragma unroll
        for (int bj = 0; bj < 2; ++bj)
#pragma unroll
            for (int n = 0; n < 2; ++n) bv[bj][n] = bp ? *(const f32x4*)(bp + col0 + bj * HALF + 4 * n) : (f32x4){0.f, 0.f, 0.f, 0.f};
#pragma unroll
        for (int ai = 0; ai < 2; ++ai)
#pragma unroll
            for (int m = 0; m < 4; ++m) { bf16_t* rowp = O + (size_t)(row0 + ai * HALF + m * 16) * ldc + col0;
#pragma unroll
                for (int bj = 0; bj < 2; ++bj) { f32x4 v0 = (acc[ai][bj][m][0] + bv[bj][0]) * sc, v1 = (acc[ai][bj][m][1] + bv[bj][1]) * sc;
                    u32x4 w; w.x = cvt_pk_bf16(v0[0], v0[1]); w.y = cvt_pk_bf16(v0[2], v0[3]); w.z = cvt_pk_bf16(v1[0], v1[1]); w.w = cvt_pk_bf16(v1[2], v1[3]);
                    *(u32x4*)(rowp + bj * HALF) = w; } }
    }
};
struct EpiVT {
    static constexpr bool PERM = false;
    bf16_t* O;
    __device__ __forceinline__ void operator()(const f32x4 (&acc)[2][2][4][2], const Unit& u, int wr, int wc, int fr, int fq) const {
        const int sfq = (fq == 1) ? 2 : ((fq == 2) ? 1 : fq);
        const int row0 = u.orow + wr * 64 + fr, col0 = u.pn * BM + wc * 32 + 4 * sfq;
#pragma unroll
        for (int ai = 0; ai < 2; ++ai)
#pragma unroll
            for (int m = 0; m < 4; ++m) { bf16_t* rowp = O + (size_t)(row0 + ai * HALF + m * 16) * T + col0;
#pragma unroll
                for (int bj = 0; bj < 2; ++bj)
#pragma unroll
                    for (int n = 0; n < 2; ++n) { const f32x4 v = acc[ai][bj][m][n]; u32x2 w; w.x = cvt_pk_bf16(v[0], v[1]); w.y = cvt_pk_bf16(v[2], v[3]); *(u32x2*)(rowp + bj * HALF + n * 16) = w; } }
    }
};
struct EpiF32 {
    static constexpr bool PERM = false;
    float* O; int ldc;
    __device__ __forceinline__ void operator()(const f32x4 (&acc)[2][2][4][2], const Unit& u, int wr, int wc, int fr, int fq) const {
        const int row0 = u.orow + wr * 64 + fr, col0 = u.pn * BM + wc * 32 + 4 * fq;
#pragma unroll
        for (int ai = 0; ai < 2; ++ai)
#pragma unroll
            for (int m = 0; m < 4; ++m) { float* rowp = O + (size_t)(row0 + ai * HALF + m * 16) * ldc + col0;
#pragma unroll
                for (int bj = 0; bj < 2; ++bj)
#pragma unroll
                    for (int n = 0; n < 2; ++n) *(f32x4*)(rowp + bj * HALF + n * 16) = acc[ai][bj][m][n]; }
    }
};
struct EpiAct {
    static constexpr bool PERM = true;
    unsigned char* O; const float* b1;
    __device__ __forceinline__ void operator()(const f32x4 (&acc)[2][2][4][2], const Unit& u, int wr, int wc, int fr, int fq) const {
        const int row0 = u.orow + wr * 64 + fr, j0 = u.pn * HALF + wc * 32 + 8 * fq;
        const float* bp = b1 + (size_t)u.e * 2048;
        f32x4 bg[2], bl[2];
#pragma unroll
        for (int n = 0; n < 2; ++n) { bg[n] = *(const f32x4*)(bp + j0 + 4 * n); bl[n] = *(const f32x4*)(bp + 1024 + j0 + 4 * n); }
#pragma unroll
        for (int ai = 0; ai < 2; ++ai)
#pragma unroll
            for (int m = 0; m < 4; ++m) { unsigned char* rowp = O + (size_t)(row0 + ai * HALF + m * 16) * 1024 + j0;
                float o[8];
#pragma unroll
                for (int n = 0; n < 2; ++n)
#pragma unroll
                    for (int q = 0; q < 4; ++q) { float g = acc[ai][0][m][n][q] + bg[n][q], l = acc[ai][1][m][n][q] + bl[n][q];
                        g = fminf(g, 7.0f); l = fminf(fmaxf(l, -7.0f), 7.0f);
                        o[n * 4 + q] = g * (1.0f / (1.0f + __builtin_amdgcn_exp2f(-1.702f * LOG2E * g))) * (l + 1.0f); }
                int w0 = 0, w1 = 0;
                w0 = __builtin_amdgcn_cvt_pk_fp8_f32(o[0], o[1], w0, false); w0 = __builtin_amdgcn_cvt_pk_fp8_f32(o[2], o[3], w0, true);
                w1 = __builtin_amdgcn_cvt_pk_fp8_f32(o[4], o[5], w1, false); w1 = __builtin_amdgcn_cvt_pk_fp8_f32(o[6], o[7], w1, true);
                u32x2 w; w.x = (unsigned)w0; w.y = (unsigned)w1; *(u32x2*)rowp = w; }
    }
};

__device__ __forceinline__ void mfma_fp8(f32x4& acc, const i32x8 w, const i32x8 x, int sw, int sx) {
    asm volatile("s_nop 1\n\tv_mfma_scale_f32_16x16x128_f8f6f4 %0, %1, %2, %0, %3, %4 op_sel_hi:[0,0,0]" : "+v"(acc) : "v"(w), "v"(x), "v"(sw), "v"(sx));
}
template <class Epi, class Sched, bool ALIGN_EPI, bool FP8 = false>
__device__ __forceinline__ void gemm_phase(LAS unsigned char* lds, const char* wsb, const int tid0, const Sched& S, const Epi& E) {
    Unit cur, nxt; int ui = 0;
    if (!S.next(0, cur, tid0)) return;
    int tid = tid0; asm volatile("" : "+v"(tid));
    const int wid = __builtin_amdgcn_readfirstlane(tid >> 6), lane = tid & 63, wr = wid >> 2, wc = wid & 3, fr = lane & 15, fq = lane >> 4;
    constexpr int ROWB = FP8 ? KD : KD * 2, nt = ROWB / (BK * 2);
    unsigned voffB[2];
    { int R0, C0, R1, C1; stage_rc(tid * 16, R0, C0); stage_rc(tid * 16 + 8192, R1, C1);
      const int Rb0 = Epi::PERM ? ((R0 & ~31) + perm32(R0 & 31)) : R0, Rb1 = Epi::PERM ? ((R1 & ~31) + perm32(R1 & 31)) : R1;
      voffB[0] = (unsigned)(Rb0 * ROWB + C0 * 2); voffB[1] = (unsigned)(Rb1 * ROWB + C1 * 2); }
    constexpr unsigned kstep = (unsigned)(BK * 2);
    constexpr unsigned hstep = (unsigned)HALF * ROWB;
    const unsigned ldsw = (unsigned)wid * 1024u;
    const int aoff = lds_byte(wr * 64 + fr, fq * 8), boff = lds_byte(wc * 32 + fr, fq * 8);
#define PG8_SA(b, h) (((b) * 2 + (h)) * HTB)
#define PG8_SB(b, h) ((4 + (b) * 2 + (h)) * HTB)
#define PG8_GLDS(gp, lp) __builtin_amdgcn_global_load_lds((const unsigned*)(gp), (LAS unsigned*)(lp), 16, 0, 0)
#define PG8_STB(bufoff, gbase) do { PG8_GLDS(wsb + (size_t)((gbase) + voffB[0]), lds + (bufoff) + ldsw); PG8_GLDS(wsb + (size_t)((gbase) + voffB[1]), lds + (bufoff) + ldsw + 8192); } while (0)
#define PG8_STA(bufoff, gbase, v0, v1) do { PG8_GLDS(wsb + (size_t)((gbase) + (v0)), lds + (bufoff) + ldsw); PG8_GLDS(wsb + (size_t)((gbase) + (v1)), lds + (bufoff) + ldsw + 8192); } while (0)
#define PG8_LDA(dst, b, h) do { _Pragma("unroll") for (int m = 0; m < 4; ++m) _Pragma("unroll") for (int k = 0; k < 2; ++k) dst[m][k] = *(const LAS bf16x8*)(lds + PG8_SA(b, h) + aoff + m * 2048 + k * 1024); } while (0)
#define PG8_LDB(dst, b, h) do { _Pragma("unroll") for (int n = 0; n < 2; ++n) _Pragma("unroll") for (int k = 0; k < 2; ++k) dst[n][k] = *(const LAS bf16x8*)(lds + PG8_SB(b, h) + boff + n * 2048 + k * 1024); } while (0)
#define PG8_CAT(x) __builtin_bit_cast(i32x8, __builtin_shufflevector(__builtin_bit_cast(i32x4, x[0]), __builtin_bit_cast(i32x4, x[1]), 0, 1, 2, 3, 4, 5, 6, 7))
#define PG8_MMA(ai, bj, At, Bt) do { __builtin_amdgcn_s_setprio(1); _Pragma("unroll") for (int m = 0; m < 4; ++m) _Pragma("unroll") for (int n = 0; n < 2; ++n) { \
        if constexpr (FP8) mfma_fp8(acc[ai][bj][m][n], PG8_CAT(Bt[n]), PG8_CAT(At[m]), sc_w, sc_x); \
        else { _Pragma("unroll") for (int k = 0; k < 2; ++k) acc[ai][bj][m][n] = __builtin_amdgcn_mfma_f32_16x16x32_bf16(Bt[n][k], At[m][k], acc[ai][bj][m][n], 0, 0, 0); } } __builtin_amdgcn_s_setprio(0); } while (0)
#define PG8_WAIT_V(n) asm volatile("s_waitcnt vmcnt(" #n ")" ::: "memory")
#define PG8_WAIT_L(n) asm volatile("s_waitcnt lgkmcnt(" #n ")" ::: "memory")
#define PG8_BAR __builtin_amdgcn_s_barrier()
#define PG8_SCHED __builtin_amdgcn_sched_barrier(0)
    f32x4 acc[2][2][4][2];
#pragma unroll
    for (int a = 0; a < 2; ++a)
#pragma unroll
        for (int b = 0; b < 2; ++b)
#pragma unroll
            for (int m = 0; m < 4; ++m)
#pragma unroll
                for (int n = 0; n < 2; ++n) acc[a][b][m][n] = (f32x4){0.f, 0.f, 0.f, 0.f};
    bf16x8 At[4][2], B0[2][2], B1[2][2];
    const int sc_w = 122, sc_x = 127;
    unsigned cA = cur.A, cB = cur.B;
    unsigned c00 = cur.va00, c01 = cur.va01, c10 = cur.va10, c11 = cur.va11;
    PG8_STB(PG8_SB(0, 0), cB); PG8_STB(PG8_SB(0, 1), cB + hstep); PG8_STA(PG8_SA(0, 0), cA, c00, c01); PG8_STA(PG8_SA(0, 1), cA, c10, c11);
    if (wr == 1) PG8_BAR;
    PG8_WAIT_V(2); PG8_BAR;
    PG8_STB(PG8_SB(1, 0), cB + kstep); PG8_STA(PG8_SA(1, 0), cA + kstep, c00, c01); PG8_STB(PG8_SB(1, 1), cB + hstep + kstep);
    PG8_WAIT_V(6); PG8_BAR;
    for (;;) {
        const bool has_next = S.next(ui + 1, nxt, tid);
        const unsigned nA = has_next ? nxt.A : cA, nB = has_next ? nxt.B : cB;
        { u32x4 pv; pv.x = has_next ? nxt.va00 : c00; pv.y = has_next ? nxt.va01 : c01; pv.z = has_next ? nxt.va10 : c10; pv.w = has_next ? nxt.va11 : c11; *(LAS u32x4*)(lds + VA_PARK_OFF + tid * 16) = pv; }
        for (int t = 0; t < nt; t += 2) {
            const bool last = (t == nt - 2);
            const unsigned a1 = cA + (unsigned)(t + 1) * kstep;
            const unsigned a2 = last ? nA : cA + (unsigned)(t + 2) * kstep, b2 = last ? nB : cB + (unsigned)(t + 2) * kstep;
            const unsigned a3 = a2 + kstep, b3 = b2 + kstep;
            unsigned s00 = c00, s01 = c01, s10 = c10, s11 = c11;
            if (last) { const u32x4 pv = *(const LAS u32x4*)(lds + VA_PARK_OFF + tid * 16); s00 = pv.x; s01 = pv.y; s10 = pv.z; s11 = pv.w; }
            PG8_LDB(B0, 0, 0); PG8_LDB(B1, 0, 1); PG8_SCHED; PG8_LDA(At, 0, 0); PG8_STA(PG8_SA(1, 1), a1, c10, c11);
            PG8_WAIT_V(8); PG8_WAIT_L(0); PG8_BAR; PG8_MMA(0, 0, At, B0); PG8_MMA(0, 1, At, B1); PG8_BAR; PG8_SCHED;
            PG8_LDA(At, 0, 1); PG8_STB(PG8_SB(0, 0), b2); PG8_STB(PG8_SB(0, 1), b2 + hstep); PG8_STA(PG8_SA(0, 0), a2, s00, s01);
            PG8_WAIT_V(8); PG8_WAIT_L(0); PG8_BAR; PG8_MMA(1, 0, At, B0); PG8_MMA(1, 1, At, B1); PG8_BAR; PG8_SCHED;
            PG8_LDB(B0, 1, 0); PG8_LDB(B1, 1, 1); PG8_SCHED; PG8_LDA(At, 1, 0); PG8_STA(PG8_SA(0, 1), a2, s10, s11);
            PG8_WAIT_V(8); PG8_WAIT_L(0); PG8_BAR; PG8_MMA(0, 0, At, B0); PG8_MMA(0, 1, At, B1); PG8_BAR; PG8_SCHED;
            PG8_LDA(At, 1, 1); PG8_STB(PG8_SB(1, 0), b3); PG8_STB(PG8_SB(1, 1), b3 + hstep); PG8_STA(PG8_SA(1, 0), a3, s00, s01);
            PG8_WAIT_V(8); PG8_WAIT_L(0); PG8_BAR; PG8_MMA(1, 0, At, B0); PG8_MMA(1, 1, At, B1); PG8_BAR; PG8_SCHED;
        }
        if constexpr (ALIGN_EPI) { if (wr == 0) PG8_BAR; }
        if constexpr (FP8) asm volatile("s_nop 15\n\ts_nop 15\n\ts_nop 15" ::: "memory");
        E(acc, cur, wr, wc, fr, fq);
        if (!has_next) break;
#pragma unroll
        for (int a = 0; a < 2; ++a)
#pragma unroll
            for (int b = 0; b < 2; ++b)
#pragma unroll
                for (int m = 0; m < 4; ++m)
#pragma unroll
                    for (int n = 0; n < 2; ++n) acc[a][b][m][n] = (f32x4){0.f, 0.f, 0.f, 0.f};
        cur = nxt; cA = nA; cB = nB; { const u32x4 pv = *(const LAS u32x4*)(lds + VA_PARK_OFF + tid * 16); c00 = pv.x; c01 = pv.y; c10 = pv.z; c11 = pv.w; } ++ui;
        if constexpr (ALIGN_EPI) { if (wr == 1) PG8_BAR; }
    }
    PG8_WAIT_V(0);
    if constexpr (!ALIGN_EPI) { if (wr == 0) PG8_BAR; }
    PG8_BAR;
#undef PG8_SA
#undef PG8_SB
#undef PG8_GLDS
#undef PG8_STB
#undef PG8_STA
#undef PG8_LDA
#undef PG8_LDB
#undef PG8_MMA
#undef PG8_CAT
#undef PG8_WAIT_V
#undef PG8_WAIT_L
#undef PG8_BAR
#undef PG8_SCHED
}
}

#define XB_TMO      128
#define XB_XCNT(j)  (256  + 64 * (j))
#define XB_XSUB(j)  (1280 + 64 * (j))
#define XB_XGEN(j)  (2304 + 64 * (j))
#define XB_TOP      3328
#define XB_TOPGEN   3392
#define XCD_BAR_WORDS 3456
#define XB_SPIN_CAP (1u << 22)
__device__ __forceinline__ unsigned xb_ld(unsigned* p)              { return __hip_atomic_load(p, __ATOMIC_RELAXED, __HIP_MEMORY_SCOPE_AGENT); }
__device__ __forceinline__ unsigned xb_add(unsigned* p, unsigned v) { return __hip_atomic_fetch_add(p, v, __ATOMIC_RELAXED, __HIP_MEMORY_SCOPE_AGENT); }
__device__ __forceinline__ unsigned xb_xcc_id() { return (unsigned)__builtin_amdgcn_s_getreg((3 << 11) | 20) & 0xFu; }
#define XB_SPIN(cond, bar) do { unsigned _sp = 0; while (cond) { __builtin_amdgcn_s_sleep(1); \
    if ((++_sp & 255u) == 0u) { if (xb_ld(&(bar)[XB_TMO])) break; if (_sp > XB_SPIN_CAP) { atomicAdd(&(bar)[XB_TMO], 1u); break; } } } } while (0)
struct XcdBarrier { unsigned* bar; unsigned x; volatile LAS unsigned* st; };
__device__ __forceinline__ XcdBarrier xcd_barrier_post(unsigned* bar, volatile LAS unsigned* st) {
    XcdBarrier b; b.bar = bar; b.x = xb_xcc_id(); b.st = st;
    if (threadIdx.x == 0) (void)xb_add(&bar[XB_XCNT(b.x)], 1u);
    return b;
}
__device__ __forceinline__ void xcd_barrier_complete(unsigned* bar, unsigned x, unsigned& nloc, unsigned& nx) {
    const unsigned G = gridDim.x * gridDim.y * gridDim.z;
    unsigned sum, cnt, mine, sp = 0u;
    for (;;) {
        sum = 0u; cnt = 0u; mine = 0u;
#pragma unroll 1
        for (unsigned j = 0; j < 16; ++j) { const unsigned c = xb_ld(&bar[XB_XCNT(j)]); sum += c; cnt += (c > 0u) ? 1u : 0u; mine = (j == x) ? c : mine; }
        if (sum == G) break;
        __builtin_amdgcn_s_sleep(1);
        if ((++sp & 255u) == 0u) { if (xb_ld(&bar[XB_TMO])) break; if (sp > XB_SPIN_CAP) { atomicAdd(&bar[XB_TMO], 1u); break; } }
    }
    nloc = mine > 0u ? mine : 1u; nx = cnt > 0u ? cnt : 1u;
}
__device__ __forceinline__ void xcd_barrier(const XcdBarrier& b) {
    asm volatile("s_waitcnt vmcnt(0)" ::: "memory");
    __syncthreads();
    if (threadIdx.x == 0) {
        unsigned* bar = b.bar;
        __builtin_amdgcn_s_waitcnt(0);
        unsigned nloc = b.st[0], nx = b.st[1];
        if (nloc == 0u) { xcd_barrier_complete(bar, b.x, nloc, nx); b.st[0] = nloc; b.st[1] = nx; }
        const unsigned old = xb_add(&bar[XB_XSUB(b.x)], 1u);
        const unsigned gen = old / nloc;
        if (old + 1u == (gen + 1u) * nloc) {
            __builtin_amdgcn_fence(__ATOMIC_RELEASE, "agent");
            asm volatile("s_waitcnt vmcnt(0)" ::: "memory");
            const unsigned og = xb_add(&bar[XB_TOP], 1u);
            const unsigned tg = og / nx;
            if (og + 1u == (tg + 1u) * nx) xb_add(&bar[XB_TOPGEN], 1u);
            else XB_SPIN(xb_ld(&bar[XB_TOPGEN]) == tg, bar);
            __builtin_amdgcn_fence(__ATOMIC_ACQUIRE, "agent");
            xb_add(&bar[XB_XGEN(b.x)], 1u);
            asm volatile("s_waitcnt vmcnt(0)" ::: "memory");
        } else {
            XB_SPIN(xb_ld(&bar[XB_XGEN(b.x)]) == gen, bar);
            __builtin_amdgcn_fence(__ATOMIC_ACQUIRE, "agent");
            asm volatile("s_waitcnt vmcnt(0)" ::: "memory");
        }
    }
    __syncthreads();
}

struct Args { const float* in[31]; float* out; unsigned char* ws; int ph_lo, ph_hi, probe, pad; };

struct Frame {
    LAS unsigned char* lds;
    int tid, lane, wave, G, bid;
    unsigned char* ws;
};
constexpr int PTAB_OFF = MISC_OFF + 3072;
struct InTab { LAS unsigned char* lds;
    __device__ __forceinline__ const float* operator[](int k) const {
        const LAS unsigned* p = (const LAS unsigned*)(lds + PTAB_OFF) + 2 * k;
        const unsigned lo = __builtin_amdgcn_readfirstlane(p[0]), hi = __builtin_amdgcn_readfirstlane(p[1]);
        return (const float*)(((unsigned long long)hi << 32) | lo); } };
struct ArgsV { InTab in; };
__device__ __forceinline__ Frame make_frame(LAS unsigned char* lds, unsigned char* ws) {
    Frame F; F.lds = lds;
    int tid = threadIdx.x; asm volatile("" : "+v"(tid));
    F.tid = tid; F.lane = tid & 63; F.wave = __builtin_amdgcn_readfirstlane(tid >> 6);
    F.G = gridDim.x; F.bid = blockIdx.x;
    unsigned long long w = (unsigned long long)ws; asm volatile("" : "+s"(w)); F.ws = (unsigned char*)w;
    return F;
}

__device__ __forceinline__ void transpose_item(const float* W, int N, bf16_t* WT, int k0, int n0, int drow0, LAS float* scr, int lane) {
    f32x4 v[16];
    const int lr = lane >> 4, lc = (lane & 15) * 4;
#pragma unroll
    for (int i = 0; i < 16; ++i) v[i] = __builtin_nontemporal_load((const f32x4*)(W + (size_t)(k0 + 4 * i + lr) * N + n0 + lc));
#pragma unroll
    for (int i = 0; i < 16; ++i) { LAS float* s = scr + (4 * i + lr) * 65 + lc; s[0] = v[i].x; s[1] = v[i].y; s[2] = v[i].z; s[3] = v[i].w; }
    LDS_WAIT(); asm volatile("" ::: "memory");
    const int c = lane & 7;
#pragma unroll
    for (int j = 0; j < 8; ++j) { const int n = (lane >> 3) + 8 * j; const LAS float* s = scr + (8 * c) * 65 + n;
        u32x4 o; o.x = pk2(s[0 * 65], s[1 * 65]); o.y = pk2(s[2 * 65], s[3 * 65]); o.z = pk2(s[4 * 65], s[5 * 65]); o.w = pk2(s[6 * 65], s[7 * 65]);
        *(u32x4*)(WT + (size_t)(drow0 + n) * KD + k0 + 8 * c) = o; }
    LDS_WAIT(); asm volatile("" ::: "memory");
}
__device__ __forceinline__ void transpose_item_fp8(const float* W, int N, unsigned char* WT, int k0, int n0, int drow0, LAS float* scr, int lane) {
    f32x4 v[16];
    const int lr = lane >> 3, lc = (lane & 7) * 4;
#pragma unroll
    for (int i = 0; i < 16; ++i) v[i] = __builtin_nontemporal_load((const f32x4*)(W + (size_t)(k0 + 8 * i + lr) * N + n0 + lc));
#pragma unroll
    for (int i = 0; i < 16; ++i) { LAS float* s = scr + (8 * i + lr) * 33 + lc; s[0] = v[i].x; s[1] = v[i].y; s[2] = v[i].z; s[3] = v[i].w; }
    LDS_WAIT(); asm volatile("" ::: "memory");
#pragma unroll
    for (int j = 0; j < 4; ++j) { const int id = lane + 64 * j, n = id >> 3, kc = id & 7; const LAS float* s = scr + (16 * kc) * 33 + n;
        int o[4];
#pragma unroll
        for (int q = 0; q < 4; ++q) { int w8 = 0;
            w8 = __builtin_amdgcn_cvt_pk_fp8_f32(32.f * s[(4 * q + 0) * 33], 32.f * s[(4 * q + 1) * 33], w8, false);
            w8 = __builtin_amdgcn_cvt_pk_fp8_f32(32.f * s[(4 * q + 2) * 33], 32.f * s[(4 * q + 3) * 33], w8, true); o[q] = w8; }
        u32x4 ov; ov.x = (unsigned)o[0]; ov.y = (unsigned)o[1]; ov.z = (unsigned)o[2]; ov.w = (unsigned)o[3];
        *(u32x4*)(WT + (size_t)(drow0 + n) * KD + k0 + 16 * kc) = ov; }
    LDS_WAIT(); asm volatile("" ::: "memory");
}
__device__ __forceinline__ void ln_store(f32x4 (&v)[4], const float* g, const float* b, float* of32, bf16_t* obf, int lane, unsigned char* of8 = nullptr) {
    float s = 0.f;
#pragma unroll
    for (int j = 0; j < 4; ++j) s += (v[j].x + v[j].y) + (v[j].z + v[j].w);
    const float mean = wave_sum(s, lane << 2) * (1.f / D); float s2 = 0.f;
#pragma unroll
    for (int j = 0; j < 4; ++j) { v[j] = v[j] - mean; s2 += (v[j].x * v[j].x + v[j].y * v[j].y) + (v[j].z * v[j].z + v[j].w * v[j].w); }
    const float rstd = __builtin_amdgcn_rsqf(wave_sum(s2, lane << 2) * (1.f / D) + LN_EPS);
#pragma unroll
    for (int j = 0; j < 4; ++j) {
        const f32x4 gv = *(const f32x4*)(g + 4 * lane + 256 * j), bv = *(const f32x4*)(b + 4 * lane + 256 * j);
        const f32x4 o = v[j] * rstd * gv + bv;
        if (of32) *(f32x4*)(of32 + 4 * lane + 256 * j) = o;
        if (obf) { u32x2 w; w.x = pk2(o.x, o.y); w.y = pk2(o.z, o.w); *(u32x2*)(obf + 4 * lane + 256 * j) = w; }
        if (of8) { int w8 = 0; w8 = __builtin_amdgcn_cvt_pk_fp8_f32(o.x, o.y, w8, false); w8 = __builtin_amdgcn_cvt_pk_fp8_f32(o.z, o.w, w8, true); *(int*)(of8 + 4 * lane + 256 * j) = w8; }
    }
}

__device__ __forceinline__ void phase_prologue(Frame& F, const ArgsV& A_) {
    LAS float* scr = (LAS float*)(F.lds + F.wave * 16896);
    const int gw = F.bid * NWAVES + F.wave, NGW = F.G * NWAVES;
    bf16_t* WINT = (bf16_t*)(F.ws + WS_WINT); bf16_t* WOUTT = (bf16_t*)(F.ws + WS_WOUTT); unsigned char* W1T = (unsigned char*)(F.ws + WS_W1T); unsigned char* W2T = (unsigned char*)(F.ws + WS_W2T);
    constexpr int I_IN = NL * 16 * 40, I_OUT = NL * 16 * 16, I_W1 = NL * NE * 8 * 64, I_W2 = NL * NE * 8 * 32;
    const float* w_in = A_.in[3]; const float* w_out = A_.in[20]; const float* w1 = A_.in[25]; const float* w2 = A_.in[27];
    for (int it = gw; it < I_IN + I_OUT + I_W1 + I_W2; it += NGW) {
        int r = it;
        if (r < I_W1) { const int le = r / (8 * 64), q = r % (8 * 64), kb = q / 64, nb = q % 64, n0 = nb * 32;
            const int drow = (n0 < 1024) ? ((n0 >> 7) * 256 + (n0 & 127)) : (((n0 - 1024) >> 7) * 256 + 128 + ((n0 - 1024) & 127));
            transpose_item_fp8(w1 + (size_t)le * 1024 * 2048, 2048, W1T + (size_t)le * 2048 * 1024, kb * 128, n0, drow, scr, F.lane); continue; }
        r -= I_W1;
        if (r < I_W2) { const int le = r / (8 * 32), q = r % (8 * 32), kb = q / 32, nb = q % 32;
            transpose_item_fp8(w2 + (size_t)le * 1024 * 1024, 1024, W2T + (size_t)le * 1024 * 1024, kb * 128, nb * 32, nb * 32, scr, F.lane); continue; }
        r -= I_W2;
        if (r < I_IN) { const int l = r / (16 * 40), q = r % (16 * 40), kb = q / 40, nb = q % 40, n0 = nb * 64;
            const int drow = (n0 < 1024) ? n0 : ((n0 < 1536) ? (2048 + n0 - 1024) : (n0 - 512));
            transpose_item(w_in + (size_t)l * 1024 * 2560, 2560, WINT + (size_t)l * 2560 * 1024, kb * 64, n0, drow, scr, F.lane); continue; }
        r -= I_IN;
        { const int l = r / (16 * 16), q = r % (16 * 16), kb = q / 16, nb = q % 16;
            transpose_item(w_out + (size_t)l * 1024 * 1024, 1024, WOUTT + (size_t)l * 1024 * 1024, kb * 64, nb * 64, nb * 64, scr, F.lane); }
    }
    float* HA = (float*)(F.ws + WS_HA); bf16_t* XB = (bf16_t*)(F.ws + WS_XB);
    for (int m = gw; m < T; m += NGW) {
        f32x4 v[4];
#pragma unroll
        for (int j = 0; j < 4; ++j) v[j] = *(const f32x4*)(A_.in[0] + (size_t)m * D + 4 * F.lane + 256 * j);
        ln_store(v, A_.in[1], A_.in[2], HA + (size_t)m * D, XB + (size_t)m * D, F.lane);
    }
}

constexpr int P2_KP = VA_PARK_OFF;
constexpr int P2_ORD = MISC_OFF + 1024;
constexpr int P2_FLG = MISC_OFF + 2304;
constexpr int CW_QUEUE = 20480;
constexpr size_t WS_KN = 768 * MiB + 512 * 1024;


constexpr int SEGT = 32, N_UNSPLIT = 400, N_SPLIT = 560, N_ITEMS = N_UNSPLIT + N_SPLIT;
struct ItemTabs { unsigned short item[1024]; unsigned short order[1024]; unsigned short segstart[128]; };
constexpr int west_of(int h) { return h == 0 ? 6 : (h == 1 ? 14 : (h == 2 ? 46 : 1000)); }
constexpr ItemTabs make_item_tabs() {
    ItemTabs t{}; int cost[1024] = {};
    for (int i = 0; i < 1024; ++i) { t.item[i] = 0; t.order[i] = 0; }
    for (int i = 0; i < 384; ++i) { const int h = i >> 7, qb = i & 127; t.item[i] = (unsigned short)(h | (qb << 2)); const int c = 2 * qb + 2; cost[i] = c < west_of(h) ? c : west_of(h); }
    for (int i = 384; i < 400; ++i) { const int qb = i - 384; t.item[i] = (unsigned short)(3 | (qb << 2)); cost[i] = 2 * qb + 2; }
    int n = 400;
    for (int qb = 0; qb < 128; ++qb) { t.segstart[qb] = (unsigned short)(n - 400);
        if (qb >= 16) { const int ns = (qb + 16) >> 4; for (int s = 0; s < ns; ++s) { t.item[n] = (unsigned short)(3 | (qb << 2) | (s << 9) | 0x8000); const int rem = 2 * qb + 2 - SEGT * s; cost[n] = rem < SEGT ? rem : SEGT; ++n; } } }
    int k = 0;
    for (int c = 64; c >= 1; --c) for (int i = 0; i < n; ++i) if (cost[i] == c) t.order[k++] = (unsigned short)i;
    return t;
}
__device__ const ItemTabs g_tabs = make_item_tabs();
constexpr size_t WS_PART = WS_END;
constexpr size_t PART_WAVE = 16896, PART_SLOT = 8 * PART_WAVE;
constexpr size_t WS_XB8 = ((WS_PART + (size_t)N_SPLIT * PART_SLOT + MiB) / MiB) * MiB;
constexpr size_t WS_END2 = WS_XB8 + 17 * MiB;

namespace attn {
__device__ __forceinline__ int crow(int r, int hi) { return (r & 3) + 8 * (r >> 2) + 4 * hi; }
__device__ __forceinline__ int swz(int row, int chunk) { return row * 128 + ((chunk ^ ((row >> 1) & 7)) << 4); }
#define MFMA32(a, b, c) __builtin_amdgcn_mfma_f32_32x32x16_bf16(a, b, c, 0, 0, 0)

__device__ __forceinline__ void attn_finish(LAS unsigned char* lds, f32x16 (&O)[4], float lsum, bf16_t* MIX, const float* subg, float lam, float outscale, int h, int rowmin, int c, int rg, int lane) {
    const int ln = lane & 31, hi = lane >> 5;
    const float ltot = lsum + shx(lsum, lane << 2, 32);
    LAS float* ex = (LAS float*)lds;
    if (c == 1) {
        const float sc = lam / ltot;
#pragma unroll
        for (int db = 0; db < 4; ++db)
#pragma unroll
            for (int r = 0; r < 16; ++r) ex[(rg * 64 + db * 16 + r) * 64 + lane] = O[db][r] * sc;
    }
    __syncthreads();
    if (c == 0) {
        const float inv = 1.0f / ltot; float ss = 0.f;
#pragma unroll
        for (int db = 0; db < 4; ++db)
#pragma unroll
            for (int r = 0; r < 16; ++r) { const float o = O[db][r] * inv - ex[(rg * 64 + db * 16 + r) * 64 + lane]; O[db][r] = o; ss += o * o; }
        ss += shx(ss, lane << 2, 32);
        const float rn = __builtin_amdgcn_rsqf(ss * (1.0f / 128.0f) + LN_EPS) * outscale;
        bf16_t* op = MIX + (size_t)(rowmin + ln) * 1024 + h * 128 + 4 * hi;
#pragma unroll
        for (int db = 0; db < 4; ++db)
#pragma unroll
            for (int g = 0; g < 4; ++g) { const int dv0 = 32 * db + 8 * g;
                const f32x4 gv = *(const f32x4*)(subg + dv0 + 4 * hi);
                u32x2 wv; wv.x = cvt_pk_bf16(O[db][4 * g + 0] * rn * gv.x, O[db][4 * g + 1] * rn * gv.y); wv.y = cvt_pk_bf16(O[db][4 * g + 2] * rn * gv.z, O[db][4 * g + 3] * rn * gv.w);
                *(u32x2*)(op + dv0) = wv; }
    }
    __syncthreads();
}
__device__ __forceinline__ void attn_unit(LAS unsigned char* lds, const unsigned char* wsb, bf16_t* MIX, const float* subg, float lam, float outscale, int h, int qb, int jt_top, int jt_bot, float* part, const int tid) {
    const int w = __builtin_amdgcn_readfirstlane(tid >> 6), lane = tid & 63, ln = lane & 31, hi = lane >> 5;
    const int c = w >> 2, rg = w & 3;
    const int i0 = qb * 128, rowmin = i0 + 32 * rg;
    const float slope2 = __builtin_amdgcn_exp2f(-2.0f * (float)(h + 1)) * LOG2E;
    const LAS float* kp = (const LAS float*)(lds + P2_KP) + (h * 2 + c) * 256;
    volatile LAS unsigned* flg = (volatile LAS unsigned*)(lds + P2_FLG);
    const bf16_t* U = (const bf16_t*)(wsb + WS_U);
    bf16x8 Qf[4];
    { const bf16_t* qp = U + (size_t)(rowmin + ln) * NCOLA + UQ + h * 128 + c * 64 + 8 * hi;
#pragma unroll
      for (int ks = 0; ks < 4; ++ks) Qf[ks] = *(const bf16x8*)(qp + 16 * ks); }
    float qn;
    { float ss = 0.f;
#pragma unroll
      for (int ks = 0; ks < 4; ++ks)
#pragma unroll
          for (int j = 0; j < 8; ++j) { const float v = bf2f((bf16_t)Qf[ks][j]); ss += v * v; }
      ss += shx(ss, lane << 2, 32); qn = fsqrt(ss) * 1.001f; }
    float mlb = -__builtin_inff();
    if (jt_top < 2 * qb + 1) { const bf16_t* kd = U + (size_t)(rowmin + ln) * NCOLA + UK + h * 128 + c * 64 + 8 * hi; float dd = 0.f;
#pragma unroll
        for (int ks = 0; ks < 4; ++ks) { const bf16x8 kv = *(const bf16x8*)(kd + 16 * ks);
#pragma unroll
            for (int j = 0; j < 8; ++j) dd += bf2f((bf16_t)Qf[ks][j]) * bf2f((bf16_t)kv[j]); }
        dd += shx(dd, lane << 2, 32); mlb = dd + slope2 * (float)(rowmin + ln - i0) - 0.01f; }
    unsigned kso0, kso1, vso0, vso1;
    { const int r8 = lane >> 3, cp = lane & 7;
      { const int key = 8 * ((2 * w) & 7) + r8, ch = cp ^ ((key >> 1) & 7); kso0 = (unsigned)WS_U + (unsigned)(key * NCOLA + UK + h * 128 + c * 64 + ch * 8) * 2u; }
      { const int key = 8 * ((2 * w + 1) & 7) + r8, ch = cp ^ ((key >> 1) & 7); kso1 = (unsigned)WS_U + (unsigned)(key * NCOLA + UK + h * 128 + c * 64 + ch * 8) * 2u; }
      { const int dv = 8 * (2 * w) + r8, ch = cp ^ ((dv >> 1) & 7); vso0 = (unsigned)WS_VT + (unsigned)((h * 128 + dv) * T + ch * 8) * 2u; }
      { const int dv = 8 * (2 * w + 1) + r8, ch = cp ^ ((dv >> 1) & 7); vso1 = (unsigned)WS_VT + (unsigned)((h * 128 + dv) * T + ch * 8) * 2u; } }
    int o4[4];
#pragma unroll
    for (int j = 0; j < 4; ++j) o4[j] = ln * 128 + (((2 * j + hi) ^ ((ln >> 1) & 7)) << 4);
    f32x16 O[4];
#pragma unroll
    for (int db = 0; db < 4; ++db)
#pragma unroll
        for (int r = 0; r < 16; ++r) O[db][r] = 0.f;
    float m = -__builtin_inff(), lsum = 0.f, al_pend = 1.0f;
    const int jt_hi = jt_top;
#define AB(t) (((jt_hi - (t)) & 3) * 32768)
#define A_GLDS(gp, lp) __builtin_amdgcn_global_load_lds((const unsigned*)(gp), (LAS unsigned*)(lp), 16, 0, 0)
#define A_GL(t) do { const unsigned kb_ = (unsigned)(t) * (unsigned)(64 * NCOLA * 2), vb_ = (unsigned)(t) * 128u; LAS unsigned char* d_ = lds + AB(t) + w * 2048; \
        A_GLDS(wsb + (size_t)(kso0 + kb_), d_); A_GLDS(wsb + (size_t)(kso1 + kb_), d_ + 1024); A_GLDS(wsb + (size_t)(vso0 + vb_), d_ + 16384); A_GLDS(wsb + (size_t)(vso1 + vb_), d_ + 16384 + 1024); } while (0)
#define A_BAR() do { asm volatile("s_waitcnt lgkmcnt(0)" ::: "memory"); __builtin_amdgcn_s_barrier(); asm volatile("" ::: "memory"); } while (0)
#define SB0 __builtin_amdgcn_sched_barrier(0)
#define A_QK(t) do { const LAS unsigned char* b_ = lds + AB(t) + c * 8192; float sl_ = slope2; asm volatile("" : "+v"(sl_)); const float b0_ = sl_ * (float)((t) * 64 + 4 * hi - i0), b1_ = __builtin_fmaf(sl_, 32.0f, b0_); \
        _Pragma("unroll") for (int r = 0; r < 16; ++r) { s0[r] = __builtin_fmaf(sl_, (float)((r & 3) + 8 * (r >> 2)), b0_); s1[r] = __builtin_fmaf(sl_, (float)((r & 3) + 8 * (r >> 2)), b1_); } \
        _Pragma("unroll") for (int ks = 0; ks < 4; ++ks) { const bf16x8 k0_ = *(const LAS bf16x8*)(b_ + o4[ks]); const bf16x8 k1_ = *(const LAS bf16x8*)(b_ + o4[ks] + 4096); \
            s0 = MFMA32(k0_, Qf[ks], s0); s1 = MFMA32(k1_, Qf[ks], s1); } } while (0)
#define A_PVG(b_, db) do { _Pragma("unroll") for (int g = 0; g < 4; ++g) { const bf16x8 vf_ = *(const LAS bf16x8*)((b_) + o4[g] + (db) * 4096); O[db] = MFMA32(vf_, Pf[g], O[db]); } } while (0)
#define A_PV(t) do { const LAS unsigned char* b_ = lds + AB(t) + 16384; A_PVG(b_, 0); SB0; A_PVG(b_, 1); SB0; A_PVG(b_, 2); SB0; A_PVG(b_, 3); SB0; } while (0)
#define A_MASK(t) do { const int j0_ = (t) * 64; if (j0_ + 63 > rowmin) { const int qrow_ = rowmin + ln; \
            _Pragma("unroll") for (int r = 0; r < 16; ++r) { const int key_ = j0_ + crow(r, hi); if (key_ > qrow_) s0[r] = -__builtin_inff(); if (key_ + 32 > qrow_) s1[r] = -__builtin_inff(); } } } while (0)
#define A_SM_MAX() float mx_ = fmaxf(s0[0], s1[0]); \
        _Pragma("unroll") for (int r = 1; r < 16; ++r) mx_ = fmaxf(mx_, fmaxf(s0[r], s1[r])); \
        mx_ = fmaxf(mx_, shx(mx_, lane << 2, 32));
#define A_SM_NEWMAX() const float mn_ = fmaxf(m, mx_); const float al_ = __builtin_amdgcn_exp2f(m - mn_); al_pend = al_; m = mn_;
#define A_SM_EXP(sv) _Pragma("unroll") for (int r = 0; r < 16; ++r) sv[r] = __builtin_amdgcn_exp2f(sv[r] - mn_);
#define A_SM_FIN() float ps_ = 0.f; \
        _Pragma("unroll") for (int r = 0; r < 16; ++r) ps_ += s0[r] + s1[r]; \
        lsum = lsum * al_ + ps_; \
        _Pragma("unroll") for (int s2 = 0; s2 < 2; ++s2) { u32x4 a_, b2_; \
            a_.x = cvt_pk_bf16(s0[8 * s2 + 0], s0[8 * s2 + 1]); a_.y = cvt_pk_bf16(s0[8 * s2 + 2], s0[8 * s2 + 3]); a_.z = cvt_pk_bf16(s0[8 * s2 + 4], s0[8 * s2 + 5]); a_.w = cvt_pk_bf16(s0[8 * s2 + 6], s0[8 * s2 + 7]); \
            b2_.x = cvt_pk_bf16(s1[8 * s2 + 0], s1[8 * s2 + 1]); b2_.y = cvt_pk_bf16(s1[8 * s2 + 2], s1[8 * s2 + 3]); b2_.z = cvt_pk_bf16(s1[8 * s2 + 4], s1[8 * s2 + 5]); b2_.w = cvt_pk_bf16(s1[8 * s2 + 6], s1[8 * s2 + 7]); \
            Pn[s2] = __builtin_bit_cast(bf16x8, a_); Pn[2 + s2] = __builtin_bit_cast(bf16x8, b2_); }
#define A_SOFTMAX(t) do { A_MASK(t); A_SM_MAX(); A_SM_NEWMAX(); A_SM_EXP(s0); A_SM_EXP(s1); A_SM_FIN(); } while (0)
#define A_FUSED(t) do { A_QK((t) - 1); SB0; const LAS unsigned char* vb2_ = lds + AB(t) + 16384; \
        A_PVG(vb2_, 0); A_SM_MAX(); SB0; \
        A_PVG(vb2_, 1); A_SM_NEWMAX(); A_SM_EXP(s0); SB0; \
        A_PVG(vb2_, 2); A_SM_EXP(s1); SB0; \
        A_PVG(vb2_, 3); A_SM_FIN(); SB0; } while (0)
    A_GL(jt_hi); A_GL(jt_hi - 1);
    if (jt_hi - 2 >= jt_bot) { A_GL(jt_hi - 2); asm volatile("s_waitcnt vmcnt(4)" ::: "memory"); } else asm volatile("s_waitcnt vmcnt(0)" ::: "memory");
    A_BAR();
    bool done = false, hasP = false;
    bf16x8 Pf[4], Pn[4];
    f32x16 s0, s1;
    if (jt_hi * 64 <= rowmin + 31) { A_QK(jt_hi); A_SOFTMAX(jt_hi); hasP = true;
#pragma unroll
        for (int g = 0; g < 4; ++g) Pf[g] = Pn[g]; }
    for (int jt = jt_hi; jt >= jt_bot; --jt) {
        const int cur = (jt_hi - jt) & 1;
        if (jt - 3 >= jt_bot) A_GL(jt - 3);
        if (__any(al_pend != 1.0f)) {
#pragma unroll
            for (int db = 0; db < 4; ++db)
#pragma unroll
                for (int r = 0; r < 16; ++r) O[db][r] *= al_pend;
        }
        al_pend = 1.0f;
        bool nvalid = (jt - 1 >= jt_bot) && !done && ((jt - 1) * 64 <= rowmin + 31);
        if (nvalid) {
            const float bnd = qn * kp[jt - 1] - fmaxf(m, mlb) + slope2 * (float)((jt - 1) * 64 + 63 - i0);
            if (__all(bnd < -48.0f)) { done = true; nvalid = false; }
        }
        if (hasP && nvalid) { if ((jt - 1) * 64 + 63 > rowmin) { A_PV(jt); A_QK(jt - 1); A_SOFTMAX(jt - 1); } else { A_FUSED(jt); } }
        else if (hasP) { A_PV(jt); }
        else if (nvalid) { A_QK(jt - 1); A_SOFTMAX(jt - 1); }
        hasP = nvalid;
        if (nvalid) {
#pragma unroll
            for (int g = 0; g < 4; ++g) Pf[g] = Pn[g]; }
        if (lane == 0) flg[cur * 8 + w] = done ? 1u : 0u;
        if (jt - 3 >= jt_bot) asm volatile("s_waitcnt vmcnt(4)" ::: "memory"); else asm volatile("s_waitcnt vmcnt(0)" ::: "memory");
        A_BAR();
        { const u32x4 f0 = *(const LAS u32x4*)(lds + P2_FLG + cur * 32), f1 = *(const LAS u32x4*)(lds + P2_FLG + cur * 32 + 16);
          if ((f0.x & f0.y & f0.z & f0.w & f1.x & f1.y & f1.z & f1.w) != 0u) break; }
    }
    asm volatile("s_waitcnt vmcnt(0)" ::: "memory");
    A_BAR();
#undef AB
#undef A_GLDS
#undef A_GL
#undef A_BAR
#undef SB0
#undef A_QK
#undef A_PVG
#undef A_PV
#undef A_MASK
#undef A_SM_MAX
#undef A_SM_NEWMAX
#undef A_SM_EXP
#undef A_SM_FIN
#undef A_SOFTMAX
#undef A_FUSED
    if (part) {
        float* pw = part + (size_t)w * (PART_WAVE / 4);
#pragma unroll
        for (int db = 0; db < 4; ++db)
#pragma unroll
            for (int r = 0; r < 16; ++r) pw[(db * 16 + r) * 64 + lane] = O[db][r];
        pw[4096 + lane] = m; pw[4160 + lane] = lsum;
    } else attn_finish(lds, O, lsum, MIX, subg, lam, outscale, h, rowmin, c, rg, lane);
}
__device__ __forceinline__ void attn_combine(LAS unsigned char* lds, const unsigned char* wsb, bf16_t* MIX, const float* subg, float lam, float outscale, int qb, const int tid) {
    const int w = __builtin_amdgcn_readfirstlane(tid >> 6), lane = tid & 63, c = w >> 2, rg = w & 3;
    const int nseg = (qb + 16) >> 4, slot0 = g_tabs.segstart[qb];
    const float* pb = (const float*)(wsb + WS_PART) + (size_t)slot0 * (PART_SLOT / 4) + (size_t)w * (PART_WAVE / 4);
    float M = -__builtin_inff();
    for (int s = 0; s < nseg; ++s) M = fmaxf(M, pb[(size_t)s * (PART_SLOT / 4) + 4096 + lane]);
    f32x16 O[4];
#pragma unroll
    for (int db = 0; db < 4; ++db)
#pragma unroll
        for (int r = 0; r < 16; ++r) O[db][r] = 0.f;
    float lsum = 0.f;
    for (int s = 0; s < nseg; ++s) { const float* ps = pb + (size_t)s * (PART_SLOT / 4);
        const float sc = __builtin_amdgcn_exp2f(ps[4096 + lane] - M); lsum += sc * ps[4160 + lane];
#pragma unroll
        for (int db = 0; db < 4; ++db)
#pragma unroll
            for (int r = 0; r < 16; ++r) O[db][r] += sc * ps[(db * 16 + r) * 64 + lane]; }
    attn_finish(lds, O, lsum, MIX, subg, lam, outscale, 3, qb * 128 + 32 * rg, c, rg, lane);
}
#undef MFMA32
}

__device__ __forceinline__ void phase_knorm(Frame& F) {
    const bf16_t* U = (const bf16_t*)(F.ws + WS_U); float* KN = (float*)(F.ws + WS_KN);
    const int gw = F.bid * NWAVES + F.wave, NGW = F.G * NWAVES;
    for (int item = gw; item < 2048; item += NGW) {
        const int hc = item >> 8, jt = item & 255;
        const bf16_t* kr = U + (size_t)(jt * 64 + F.lane) * NCOLA + UK + hc * 64;
        float ss = 0.f;
#pragma unroll
        for (int q = 0; q < 8; ++q) { const u32x4 v = *(const u32x4*)(kr + 8 * q);
            ss += bflo(v.x) * bflo(v.x) + bfhi(v.x) * bfhi(v.x) + bflo(v.y) * bflo(v.y) + bfhi(v.y) * bfhi(v.y) + bflo(v.z) * bflo(v.z) + bfhi(v.z) * bfhi(v.z) + bflo(v.w) * bflo(v.w) + bfhi(v.w) * bfhi(v.w); }
#pragma unroll
        for (int o = 1; o < 64; o <<= 1) ss = fmaxf(ss, shx(ss, F.lane << 2, o));
        if (F.lane == 0) KN[item] = ss;
    }
}

__device__ __forceinline__ void lru_unit(Frame& F, const ArgsV& A_, int l, int unit) {
    const bf16_t* U = (const bf16_t*)(F.ws + WS_U);
    float* HLOC = (float*)(F.ws + WS_HLOC); float* CUMA = (float*)(F.ws + WS_CUMA); float* AGG = (float*)(F.ws + WS_AGG);
    const float* cw = A_.in[9] + l * 4 * 256; const float* cb = A_.in[10] + l * 256;
    const float* wa = A_.in[11] + l * 4 * 4096; const float* ba = A_.in[12] + l * 256;
    const float* wx = A_.in[13] + l * 4 * 4096; const float* bx = A_.in[14] + l * 256; const float* lamp = A_.in[15] + l * 256;
    LAS float* wA = (LAS float*)F.lds; LAS float* wX = wA + 4096; LAS float* xc = wA + 8192; LAS float* wagg = wA + 8192 + 16384;
    const int w = F.wave, d = F.lane;
    const int chunk = unit >> 2, blk = unit & 3, t0 = chunk * 256, ch0 = blk * 64;
    for (int i = F.tid; i < 1024; i += NTHREADS) { *(LAS f32x4*)(wA + 4 * i) = *(const f32x4*)(wa + blk * 4096 + 4 * i); *(LAS f32x4*)(wX + 4 * i) = *(const f32x4*)(wx + blk * 4096 + 4 * i); }
    {
      const int g8 = F.tid & 7, chb = ch0 + 8 * g8;
      f32x4 wv[4][2], bv[2];
#pragma unroll
      for (int j = 0; j < 4; ++j) { wv[j][0] = *(const f32x4*)(cw + j * 256 + chb); wv[j][1] = *(const f32x4*)(cw + j * 256 + chb + 4); }
      bv[0] = *(const f32x4*)(cb + chb); bv[1] = *(const f32x4*)(cb + chb + 4);
#pragma unroll
      for (int k = 0; k < 4; ++k) { const int t = (F.tid >> 3) + 64 * k, tt = t0 + t;
          f32x4 a0 = bv[0], a1 = bv[1];
#pragma unroll
          for (int j = 0; j < 4; ++j) { const int ts = tt - 3 + j;
              if (ts >= 0) { const u32x4 x = *(const u32x4*)(U + (size_t)ts * NCOLA + ULX + chb);
                  a0.x += wv[j][0].x * bflo(x.x); a0.y += wv[j][0].y * bfhi(x.x); a0.z += wv[j][0].z * bflo(x.y); a0.w += wv[j][0].w * bfhi(x.y);
                  a1.x += wv[j][1].x * bflo(x.z); a1.y += wv[j][1].y * bfhi(x.z); a1.z += wv[j][1].z * bflo(x.w); a1.w += wv[j][1].w * bfhi(x.w); } }
          *(LAS f32x4*)(xc + t * 64 + 8 * g8) = a0; *(LAS f32x4*)(xc + t * 64 + 8 * g8 + 4) = a1; } }
    __syncthreads();
    float ga[32], gx[32];
#pragma unroll
    for (int tt = 0; tt < 32; ++tt) { ga[tt] = 0.f; gx[tt] = 0.f; }
    for (int c4 = 0; c4 < 16; ++c4) {
        const float wa0 = wA[(4 * c4 + 0) * 64 + d], wa1 = wA[(4 * c4 + 1) * 64 + d], wa2 = wA[(4 * c4 + 2) * 64 + d], wa3 = wA[(4 * c4 + 3) * 64 + d];
        const float wx0 = wX[(4 * c4 + 0) * 64 + d], wx1 = wX[(4 * c4 + 1) * 64 + d], wx2 = wX[(4 * c4 + 2) * 64 + d], wx3 = wX[(4 * c4 + 3) * 64 + d];
#pragma unroll
        for (int tt = 0; tt < 32; ++tt) { const f32x4 x = *(const LAS f32x4*)(xc + (32 * w + tt) * 64 + 4 * c4);
            ga[tt] += x.x * wa0 + x.y * wa1 + x.z * wa2 + x.w * wa3; gx[tt] += x.x * wx0 + x.y * wx1 + x.z * wx2 + x.w * wx3; } }
    const int ch = ch0 + d; const float bav = ba[ch], bxv = bx[ch];
    const float sp = flog(1.0f + fexp(-lamp[ch]));
    float hl = 0.f, ca = 1.f;
#pragma unroll
    for (int tt = 0; tt < 32; ++tt) {
        const float sa = sigmoidf_(ga[tt] + bav), sx = sigmoidf_(gx[tt] + bxv);
        const float log_a = -8.0f * sa * sp, a = fexp(log_a), mult = fsqrt(fmaxf(1.0f - a * a, 0.f));
        const float b = mult * sx * xc[(32 * w + tt) * 64 + d];
        hl = a * hl + b; ca *= a; ga[tt] = hl; gx[tt] = ca;
    }
    wagg[(w * 2 + 0) * 64 + d] = ca; wagg[(w * 2 + 1) * 64 + d] = hl;
    __syncthreads();
    float cin = 0.f, cprod = 1.f;
    for (int w2 = 0; w2 < w; ++w2) { const float A2 = wagg[(w2 * 2 + 0) * 64 + d], B2 = wagg[(w2 * 2 + 1) * 64 + d]; cin = A2 * cin + B2; cprod *= A2; }
#pragma unroll
    for (int tt = 0; tt < 32; ++tt) { const size_t o = (size_t)(t0 + 32 * w + tt) * 256 + ch; const float hh = ga[tt] + gx[tt] * cin, cA = gx[tt] * cprod; HLOC[o] = hh; CUMA[o] = cA;
        if (w == 7 && tt == 31) { AGG[(chunk * 2 + 0) * 256 + ch] = cA; AGG[(chunk * 2 + 1) * 256 + ch] = hh; } }
    __syncthreads();
}

__device__ __forceinline__ void conf_unit(Frame& F, const ArgsV& A_, int l, int unit) {
    const bf16_t* U = (const bf16_t*)(F.ws + WS_U); bf16_t* MIX = (bf16_t*)(F.ws + WS_MIX);
    const float* cw = A_.in[16] + l * 31 * 256; const float* cb = A_.in[17] + l * 256; const float* lg = A_.in[18] + l * 256; const float* lb = A_.in[19] + l * 256;
    LAS float* gin = (LAS float*)F.lds; LAS float* cout = gin + 62 * 256;
    const int ch = F.tid & 255, half = F.tid >> 8, t0 = unit * 32;
    for (int it = F.tid; it < 62 * 32; it += NTHREADS) { const int r = it >> 5, g8 = it & 31, ts = t0 - 30 + r;
        f32x4 v0 = (f32x4){0.f, 0.f, 0.f, 0.f}, v1 = v0;
        if (ts >= 0) { const u32x4 a = *(const u32x4*)(U + (size_t)ts * NCOLA + UCA + 8 * g8), b = *(const u32x4*)(U + (size_t)ts * NCOLA + UCB + 8 * g8);
            v0.x = bflo(a.x) * sigmoidf_(bflo(b.x)); v0.y = bfhi(a.x) * sigmoidf_(bfhi(b.x)); v0.z = bflo(a.y) * sigmoidf_(bflo(b.y)); v0.w = bfhi(a.y) * sigmoidf_(bfhi(b.y));
            v1.x = bflo(a.z) * sigmoidf_(bflo(b.z)); v1.y = bfhi(a.z) * sigmoidf_(bfhi(b.z)); v1.z = bflo(a.w) * sigmoidf_(bflo(b.w)); v1.w = bfhi(a.w) * sigmoidf_(bfhi(b.w)); }
        *(LAS f32x4*)(gin + r * 256 + 8 * g8) = v0; *(LAS f32x4*)(gin + r * 256 + 8 * g8 + 4) = v1; }
    float wreg[31];
#pragma unroll
    for (int j = 0; j < 31; ++j) wreg[j] = cw[j * 256 + ch];
    const float bb = cb[ch];
    __syncthreads();
    { float x[46];
#pragma unroll
      for (int k = 0; k < 46; ++k) x[k] = gin[(half * 16 + k) * 256 + ch];
#pragma unroll
      for (int tt = 0; tt < 16; ++tt) { float a = bb;
#pragma unroll
          for (int j = 0; j < 31; ++j) a += wreg[j] * x[tt + j];
          cout[(half * 16 + tt) * 256 + ch] = a; } }
    __syncthreads();
#pragma unroll
    for (int q = 0; q < 4; ++q) { const int t = 4 * F.wave + q;
        f32x4 v = *(const LAS f32x4*)(cout + t * 256 + 4 * F.lane);
        const float mean = wave_sum((v.x + v.y) + (v.z + v.w), F.lane << 2) * (1.f / 256.f); v = v - mean;
        const float var = wave_sum((v.x * v.x + v.y * v.y) + (v.z * v.z + v.w * v.w), F.lane << 2) * (1.f / 256.f), rstd = __builtin_amdgcn_rsqf(var + LN_EPS);
        const f32x4 gv = *(const f32x4*)(lg + 4 * F.lane), bv = *(const f32x4*)(lb + 4 * F.lane);
        f32x4 y = v * rstd * gv + bv;
        y.x = y.x * sigmoidf_(y.x); y.y = y.y * sigmoidf_(y.y); y.z = y.z * sigmoidf_(y.z); y.w = y.w * sigmoidf_(y.w);
        u32x2 wv; wv.x = pk2(y.x, y.y); wv.y = pk2(y.z, y.w);
        *(u32x2*)(MIX + (size_t)(t0 + t) * 1024 + 768 + 4 * F.lane) = wv; }
    __syncthreads();
}

__device__ __forceinline__ void phase_mixers(Frame& F, const ArgsV& A_, int l, int probe) {
    const bf16_t* U = (const bf16_t*)(F.ws + WS_U); const bf16_t* VT = (const bf16_t*)(F.ws + WS_VT); bf16_t* MIX = (bf16_t*)(F.ws + WS_MIX);
    { const float* KN = (const float*)(F.ws + WS_KN); LAS float* kp = (LAS float*)(F.lds + P2_KP);
      const int tb = F.wave, ln = F.lane;
      const f32x4 v = *(const f32x4*)(KN + tb * 256 + 4 * ln);
      const float p0 = v.x, p1 = fmaxf(p0, v.y), p2 = fmaxf(p1, v.z), p3 = fmaxf(p2, v.w);
      float run = p3;
#pragma unroll
      for (int o = 1; o < 64; o <<= 1) { const float t = shup(run, ln << 2, o); if (ln >= o) run = fmaxf(run, t); }
      float ex = shup(run, ln << 2, 1); if (ln == 0) ex = 0.f;
      f32x4 o4; o4.x = fsqrt(fmaxf(ex, p0)); o4.y = fsqrt(fmaxf(ex, p1)); o4.z = fsqrt(fmaxf(ex, p2)); o4.w = fsqrt(fmaxf(ex, p3));
      *(LAS f32x4*)(kp + tb * 256 + 4 * ln) = o4;
    }
    float d1 = 0.f, d2 = 0.f;
    { const float* lq1 = A_.in[4] + l * 64; const float* lk1 = A_.in[5] + l * 64; const float* lq2 = A_.in[6] + l * 64; const float* lk2 = A_.in[7] + l * 64;
      d1 = wave_sum(lq1[F.lane] * lk1[F.lane], F.lane << 2); d2 = wave_sum(lq2[F.lane] * lk2[F.lane], F.lane << 2); }
    const float lam_init = 0.8f - 0.6f * fexp(-0.3f * (float)l);
    const float lam = fexp(d1) - fexp(d2) + lam_init;
    const float* subg = A_.in[8] + l * 128;
    unsigned* qhead = (unsigned*)(F.ws + WS_CTL) + CW_QUEUE + 64 * l;
    volatile LAS unsigned* slot = (volatile LAS unsigned*)(F.lds + P2_FLG) + 16;
    __syncthreads();
    for (;;) {
        if (F.tid == 0) slot[0] = atomicAdd(qhead, 1u);
        __syncthreads();
        const int q = (int)__builtin_amdgcn_readfirstlane(slot[0]);
        __syncthreads();
        if (q >= N_ITEMS + 256 + 512) break;
        if (probe) {
            if (probe == 1 && q >= N_ITEMS) continue;
            if (probe == 2 && (q < N_ITEMS || q >= N_ITEMS + 256)) continue;
            if (probe == 3 && q < N_ITEMS + 256) continue;
            if (probe >= 4 && probe <= 7 && (q >= N_ITEMS || (g_tabs.item[g_tabs.order[q]] & 3) != probe - 4)) continue;
        }
        Frame Fu = make_frame(F.lds, F.ws);
        if (q < N_ITEMS) { const int idx = g_tabs.order[q], it = g_tabs.item[idx]; const int h = it & 3, qb = (it >> 2) & 127;
            if (it & 0x8000) { const int seg = (it >> 9) & 7, jt_top = 2 * qb + 1 - SEGT * seg; const int jb = jt_top - (SEGT - 1);
                attn::attn_unit(Fu.lds, (const unsigned char*)Fu.ws, (bf16_t*)(Fu.ws + WS_MIX), subg, lam, 1.0f - lam_init, h, qb, jt_top, jb > 0 ? jb : 0, (float*)(Fu.ws + WS_PART) + (size_t)(idx - N_UNSPLIT) * (PART_SLOT / 4), Fu.tid); }
            else attn::attn_unit(Fu.lds, (const unsigned char*)Fu.ws, (bf16_t*)(Fu.ws + WS_MIX), subg, lam, 1.0f - lam_init, h, qb, 2 * qb + 1, 0, nullptr, Fu.tid); }
        else if (q < N_ITEMS + 256) lru_unit(Fu, A_, l, q - N_ITEMS);
        else conf_unit(Fu, A_, l, q - N_ITEMS - 256);
    }
}

__device__ __forceinline__ void phase_lru_fix(Frame& F, const ArgsV& A_, int l) {
    const bf16_t* U = (const bf16_t*)(F.ws + WS_U); bf16_t* MIX = (bf16_t*)(F.ws + WS_MIX);
    const float* HLOC = (const float*)(F.ws + WS_HLOC); const float* CUMA = (const float*)(F.ws + WS_CUMA); const float* AGG = (const float*)(F.ws + WS_AGG);
    LAS float* ag = (LAS float*)F.lds;
    const int ch = F.tid & 255, half = F.tid >> 8;
    for (int unit = F.bid; unit < 256; unit += F.G) {
        const int chunk = unit >> 2, qt = unit & 3, t0 = chunk * 256 + qt * 64 + half * 32;
        for (int i = F.tid; i < chunk * 128; i += NTHREADS) *(LAS f32x4*)(ag + 4 * i) = *(const f32x4*)(AGG + 4 * i);
        __syncthreads();
        float cin = 0.f;
        for (int k = 0; k < chunk; ++k) cin = ag[(k * 2 + 0) * 256 + ch] * cin + ag[(k * 2 + 1) * 256 + ch];
        for (int t = 0; t < 32; ++t) { const size_t tt = (size_t)(t0 + t);
            const float hh = HLOC[tt * 256 + ch] + CUMA[tt * 256 + ch] * cin;
            const float y = bf2f(U[tt * NCOLA + ULY + ch]);
            const float gl = y * frcp(1.0f + fexp(-2.0f * 0.7978845608028654f * (y + 0.044715f * y * y * y)));
            MIX[tt * 1024 + 512 + ch] = (bf16_t)f2bf(hh * gl); }
        __syncthreads();
    }
    { const float* lq1 = A_.in[4] + l * 64; const float* lk1 = A_.in[5] + l * 64; const float* lq2 = A_.in[6] + l * 64; const float* lk2 = A_.in[7] + l * 64;
      const float d1 = wave_sum(lq1[F.lane] * lk1[F.lane], F.lane << 2), d2 = wave_sum(lq2[F.lane] * lk2[F.lane], F.lane << 2);
      const float lam_init = 0.8f - 0.6f * fexp(-0.3f * (float)l), lam = fexp(d1) - fexp(d2) + lam_init;
      for (int unit = F.bid; unit < 112; unit += F.G) attn::attn_combine(F.lds, (const unsigned char*)F.ws, MIX, A_.in[8] + l * 128, lam, 1.0f - lam_init, 16 + unit, F.tid); }
}

__device__ __forceinline__ void phase_ln1(Frame& F, const ArgsV& A_, int l) {
    const float* HA = (const float*)(F.ws + WS_HA); const float* MO = (const float*)(F.ws + WS_MIXO); float* HB = (float*)(F.ws + WS_HB); bf16_t* XB = (bf16_t*)(F.ws + WS_XB);
    const int gw = F.bid * NWAVES + F.wave, NGW = F.G * NWAVES;
    for (int m = gw; m < T; m += NGW) {
        f32x4 v[4];
#pragma unroll
        for (int j = 0; j < 4; ++j) v[j] = *(const f32x4*)(HA + (size_t)m * D + 4 * F.lane + 256 * j) * ALPHA + *(const f32x4*)(MO + (size_t)m * D + 4 * F.lane + 256 * j);
        ln_store(v, A_.in[21] + l * D, A_.in[22] + l * D, HB + (size_t)m * D, nullptr, F.lane, (unsigned char*)(F.ws + WS_XB8) + (size_t)m * D);
    }
}

__device__ __forceinline__ void phase_router(Frame& F, const ArgsV& A_, int l) {
    const float* HB = (const float*)(F.ws + WS_HB); const float* rw = A_.in[23] + (size_t)l * 1024 * 32; const float* rb = A_.in[24] + l * 32;
    int* TKS = (int*)(F.ws + WS_TKS); float* TKG = (float*)(F.ws + WS_TKG); int* LIST = (int*)(F.ws + WS_LIST);
    unsigned* gcnt = (unsigned*)(F.ws + WS_CTL) + CW_CNT + l * 64;
    LAS float* part = (LAS float*)F.lds;
    LAS float* lg = (LAS float*)(F.lds + 65536);
    LAS unsigned* lcnt = (LAS unsigned*)(F.lds + 81920);
    const int ln = F.lane & 31, hf = F.lane >> 5, kb = F.wave * 128;
    float rwv[16][4];
#pragma unroll
    for (int i = 0; i < 16; ++i)
#pragma unroll
        for (int s = 0; s < 4; ++s) rwv[i][s] = rw[(size_t)(kb + 8 * i + 4 * hf + s) * 32 + ln];
    for (int base = F.bid * 64; base < T; base += F.G * 64) {
        if (F.tid < 64) lcnt[F.tid] = 0u;
#pragma unroll
        for (int g = 0; g < 2; ++g) {
            f32x4 hv[16];
            const float* hp = HB + (size_t)(base + 32 * g + ln) * D + kb + 4 * hf;
#pragma unroll
            for (int i = 0; i < 16; ++i) hv[i] = *(const f32x4*)(hp + 8 * i);
            f32x16 acc;
#pragma unroll
            for (int r = 0; r < 16; ++r) acc[r] = 0.f;
#pragma unroll
            for (int i = 0; i < 16; ++i) {
                acc = __builtin_amdgcn_mfma_f32_32x32x2f32(rwv[i][0], hv[i].x, acc, 0, 0, 0);
                acc = __builtin_amdgcn_mfma_f32_32x32x2f32(rwv[i][1], hv[i].y, acc, 0, 0, 0);
                acc = __builtin_amdgcn_mfma_f32_32x32x2f32(rwv[i][2], hv[i].z, acc, 0, 0, 0);
                acc = __builtin_amdgcn_mfma_f32_32x32x2f32(rwv[i][3], hv[i].w, acc, 0, 0, 0);
            }
#pragma unroll
            for (int r = 0; r < 16; ++r) { const int e = (r & 3) + 8 * (r >> 2) + 4 * hf; part[((F.wave * 2 + g) * 32 + e) * 32 + ln] = acc[r]; }
        }
        __syncthreads();
        { const int tt = F.tid & 63, eg = F.tid >> 6;
#pragma unroll
          for (int q = 0; q < 4; ++q) { const int e = 4 * eg + q; float s = rb[e];
#pragma unroll
              for (int w2 = 0; w2 < 8; ++w2) s += part[((w2 * 2 + (tt >> 5)) * 32 + e) * 32 + (tt & 31)];
              lg[tt * 33 + e] = s; } }
        __syncthreads();
        int sel[4]; float sv[4]; int pos[4];
        if (F.tid < 64) {
            float v[32];
#pragma unroll
            for (int e = 0; e < 32; ++e) v[e] = lg[F.tid * 33 + e];
#pragma unroll
            for (int k = 0; k < 4; ++k) { float best = -__builtin_inff(); int bi = 0;
#pragma unroll
                for (int e = 0; e < 32; ++e) { if (v[e] > best) { best = v[e]; bi = e; } }
                sel[k] = bi; sv[k] = best;
#pragma unroll
                for (int e = 0; e < 32; ++e) if (e == bi) v[e] = -__builtin_inff(); }
            const float e1 = fexp(sv[1] - sv[0]), e2 = fexp(sv[2] - sv[0]), e3 = fexp(sv[3] - sv[0]), inv = 1.0f / (1.0f + e1 + e2 + e3);
            sv[0] = inv; sv[1] = e1 * inv; sv[2] = e2 * inv; sv[3] = e3 * inv;
#pragma unroll
            for (int k = 0; k < 4; ++k) pos[k] = (int)atomicAdd((unsigned*)&lcnt[sel[k]], 1u);
        }
        __syncthreads();
        if (F.tid < 32) lcnt[32 + F.tid] = atomicAdd(&gcnt[F.tid], lcnt[F.tid]);
        __syncthreads();
        if (F.tid < 64) {
            const int t = base + F.tid;
#pragma unroll
            for (int k = 0; k < 4; ++k) { const int p = pos[k] + (int)lcnt[32 + sel[k]]; TKS[t * 4 + k] = sel[k] * T + p; TKG[t * 4 + k] = sv[k]; LIST[(size_t)sel[k] * T + p] = t; }
        }
        __syncthreads();
    }
}

__device__ __forceinline__ void moe_tables(Frame& F, int l, int NT) {
    LAS int* tab = (LAS int*)(F.lds + MISC_OFF);
    if (F.wave == 0) {
        const unsigned* gcnt = (const unsigned*)(F.ws + WS_CTL) + CW_CNT + l * 64;
        const int e = F.lane & 31;
        const int c = (int)__hip_atomic_load(&gcnt[e], __ATOMIC_RELAXED, __HIP_MEMORY_SCOPE_AGENT);
        const int tm = (c + 255) >> 8;
        int incl = tm;
#pragma unroll
        for (int o = 1; o < 32; o <<= 1) { const int v = shupi(incl, F.lane << 2, o); if (e >= o) incl += v; }
        if (F.lane < 32) { tab[e] = (incl - tm) * NT; tab[40 + e] = (incl - tm) * 256; tab[80 + e] = c; if (e == 31) tab[32] = incl * NT; }
    }
    __syncthreads();
}

__device__ __forceinline__ void phase_combine(Frame& F, const ArgsV& A_, int l, float* outp) {
    moe_tables(F, l, 1);
    const LAS int* tab = (const LAS int*)(F.lds + MISC_OFF);
    const float* HB = (const float*)(F.ws + WS_HB); const bf16_t* Y = (const bf16_t*)(F.ws + WS_Y);
    const int* TKS = (const int*)(F.ws + WS_TKS); const float* TKG = (const float*)(F.ws + WS_TKG);
    float* HA = outp ? outp : (float*)(F.ws + WS_HA); bf16_t* XB = outp ? nullptr : (bf16_t*)(F.ws + WS_XB);
    const int gw = F.bid * NWAVES + F.wave, NGW = F.G * NWAVES;
    for (int m = gw; m < T; m += NGW) {
        f32x4 v[4];
#pragma unroll
        for (int j = 0; j < 4; ++j) v[j] = *(const f32x4*)(HB + (size_t)m * D + 4 * F.lane + 256 * j) * ALPHA;
#pragma unroll
        for (int k = 0; k < 4; ++k) { const int code = TKS[m * 4 + k]; const float g = TKG[m * 4 + k]; const int e = code >> 14, p = code & (T - 1);
            const bf16_t* yr = Y + (size_t)(tab[40 + e] + p) * 1024 + 4 * F.lane;
#pragma unroll
            for (int j = 0; j < 4; ++j) { const u32x2 wv = *(const u32x2*)(yr + 256 * j); v[j].x += g * bflo(wv.x); v[j].y += g * bfhi(wv.x); v[j].z += g * bflo(wv.y); v[j].w += g * bfhi(wv.y); } }
        ln_store(v, A_.in[29] + l * D, A_.in[30] + l * D, HA + (size_t)m * D, XB ? XB + (size_t)m * D : nullptr, F.lane);
    }
    __syncthreads();
}

constexpr int PH_PER_LAYER = 10, N_PHASES = 1 + NL * PH_PER_LAYER;

__global__ void __launch_bounds__(NTHREADS, 2) mk_fwd(Args args) {
    extern __shared__ __attribute__((aligned(16))) unsigned char lds_raw[];
    LAS unsigned char* const lds = (LAS unsigned char*)lds_raw;
    const int lo = args.ph_lo, hi = args.ph_hi;
    volatile LAS unsigned* bst = (volatile LAS unsigned*)(lds + MISC_OFF + 2048);
    if (threadIdx.x < 2) bst[threadIdx.x] = 0u;
    if (threadIdx.x == 0) {
        LAS unsigned long long* pt = (LAS unsigned long long*)(lds + PTAB_OFF);
#pragma unroll
        for (int k = 0; k < 31; ++k) pt[k] = (unsigned long long)args.in[k];
    }
    __syncthreads();
    XcdBarrier bar; bar.bar = (unsigned*)(args.ws + WS_CTL) + CW_BAR; bar.x = 0; bar.st = bst;
    if (hi - lo > 1) bar = xcd_barrier_post((unsigned*)(args.ws + WS_CTL) + CW_BAR, bst);
    const ArgsV AV{InTab{lds}};
#ifdef ONLY_SUB
    const int only_sub = ONLY_SUB;
#else
    const int only_sub = -2;
#endif
#pragma unroll 1
    for (int ph = lo; ph < hi; ++ph) {
        const int l = (ph > 0) ? (ph - 1) / PH_PER_LAYER : 0;
        int sub = (ph > 0) ? (ph - 1) % PH_PER_LAYER : -1;
        if (only_sub != -2 && sub != only_sub) continue;
        bool seam = true;
        switch (sub) {
        case -1: { Frame F = make_frame(lds, args.ws); phase_prologue(F, AV); } break;
        case 0: {
            Frame F = make_frame(lds, args.ws);
            pg8::PlainOrder S; S.init(WS_XB, WS_WINT + (size_t)l * 2560 * 1024 * 2, T, NCOLA, F.G, F.bid);
            pg8::EpiBf16 E{(bf16_t*)(F.ws + WS_U), NCOLA, nullptr, 0, 0.125f * LOG2E, 512};
            pg8::gemm_phase<pg8::EpiBf16, pg8::PlainOrder, true>(F.lds, (const char*)F.ws, F.tid, S, E); } break;
        case 1: {
            Frame F = make_frame(lds, args.ws);
            pg8::PlainOrder S; S.init(WS_WINT + ((size_t)l * 2560 + 2048) * 1024 * 2, WS_XB, 512, T, F.G, F.bid);
            pg8::EpiVT E{(bf16_t*)(F.ws + WS_VT)};
            pg8::gemm_phase<pg8::EpiVT, pg8::PlainOrder, true>(F.lds, (const char*)F.ws, F.tid, S, E);
            phase_knorm(F); } break;
        case 2: { Frame F = make_frame(lds, args.ws); phase_mixers(F, AV, l, args.probe); } break;
        case 3: { Frame F = make_frame(lds, args.ws); phase_lru_fix(F, AV, l); } break;
        case 4: {
            Frame F = make_frame(lds, args.ws);
            pg8::PlainOrder S; S.init(WS_MIX, WS_WOUTT + (size_t)l * 1024 * 1024 * 2, T, D, F.G, F.bid);
            pg8::EpiF32 E{(float*)(F.ws + WS_MIXO), D};
            pg8::gemm_phase<pg8::EpiF32, pg8::PlainOrder, true>(F.lds, (const char*)F.ws, F.tid, S, E); } break;
        case 5: { Frame F = make_frame(lds, args.ws); phase_ln1(F, AV, l); } break;
        case 6: { Frame F = make_frame(lds, args.ws); phase_router(F, AV, l); } break;
        case 7: {
            Frame F = make_frame(lds, args.ws);
            moe_tables(F, l, 8);
            pg8::MoeOrder S{(unsigned)WS_XB8, (unsigned)(WS_W1T + (size_t)l * NE * 2048 * 1024), 2048u * 1024u, 8, 1, (const int*)(F.ws + WS_LIST), (const LAS int*)(F.lds + MISC_OFF), F.G, F.bid, KD};
            pg8::EpiAct E{(unsigned char*)(F.ws + WS_ACT), AV.in[26] + (size_t)l * NE * 2048};
            pg8::gemm_phase<pg8::EpiAct, pg8::MoeOrder, true, true>(F.lds, (const char*)F.ws, F.tid, S, E); } break;
        case 8: {
            Frame F = make_frame(lds, args.ws);
            moe_tables(F, l, 4);
            pg8::MoeOrder S{(unsigned)WS_ACT, (unsigned)(WS_W2T + (size_t)l * NE * 1024 * 1024), 1024u * 1024u, 4, 0, nullptr, (const LAS int*)(F.lds + MISC_OFF), F.G, F.bid, KD};
            pg8::EpiBf16 E{(bf16_t*)(F.ws + WS_Y), 1024, AV.in[28] + (size_t)l * NE * 1024, 1024, 1.0f, 0};
            pg8::gemm_phase<pg8::EpiBf16, pg8::MoeOrder, true, true>(F.lds, (const char*)F.ws, F.tid, S, E); } break;
        default: { Frame F = make_frame(lds, args.ws); phase_combine(F, AV, l, (l == NL - 1) ? args.out : nullptr); } break;
        }
        if (seam && ph + 1 < hi) xcd_barrier(bar);
    }
}

extern "C" void kernel_launch(void* const* d_in, const int* in_sizes, int n_in, void* d_out, int out_size, void* d_ws, size_t ws_size, hipStream_t stream) {
    static int grid = 0;
    if (grid == 0) {
        if (n_in != 31 || out_size != T * D || ws_size < WS_END2) { fprintf(stderr, "kernel_launch: unexpected sizes n_in %d out %d ws %zu (need %zu)\n", n_in, out_size, ws_size, (size_t)WS_END); grid = -1; return; }
        int dev = 0, cus = 0, per_cu = 0;
        if (hipGetDevice(&dev) != hipSuccess || hipDeviceGetAttribute(&cus, hipDeviceAttributeMultiprocessorCount, dev) != hipSuccess) { grid = -1; return; }
        if (hipFuncSetAttribute((const void*)mk_fwd, hipFuncAttributeMaxDynamicSharedMemorySize, LDS_BYTES) != hipSuccess) { fprintf(stderr, "kernel_launch: hipFuncSetAttribute failed\n"); grid = -1; return; }
        if (hipOccupancyMaxActiveBlocksPerMultiprocessor(&per_cu, (const void*)mk_fwd, NTHREADS, LDS_BYTES) != hipSuccess || per_cu < 1) { fprintf(stderr, "kernel_launch: occupancy query says %d blocks per CU\n", per_cu); (void)hipGetLastError(); grid = -1; return; }
        grid = cus;
    }
    if (grid < 0) return;
    (void)hipMemsetAsync((char*)d_ws + WS_CTL, 0, CTL_ZERO_BYTES, stream);
    Args a{};
    for (int i = 0; i < 31; ++i) a.in[i] = (const float*)d_in[i];
    a.out = (float*)d_out; a.ws = (unsigned char*)d_ws;
#if MK_ONE_LAUNCH
    a.ph_lo = 0; a.ph_hi = N_PHASES;
    hipLaunchKernelGGL(mk_fwd, dim3(grid), dim3(NTHREADS), LDS_BYTES, stream, a);
#ifdef PROBE_LO
    (void)hipMemsetAsync((char*)d_ws + WS_CTL + CW_BAR * 4, 0, XCD_BAR_WORDS * 4, stream);
    (void)hipMemsetAsync((char*)d_ws + WS_CTL + CW_QUEUE * 4, 0, 1024, stream);
    a.probe = PROBE_MODE;
    a.ph_lo = PROBE_LO; a.ph_hi = PROBE_HI;
    hipLaunchKernelGGL(mk_fwd, dim3(grid), dim3(NTHREADS), LDS_BYTES, stream, a);
#endif
#else
    for (int p = 0; p < N_PHASES; ++p) { a.ph_lo = p; a.ph_hi = p + 1; hipLaunchKernelGGL(mk_fwd, dim3(grid), dim3(NTHREADS), LDS_BYTES, stream, a); }
#endif
}
```

```cpp
#include <hip/hip_runtime.h>
#include <cstdio>
#include <cstdint>

#ifndef PROBE_DUP
#define PROBE_DUP 0
#endif
#ifndef MK_ONE_LAUNCH
#define MK_ONE_LAUNCH 1
#endif

#define LAS __attribute__((address_space(3)))
#define GAS __attribute__((address_space(1)))
typedef unsigned short bf16_t;
typedef short bf16x8 __attribute__((ext_vector_type(8)));
typedef float f32x2 __attribute__((ext_vector_type(2)));
typedef float f32x4 __attribute__((ext_vector_type(4)));
typedef float f32x16 __attribute__((ext_vector_type(16)));
typedef unsigned u32x4 __attribute__((ext_vector_type(4)));
typedef unsigned u32x2 __attribute__((ext_vector_type(2)));
typedef int i32x8 __attribute__((ext_vector_type(8)));
typedef int i32x4 __attribute__((ext_vector_type(4)));

constexpr int T = 16384, D = 1024, NL = 2, NE = 32, KD = 1024;
constexpr int NCOLA = 2048;
constexpr int UQ = 0, UK = 512, ULX = 1024, ULY = 1280, UCA = 1536, UCB = 1792;
constexpr float LN_EPS = 1e-5f;
constexpr float ALPHA = 1.41421356237309515f;
constexpr float LOG2E = 1.44269504088896341f;
constexpr int NWAVES = 8, NTHREADS = 512;
constexpr int ACT_ROWS = 65536 + 32 * 256 + 256;

constexpr size_t MiB = 1u << 20;
constexpr size_t WS_CTL = 0, CTL_ZERO_BYTES = 1 * MiB;
constexpr size_t WS_WINT = 2 * MiB;
constexpr size_t WS_WOUTT = 12 * MiB;
constexpr size_t WS_W1T = 16 * MiB;
constexpr size_t WS_W2T = 272 * MiB;
constexpr size_t WS_HA = 400 * MiB;
constexpr size_t WS_HB = 464 * MiB;
constexpr size_t WS_XB = 528 * MiB;
constexpr size_t WS_U = 560 * MiB;
constexpr size_t WS_VT = 624 * MiB;
constexpr size_t WS_MIX = 640 * MiB;
constexpr size_t WS_MIXO = 672 * MiB;
constexpr size_t WS_HLOC = 736 * MiB;
constexpr size_t WS_CUMA = 752 * MiB;
constexpr size_t WS_AGG = 768 * MiB;
constexpr size_t WS_TKS = 769 * MiB;
constexpr size_t WS_TKG = 769 * MiB + 512 * 1024;
constexpr size_t WS_LIST = 770 * MiB;
constexpr size_t WS_ACT = 772 * MiB;
constexpr size_t WS_Y = 920 * MiB;
constexpr size_t WS_END = 1068 * MiB;
static_assert(WS_ACT + (size_t)ACT_ROWS * 2048 <= WS_Y && WS_Y + (size_t)ACT_ROWS * 2048 <= WS_END, "ws map");
constexpr int CW_BAR = 4096;
constexpr int CW_CNT = 16384;

constexpr int RING_BYTES = 135168;
constexpr int MISC_OFF = RING_BYTES;
constexpr int LDS_BYTES = 147456;
constexpr int VA_PARK_OFF = MISC_OFF + 4096;

__device__ __forceinline__ unsigned f2bf(float f) { unsigned u = __builtin_bit_cast(unsigned, f); return (u + 0x7fffu + ((u >> 16) & 1u)) >> 16; }
__device__ __forceinline__ unsigned pk2(float lo, float hi) { return f2bf(lo) | (f2bf(hi) << 16); }
__device__ __forceinline__ float bf2f(bf16_t v) { return __builtin_bit_cast(float, (unsigned)v << 16); }
__device__ __forceinline__ float bflo(unsigned w) { return __builtin_bit_cast(float, w << 16); }
__device__ __forceinline__ float bfhi(unsigned w) { return __builtin_bit_cast(float, w & 0xffff0000u); }
__device__ __forceinline__ unsigned cvt_pk_bf16(float lo, float hi) { unsigned r; asm volatile("v_cvt_pk_bf16_f32 %0, %1, %2" : "=v"(r) : "v"(lo), "v"(hi)); return r; }
__device__ __forceinline__ float shx(float v, int lane4, int mask) { return __builtin_bit_cast(float, __builtin_amdgcn_ds_bpermute(lane4 ^ (mask << 2), __builtin_bit_cast(int, v))); }
__device__ __forceinline__ float shup(float v, int lane4, int d) { return __builtin_bit_cast(float, __builtin_amdgcn_ds_bpermute(lane4 - (d << 2), __builtin_bit_cast(int, v))); }
__device__ __forceinline__ int shupi(int v, int lane4, int d) { return __builtin_amdgcn_ds_bpermute(lane4 - (d << 2), v); }
__device__ __forceinline__ float wave_sum(float v, int lane4) {
#pragma unroll
    for (int o = 1; o < 64; o <<= 1) v += shx(v, lane4, o);
    return v;
}
__device__ __forceinline__ float ex2(float x) { return __builtin_amdgcn_exp2f(x); }
__device__ __forceinline__ float fexp(float x) { return __builtin_amdgcn_exp2f(x * LOG2E); }
__device__ __forceinline__ float frcp(float x) { return __builtin_amdgcn_rcpf(x); }
__device__ __forceinline__ float fsqrt(float x) { return __builtin_amdgcn_sqrtf(x); }
__device__ __forceinline__ float flog(float x) { return __builtin_amdgcn_logf(x) * 0.693147180559945f; }
__device__ __forceinline__ float vmax3(float a, float b, float c) { float r; asm("v_max3_f32 %0, %1, %2, %3" : "=v"(r) : "v"(a), "v"(b), "v"(c)); return r; }
__device__ __forceinline__ float vadd(float a, float b) { float r; asm("v_add_f32 %0, %1, %2" : "=v"(r) : "v"(a), "v"(b)); return r; }
__device__ __forceinline__ float sigmoidf_(float x) { return frcp(1.0f + fexp(-x)); }
#define LDS_WAIT() asm volatile("s_waitcnt lgkmcnt(0)" ::: "memory")
#define VM_WAIT() asm volatile("s_waitcnt vmcnt(0)" ::: "memory")

namespace pg8 {
constexpr int BM = 256, BK = 64, HALF = 128, HTB = HALF * BK * 2, STAGE_BYTES = 8 * HTB, NXCD = 8, WGM = 8;
__device__ __forceinline__ int lds_byte(int r, int c) { const int st = (r >> 4) * 2 + (c >> 5), rr = r & 15, cc = c & 31, ob = rr * 64 + cc * 2; return st * 1024 + (ob ^ (((ob >> 9) & 1) << 5)); }
__device__ __forceinline__ void stage_rc(int b, int& R, int& C) { const unsigned ub = (unsigned)b, st = ub >> 10, sb = ub & 1023u, swz = sb ^ (((sb >> 9) & 1u) << 5); R = (int)((st >> 1) * 16u + (swz >> 6)); C = (int)((st & 1u) * 32u + ((swz & 63u) >> 1)); }
__device__ __forceinline__ int perm32(int rho) { const int n = rho >> 4, i = rho & 15; return 8 * (i >> 2) + 4 * n + (i & 3); }

struct Unit { unsigned A, B; int pn, e, orow; unsigned va00, va01, va10, va11; };

struct PlainOrder {
    unsigned A, Bt; int nM, nN, nwg, G, c, rowb;
    __device__ void init(size_t A_, size_t Bt_, int M, int N, int G_, int c_, int rowb_ = KD * 2) { rowb = rowb_; A = (unsigned)A_; Bt = (unsigned)Bt_; nM = M / BM; nN = N / BM; nwg = nM * nN; G = G_; c = c_; }
    __device__ __forceinline__ bool next(int i, Unit& u, int tid) const {
        const long L = (long)i * G + c; if (L >= nwg) return false;
        int R0, C0, R1, C1; stage_rc(tid * 16, R0, C0); stage_rc(tid * 16 + 8192, R1, C1);
        int wgid = (int)L; { const int q = nwg / NXCD, r = nwg % NXCD, xcd = wgid % NXCD, off = wgid / NXCD; wgid = (xcd < r ? xcd * (q + 1) : r * (q + 1) + (xcd - r) * q) + off; }
        const int nig = WGM * nN, gid = wgid / nig, fm = gid * WGM, gsz = (nM - fm) < WGM ? (nM - fm) : WGM;
        const int pm = fm + ((wgid % nig) % gsz), pn = (wgid % nig) / gsz;
        u.A = A + (unsigned)pm * (unsigned)(BM * rowb); u.B = Bt + (unsigned)pn * (unsigned)(BM * rowb); u.pn = pn; u.e = 0; u.orow = pm * BM;
        u.va00 = (unsigned)(R0 * rowb + C0 * 2); u.va01 = (unsigned)(R1 * rowb + C1 * 2); u.va10 = (unsigned)((R0 + HALF) * rowb + C0 * 2); u.va11 = (unsigned)((R1 + HALF) * rowb + C1 * 2);
        return true;
    }
};

struct MoeOrder {
    unsigned Abase, Bt, bstride; int NT; int gather; const int* list; const LAS int* tab; int G, c, rowb;
    __device__ __forceinline__ bool next(int i, Unit& u, int tid) const {
        const int NU = __builtin_amdgcn_readfirstlane(tab[32]);
        int L;
        if ((G & 7) == 0) { const int g8 = G >> 3, per = (NU + 7) >> 3, idx = i * g8 + (c >> 3); if (idx >= per) return false; L = (c & 7) * per + idx; }
        else L = i * G + c;
        if (L >= NU) return false;
        int R0, C0, R1, C1; stage_rc(tid * 16, R0, C0); stage_rc(tid * 16 + 8192, R1, C1);
        const int ln_ = tid & 63;
        int e = __popcll(__ballot(ln_ >= 1 && ln_ < 32 && L >= tab[ln_ & 31]));
        e = __builtin_amdgcn_readfirstlane(e);
        const int ub = __builtin_amdgcn_readfirstlane(tab[e]), ub1 = __builtin_amdgcn_readfirstlane(tab[e + 1]);
        const int ps = __builtin_amdgcn_readfirstlane(tab[40 + e]), cnt = __builtin_amdgcn_readfirstlane(tab[80 + e]);
        const int tm = (ub1 - ub) / NT, r = L - ub, mt = r % tm, nt = r / tm;
        u.e = e; u.pn = nt; u.orow = ps + mt * BM;
        u.B = Bt + (unsigned)e * bstride + (unsigned)nt * (unsigned)(BM * rowb);
        if (gather) {
            u.A = Abase;
            const int* lp = list + (size_t)e * T + mt * BM; const int lim = cnt - mt * BM;
            const int t00 = (R0 < lim) ? lp[R0] : 0, t01 = (R1 < lim) ? lp[R1] : 0, t10 = (R0 + HALF < lim) ? lp[R0 + HALF] : 0, t11 = (R1 + HALF < lim) ? lp[R1 + HALF] : 0;
            u.va00 = (unsigned)(t00 * rowb + C0 * 2); u.va01 = (unsigned)(t01 * rowb + C1 * 2); u.va10 = (unsigned)(t10 * rowb + C0 * 2); u.va11 = (unsigned)(t11 * rowb + C1 * 2);
        } else {
            u.A = Abase + (unsigned)u.orow * (unsigned)rowb;
            u.va00 = (unsigned)(R0 * rowb + C0 * 2); u.va01 = (unsigned)(R1 * rowb + C1 * 2); u.va10 = (unsigned)((R0 + HALF) * rowb + C0 * 2); u.va11 = (unsigned)((R1 + HALF) * rowb + C1 * 2);
        }
        return true;
    }
};

struct EpiBf16 {
    static constexpr bool PERM = true;
    bf16_t* O; int ldc; const float* bias; int bias_stride; float scale0; int scale_cols;
    __device__ __forceinline__ void operator()(const f32x4 (&acc)[2][2][4][2], const Unit& u, int wr, int wc, int fr, int fq) const {
        const int row0 = u.orow + wr * 64 + fr, colt = u.pn * BM, col0 = colt + wc * 32 + 8 * fq;
        const float sc = (colt < scale_cols) ? scale0 : 1.f;
        const float* bp = bias ? bias + (size_t)u.e * bias_stride : nullptr;
        f32x4 bv[2][2];
#pragma unroll
        for (int bj = 0; bj < 2; ++bj)
#pragma unroll
            for (int n = 0; n < 2; ++n) bv[bj][n] = bp ? *(const f32x4*)(bp + col0 + bj * HALF + 4 * n) : (f32x4){0.f, 0.f, 0.f, 0.f};
#pragma unroll
        for (int ai = 0; ai < 2; ++ai)
#pragma unroll
            for (int m = 0; m < 4; ++m) { bf16_t* rowp = O + (size_t)(row0 + ai * HALF + m * 16) * ldc + col0;
#pragma unroll
                for (int bj = 0; bj < 2; ++bj) { f32x4 v0 = (acc[ai][bj][m][0] + bv[bj][0]) * sc, v1 = (acc[ai][bj][m][1] + bv[bj][1]) * sc;
                    u32x4 w; w.x = cvt_pk_bf16(v0[0], v0[1]); w.y = cvt_pk_bf16(v0[2], v0[3]); w.z = cvt_pk_bf16(v1[0], v1[1]); w.w = cvt_pk_bf16(v1[2], v1[3]);
                    *(u32x4*)(rowp + bj * HALF) = w; } }
    }
};
struct EpiVT {
    static constexpr bool PERM = false;
    bf16_t* O;
    __device__ __forceinline__ void operator()(const f32x4 (&acc)[2][2][4][2], const Unit& u, int wr, int wc, int fr, int fq) const {
        const int sfq = (fq == 1) ? 2 : ((fq == 2) ? 1 : fq);
        const int row0 = u.orow + wr * 64 + fr, col0 = u.pn * BM + wc * 32 + 4 * sfq;
#pragma unroll
        for (int ai = 0; ai < 2; ++ai)
#pragma unroll
            for (int m = 0; m < 4; ++m) { bf16_t* rowp = O + (size_t)(row0 + ai * HALF + m * 16) * T + col0;
#pragma unroll
                for (int bj = 0; bj < 2; ++bj)
#pragma unroll
                    for (int n = 0; n < 2; ++n) { const f32x4 v = acc[ai][bj][m][n]; u32x2 w; w.x = cvt_pk_bf16(v[0], v[1]); w.y = cvt_pk_bf16(v[2], v[3]); *(u32x2*)(rowp + bj * HALF + n * 16) = w; } }
    }
};
struct EpiF32 {
    static constexpr bool PERM = false;
    float* O; int ldc;
    __device__ __forceinline__ void operator()(const f32x4 (&acc)[2][2][4][2], const Unit& u, int wr, int wc, int fr, int fq) const {
        const int row0 = u.orow + wr * 64 + fr, col0 = u.pn * BM + wc * 32 + 4 * fq;
#pragma unroll
        for (int ai = 0; ai < 2; ++ai)
#pragma unroll
            for (int m = 0; m < 4; ++m) { float* rowp = O + (size_t)(row0 + ai * HALF + m * 16) * ldc + col0;
#pragma unroll
                for (int bj = 0; bj < 2; ++bj)
#pragma unroll
                    for (int n = 0; n < 2; ++n) *(f32x4*)(rowp + bj * HALF + n * 16) = acc[ai][bj][m][n]; }
    }
};
struct EpiAct {
    static constexpr bool PERM = true;
    unsigned char* O; const float* b1;
    __device__ __forceinline__ void operator()(const f32x4 (&acc)[2][2][4][2], const Unit& u, int wr, int wc, int fr, int fq) const {
        const int row0 = u.orow + wr * 64 + fr, j0 = u.pn * HALF + wc * 32 + 8 * fq;
        const float* bp = b1 + (size_t)u.e * 2048;
        f32x4 bg[2], bl[2];
#pragma unroll
        for (int n = 0; n < 2; ++n) { bg[n] = *(const f32x4*)(bp + j0 + 4 * n); bl[n] = *(const f32x4*)(bp + 1024 + j0 + 4 * n); }
#pragma unroll
        for (int ai = 0; ai < 2; ++ai)
#pragma unroll
            for (int m = 0; m < 4; ++m) { unsigned char* rowp = O + (size_t)(row0 + ai * HALF + m * 16) * 1024 + j0;
                float o[8];
#pragma unroll
                for (int n = 0; n < 2; ++n)
#pragma unroll
                    for (int q = 0; q < 4; ++q) { float g = acc[ai][0][m][n][q] + bg[n][q], l = acc[ai][1][m][n][q] + bl[n][q];
                        g = fminf(g, 7.0f); l = fminf(fmaxf(l, -7.0f), 7.0f);
                        o[n * 4 + q] = g * (1.0f / (1.0f + __builtin_amdgcn_exp2f(-1.702f * LOG2E * g))) * (l + 1.0f); }
                int w0 = 0, w1 = 0;
                w0 = __builtin_amdgcn_cvt_pk_fp8_f32(o[0], o[1], w0, false); w0 = __builtin_amdgcn_cvt_pk_fp8_f32(o[2], o[3], w0, true);
                w1 = __builtin_amdgcn_cvt_pk_fp8_f32(o[4], o[5], w1, false); w1 = __builtin_amdgcn_cvt_pk_fp8_f32(o[6], o[7], w1, true);
                u32x2 w; w.x = (unsigned)w0; w.y = (unsigned)w1; *(u32x2*)rowp = w; }
    }
};

__device__ __forceinline__ void mfma_fp8(f32x4& acc, const i32x8 w, const i32x8 x, int sw, int sx) {
    asm volatile("s_nop 1\n\tv_mfma_scale_f32_16x16x128_f8f6f4 %0, %1, %2, %0, %3, %4 op_sel_hi:[0,0,0]" : "+v"(acc) : "v"(w), "v"(x), "v"(sw), "v"(sx));
}
template <class Epi, class Sched, bool ALIGN_EPI, bool FP8 = false>
__device__ __forceinline__ void gemm_phase(LAS unsigned char* lds, const char* wsb, const int tid0, const Sched& S, const Epi& E) {
    Unit cur, nxt; int ui = 0;
    if (!S.next(0, cur, tid0)) return;
    int tid = tid0; asm volatile("" : "+v"(tid));
    const int wid = __builtin_amdgcn_readfirstlane(tid >> 6), lane = tid & 63, wr = wid >> 2, wc = wid & 3, fr = lane & 15, fq = lane >> 4;
    constexpr int ROWB = FP8 ? KD : KD * 2, nt = ROWB / (BK * 2);
    unsigned voffB[2];
    { int R0, C0, R1, C1; stage_rc(tid * 16, R0, C0); stage_rc(tid * 16 + 8192, R1, C1);
      const int Rb0 = Epi::PERM ? ((R0 & ~31) + perm32(R0 & 31)) : R0, Rb1 = Epi::PERM ? ((R1 & ~31) + perm32(R1 & 31)) : R1;
      voffB[0] = (unsigned)(Rb0 * ROWB + C0 * 2); voffB[1] = (unsigned)(Rb1 * ROWB + C1 * 2); }
    constexpr unsigned kstep = (unsigned)(BK * 2);
    constexpr unsigned hstep = (unsigned)HALF * ROWB;
    const unsigned ldsw = (unsigned)wid * 1024u;
    const int aoff = lds_byte(wr * 64 + fr, fq * 8), boff = lds_byte(wc * 32 + fr, fq * 8);
#define PG8_SA(b, h) (((b) * 2 + (h)) * HTB)
#define PG8_SB(b, h) ((4 + (b) * 2 + (h)) * HTB)
#define PG8_GLDS(gp, lp) __builtin_amdgcn_global_load_lds((const unsigned*)(gp), (LAS unsigned*)(lp), 16, 0, 0)
#define PG8_STB(bufoff, gbase) do { PG8_GLDS(wsb + (size_t)((gbase) + voffB[0]), lds + (bufoff) + ldsw); PG8_GLDS(wsb + (size_t)((gbase) + voffB[1]), lds + (bufoff) + ldsw + 8192); } while (0)
#define PG8_STA(bufoff, gbase, v0, v1) do { PG8_GLDS(wsb + (size_t)((gbase) + (v0)), lds + (bufoff) + ldsw); PG8_GLDS(wsb + (size_t)((gbase) + (v1)), lds + (bufoff) + ldsw + 8192); } while (0)
#define PG8_LDA(dst, b, h) do { _Pragma("unroll") for (int m = 0; m < 4; ++m) _Pragma("unroll") for (int k = 0; k < 2; ++k) dst[m][k] = *(const LAS bf16x8*)(lds + PG8_SA(b, h) + aoff + m * 2048 + k * 1024); } while (0)
#define PG8_LDB(dst, b, h) do { _Pragma("unroll") for (int n = 0; n < 2; ++n) _Pragma("unroll") for (int k = 0; k < 2; ++k) dst[n][k] = *(const LAS bf16x8*)(lds + PG8_SB(b, h) + boff + n * 2048 + k * 1024); } while (0)
#define PG8_CAT(x) __builtin_bit_cast(i32x8, __builtin_shufflevector(__builtin_bit_cast(i32x4, x[0]), __builtin_bit_cast(i32x4, x[1]), 0, 1, 2, 3, 4, 5, 6, 7))
#define PG8_MMA(ai, bj, At, Bt) do { __builtin_amdgcn_s_setprio(1); _Pragma("unroll") for (int m = 0; m < 4; ++m) _Pragma("unroll") for (int n = 0; n < 2; ++n) { \
        if constexpr (FP8) mfma_fp8(acc[ai][bj][m][n], PG8_CAT(Bt[n]), PG8_CAT(At[m]), sc_w, sc_x); \
        else { _Pragma("unroll") for (int k = 0; k < 2; ++k) acc[ai][bj][m][n] = __builtin_amdgcn_mfma_f32_16x16x32_bf16(Bt[n][k], At[m][k], acc[ai][bj][m][n], 0, 0, 0); } } __builtin_amdgcn_s_setprio(0); } while (0)
#define PG8_WAIT_V(n) asm volatile("s_waitcnt vmcnt(" #n ")" ::: "memory")
#define PG8_WAIT_L(n) asm volatile("s_waitcnt lgkmcnt(" #n ")" ::: "memory")
#define PG8_BAR __builtin_amdgcn_s_barrier()
#define PG8_SCHED __builtin_amdgcn_sched_barrier(0)
    f32x4 acc[2][2][4][2];
#pragma unroll
    for (int a = 0; a < 2; ++a)
#pragma unroll
        for (int b = 0; b < 2; ++b)
#pragma unroll
            for (int m = 0; m < 4; ++m)
#pragma unroll
                for (int n = 0; n < 2; ++n) acc[a][b][m][n] = (f32x4){0.f, 0.f, 0.f, 0.f};
    bf16x8 At[4][2], B0[2][2], B1[2][2];
    const int sc_w = 122, sc_x = 127;
    unsigned cA = cur.A, cB = cur.B;
    unsigned c00 = cur.va00, c01 = cur.va01, c10 = cur.va10, c11 = cur.va11;
    PG8_STB(PG8_SB(0, 0), cB); PG8_STB(PG8_SB(0, 1), cB + hstep); PG8_STA(PG8_SA(0, 0), cA, c00, c01); PG8_STA(PG8_SA(0, 1), cA, c10, c11);
    if (wr == 1) PG8_BAR;
    PG8_WAIT_V(2); PG8_BAR;
    PG8_STB(PG8_SB(1, 0), cB + kstep); PG8_STA(PG8_SA(1, 0), cA + kstep, c00, c01); PG8_STB(PG8_SB(1, 1), cB + hstep + kstep);
    PG8_WAIT_V(6); PG8_BAR;
    for (;;) {
        const bool has_next = S.next(ui + 1, nxt, tid);
        const unsigned nA = has_next ? nxt.A : cA, nB = has_next ? nxt.B : cB;
        { u32x4 pv; pv.x = has_next ? nxt.va00 : c00; pv.y = has_next ? nxt.va01 : c01; pv.z = has_next ? nxt.va10 : c10; pv.w = has_next ? nxt.va11 : c11; *(LAS u32x4*)(lds + VA_PARK_OFF + tid * 16) = pv; }
        for (int t = 0; t < nt; t += 2) {
            const bool last = (t == nt - 2);
            const unsigned a1 = cA + (unsigned)(t + 1) * kstep;
            const unsigned a2 = last ? nA : cA + (unsigned)(t + 2) * kstep, b2 = last ? nB : cB + (unsigned)(t + 2) * kstep;
            const unsigned a3 = a2 + kstep, b3 = b2 + kstep;
            unsigned s00 = c00, s01 = c01, s10 = c10, s11 = c11;
            if (last) { const u32x4 pv = *(const LAS u32x4*)(lds + VA_PARK_OFF + tid * 16); s00 = pv.x; s01 = pv.y; s10 = pv.z; s11 = pv.w; }
            PG8_LDB(B0, 0, 0); PG8_LDB(B1, 0, 1); PG8_SCHED; PG8_LDA(At, 0, 0); PG8_STA(PG8_SA(1, 1), a1, c10, c11);
            PG8_WAIT_V(8); PG8_WAIT_L(0); PG8_BAR; PG8_MMA(0, 0, At, B0); PG8_MMA(0, 1, At, B1); PG8_BAR; PG8_SCHED;
            PG8_LDA(At, 0, 1); PG8_STB(PG8_SB(0, 0), b2); PG8_STB(PG8_SB(0, 1), b2 + hstep); PG8_STA(PG8_SA(0, 0), a2, s00, s01);
            PG8_WAIT_V(8); PG8_WAIT_L(0); PG8_BAR; PG8_MMA(1, 0, At, B0); PG8_MMA(1, 1, At, B1); PG8_BAR; PG8_SCHED;
            PG8_LDB(B0, 1, 0); PG8_LDB(B1, 1, 1); PG8_SCHED; PG8_LDA(At, 1, 0); PG8_STA(PG8_SA(0, 1), a2, s10, s11);
            PG8_WAIT_V(8); PG8_WAIT_L(0); PG8_BAR; PG8_MMA(0, 0, At, B0); PG8_MMA(0, 1, At, B1); PG8_BAR; PG8_SCHED;
            PG8_LDA(At, 1, 1); PG8_STB(PG8_SB(1, 0), b3); PG8_STB(PG8_SB(1, 1), b3 + hstep); PG8_STA(PG8_SA(1, 0), a3, s00, s01);
            PG8_WAIT_V(8); PG8_WAIT_L(0); PG8_BAR; PG8_MMA(1, 0, At, B0); PG8_MMA(1, 1, At, B1); PG8_BAR; PG8_SCHED;
        }
        if constexpr (ALIGN_EPI) { if (wr == 0) PG8_BAR; }
        if constexpr (FP8) asm volatile("s_nop 15\n\ts_nop 15\n\ts_nop 15" ::: "memory");
        E(acc, cur, wr, wc, fr, fq);
        if (!has_next) break;
#pragma unroll
        for (int a = 0; a < 2; ++a)
#pragma unroll
            for (int b = 0; b < 2; ++b)
#pragma unroll
                for (int m = 0; m < 4; ++m)
#pragma unroll
                    for (int n = 0; n < 2; ++n) acc[a][b][m][n] = (f32x4){0.f, 0.f, 0.f, 0.f};
        cur = nxt; cA = nA; cB = nB; { const u32x4 pv = *(const LAS u32x4*)(lds + VA_PARK_OFF + tid * 16); c00 = pv.x; c01 = pv.y; c10 = pv.z; c11 = pv.w; } ++ui;
        if constexpr (ALIGN_EPI) { if (wr == 1) PG8_BAR; }
    }
    PG8_WAIT_V(0);
    if constexpr (!ALIGN_EPI) { if (wr == 0) PG8_BAR; }
    PG8_BAR;
#undef PG8_SA
#undef PG8_SB
#undef PG8_GLDS
#undef PG8_STB
#undef PG8_STA
#undef PG8_LDA
#undef PG8_LDB
#undef PG8_MMA
#undef PG8_CAT
#undef PG8_WAIT_V
#undef PG8_WAIT_L
#undef PG8_BAR
#undef PG8_SCHED
}
}

#define XB_TMO      128
#define XB_XCNT(j)  (256  + 64 * (j))
#define XB_XSUB(j)  (1280 + 64 * (j))
#define XB_XGEN(j)  (2304 + 64 * (j))
#define XB_TOP      3328
#define XB_TOPGEN   3392
#define XCD_BAR_WORDS 3456
#define XB_SPIN_CAP (1u << 22)
__device__ __forceinline__ unsigned xb_ld(unsigned* p)              { return __hip_atomic_load(p, __ATOMIC_RELAXED, __HIP_MEMORY_SCOPE_AGENT); }
__device__ __forceinline__ unsigned xb_add(unsigned* p, unsigned v) { return __hip_atomic_fetch_add(p, v, __ATOMIC_RELAXED, __HIP_MEMORY_SCOPE_AGENT); }
__device__ __forceinline__ unsigned xb_xcc_id() { return (unsigned)__builtin_amdgcn_s_getreg((3 << 11) | 20) & 0xFu; }
#define XB_SPIN(cond, bar) do { unsigned _sp = 0; while (cond) { __builtin_amdgcn_s_sleep(1); \
    if ((++_sp & 255u) == 0u) { if (xb_ld(&(bar)[XB_TMO])) break; if (_sp > XB_SPIN_CAP) { atomicAdd(&(bar)[XB_TMO], 1u); break; } } } } while (0)
struct XcdBarrier { unsigned* bar; unsigned x; volatile LAS unsigned* st; };
__device__ __forceinline__ XcdBarrier xcd_barrier_post(unsigned* bar, volatile LAS unsigned* st) {
    XcdBarrier b; b.bar = bar; b.x = xb_xcc_id(); b.st = st;
    if (threadIdx.x == 0) (void)xb_add(&bar[XB_XCNT(b.x)], 1u);
    return b;
}
__device__ __forceinline__ void xcd_barrier_complete(unsigned* bar, unsigned x, unsigned& nloc, unsigned& nx) {
    const unsigned G = gridDim.x * gridDim.y * gridDim.z;
    unsigned sum, cnt, mine, sp = 0u;
    for (;;) {
        sum = 0u; cnt = 0u; mine = 0u;
#pragma unroll 1
        for (unsigned j = 0; j < 16; ++j) { const unsigned c = xb_ld(&bar[XB_XCNT(j)]); sum += c; cnt += (c > 0u) ? 1u : 0u; mine = (j == x) ? c : mine; }
        if (sum == G) break;
        __builtin_amdgcn_s_sleep(1);
        if ((++sp & 255u) == 0u) { if (xb_ld(&bar[XB_TMO])) break; if (sp > XB_SPIN_CAP) { atomicAdd(&bar[XB_TMO], 1u); break; } }
    }
    nloc = mine > 0u ? mine : 1u; nx = cnt > 0u ? cnt : 1u;
}
__device__ __forceinline__ void xcd_barrier(const XcdBarrier& b) {
    asm volatile("s_waitcnt vmcnt(0)" ::: "memory");
    __syncthreads();
    if (threadIdx.x == 0) {
        unsigned* bar = b.bar;
        __builtin_amdgcn_s_waitcnt(0);
        unsigned nloc = b.st[0], nx = b.st[1];
        if (nloc == 0u) { xcd_barrier_complete(bar, b.x, nloc, nx); b.st[0] = nloc; b.st[1] = nx; }
        const unsigned old = xb_add(&bar[XB_XSUB(b.x)], 1u);
        const unsigned gen = old / nloc;
        if (old + 1u == (gen + 1u) * nloc) {
            __builtin_amdgcn_fence(__ATOMIC_RELEASE, "agent");
            asm volatile("s_waitcnt vmcnt(0)" ::: "memory");
            const unsigned og = xb_add(&bar[XB_TOP], 1u);
            const unsigned tg = og / nx;
            if (og + 1u == (tg + 1u) * nx) xb_add(&bar[XB_TOPGEN], 1u);
            else XB_SPIN(xb_ld(&bar[XB_TOPGEN]) == tg, bar);
            __builtin_amdgcn_fence(__ATOMIC_ACQUIRE, "agent");
            xb_add(&bar[XB_XGEN(b.x)], 1u);
            asm volatile("s_waitcnt vmcnt(0)" ::: "memory");
        } else {
            XB_SPIN(xb_ld(&bar[XB_XGEN(b.x)]) == gen, bar);
            __builtin_amdgcn_fence(__ATOMIC_ACQUIRE, "agent");
            asm volatile("s_waitcnt vmcnt(0)" ::: "memory");
        }
    }
    __syncthreads();
}

struct Args { const float* in[31]; float* out; unsigned char* ws; int ph_lo, ph_hi, probe, pad; };

struct Frame {
    LAS unsigned char* lds;
    int tid, lane, wave, G, bid;
    unsigned char* ws;
};
constexpr int PTAB_OFF = MISC_OFF + 3072;
struct InTab { LAS unsigned char* lds;
    __device__ __forceinline__ const float* operator[](int k) const {
        const LAS unsigned* p = (const LAS unsigned*)(lds + PTAB_OFF) + 2 * k;
        const unsigned lo = __builtin_amdgcn_readfirstlane(p[0]), hi = __builtin_amdgcn_readfirstlane(p[1]);
        return (const float*)(((unsigned long long)hi << 32) | lo); } };
struct ArgsV { InTab in; };
__device__ __forceinline__ Frame make_frame(LAS unsigned char* lds, unsigned char* ws) {
    Frame F; F.lds = lds;
    int tid = threadIdx.x; asm volatile("" : "+v"(tid));
    F.tid = tid; F.lane = tid & 63; F.wave = __builtin_amdgcn_readfirstlane(tid >> 6);
    F.G = gridDim.x; F.bid = blockIdx.x;
    unsigned long long w = (unsigned long long)ws; asm volatile("" : "+s"(w)); F.ws = (unsigned char*)w;
    return F;
}

__device__ __forceinline__ void transpose_item(const float* W, int N, bf16_t* WT, int k0, int n0, int drow0, LAS float* scr, int lane) {
    f32x4 v[16];
    const int lr = lane >> 4, lc = (lane & 15) * 4;
#pragma unroll
    for (int i = 0; i < 16; ++i) v[i] = __builtin_nontemporal_load((const f32x4*)(W + (size_t)(k0 + 4 * i + lr) * N + n0 + lc));
#pragma unroll
    for (int i = 0; i < 16; ++i) { LAS float* s = scr + (4 * i + lr) * 65 + lc; s[0] = v[i].x; s[1] = v[i].y; s[2] = v[i].z; s[3] = v[i].w; }
    LDS_WAIT(); asm volatile("" ::: "memory");
    const int c = lane & 7;
#pragma unroll
    for (int j = 0; j < 8; ++j) { const int n = (lane >> 3) + 8 * j; const LAS float* s = scr + (8 * c) * 65 + n;
        u32x4 o; o.x = pk2(s[0 * 65], s[1 * 65]); o.y = pk2(s[2 * 65], s[3 * 65]); o.z = pk2(s[4 * 65], s[5 * 65]); o.w = pk2(s[6 * 65], s[7 * 65]);
        *(u32x4*)(WT + (size_t)(drow0 + n) * KD + k0 + 8 * c) = o; }
    LDS_WAIT(); asm volatile("" ::: "memory");
}
__device__ __forceinline__ void transpose_item_fp8(const float* W, int N, unsigned char* WT, int k0, int n0, int drow0, LAS float* scr, int lane) {
    f32x4 v[16];
    const int lr = lane >> 3, lc = (lane & 7) * 4;
#pragma unroll
    for (int i = 0; i < 16; ++i) v[i] = __builtin_nontemporal_load((const f32x4*)(W + (size_t)(k0 + 8 * i + lr) * N + n0 + lc));
#pragma unroll
    for (int i = 0; i < 16; ++i) { LAS float* s = scr + (8 * i + lr) * 33 + lc; s[0] = v[i].x; s[1] = v[i].y; s[2] = v[i].z; s[3] = v[i].w; }
    LDS_WAIT(); asm volatile("" ::: "memory");
#pragma unroll
    for (int j = 0; j < 4; ++j) { const int id = lane + 64 * j, n = id >> 3, kc = id & 7; const LAS float* s = scr + (16 * kc) * 33 + n;
        int o[4];
#pragma unroll
        for (int q = 0; q < 4; ++q) { int w8 = 0;
            w8 = __builtin_amdgcn_cvt_pk_fp8_f32(32.f * s[(4 * q + 0) * 33], 32.f * s[(4 * q + 1) * 33], w8, false);
            w8 = __builtin_amdgcn_cvt_pk_fp8_f32(32.f * s[(4 * q + 2) * 33], 32.f * s[(4 * q + 3) * 33], w8, true); o[q] = w8; }
        u32x4 ov; ov.x = (unsigned)o[0]; ov.y = (unsigned)o[1]; ov.z = (unsigned)o[2]; ov.w = (unsigned)o[3];
        *(u32x4*)(WT + (size_t)(drow0 + n) * KD + k0 + 16 * kc) = ov; }
    LDS_WAIT(); asm volatile("" ::: "memory");
}
__device__ __forceinline__ void ln_store(f32x4 (&v)[4], const float* g, const float* b, float* of32, bf16_t* obf, int lane, unsigned char* of8 = nullptr) {
    float s = 0.f;
#pragma unroll
    for (int j = 0; j < 4; ++j) s += (v[j].x + v[j].y) + (v[j].z + v[j].w);
    const float mean = wave_sum(s, lane << 2) * (1.f / D); float s2 = 0.f;
#pragma unroll
    for (int j = 0; j < 4; ++j) { v[j] = v[j] - mean; s2 += (v[j].x * v[j].x + v[j].y * v[j].y) + (v[j].z * v[j].z + v[j].w * v[j].w); }
    const float rstd = __builtin_amdgcn_rsqf(wave_sum(s2, lane << 2) * (1.f / D) + LN_EPS);
#pragma unroll
    for (int j = 0; j < 4; ++j) {
        const f32x4 gv = *(const f32x4*)(g + 4 * lane + 256 * j), bv = *(const f32x4*)(b + 4 * lane + 256 * j);
        const f32x4 o = v[j] * rstd * gv + bv;
        if (of32) *(f32x4*)(of32 + 4 * lane + 256 * j) = o;
        if (obf) { u32x2 w; w.x = pk2(o.x, o.y); w.y = pk2(o.z, o.w); *(u32x2*)(obf + 4 * lane + 256 * j) = w; }
        if (of8) { int w8 = 0; w8 = __builtin_amdgcn_cvt_pk_fp8_f32(o.x, o.y, w8, false); w8 = __builtin_amdgcn_cvt_pk_fp8_f32(o.z, o.w, w8, true); *(int*)(of8 + 4 * lane + 256 * j) = w8; }
    }
}

__device__ __forceinline__ void phase_prologue(Frame& F, const ArgsV& A_) {
    LAS float* scr = (LAS float*)(F.lds + F.wave * 16896);
    const int gw = F.bid * NWAVES + F.wave, NGW = F.G * NWAVES;
    bf16_t* WINT = (bf16_t*)(F.ws + WS_WINT); bf16_t* WOUTT = (bf16_t*)(F.ws + WS_WOUTT); unsigned char* W1T = (unsigned char*)(F.ws + WS_W1T); unsigned char* W2T = (unsigned char*)(F.ws + WS_W2T);
    constexpr int I_IN = NL * 16 * 40, I_OUT = NL * 16 * 16, I_W1 = NL * NE * 8 * 64, I_W2 = NL * NE * 8 * 32;
    const float* w_in = A_.in[3]; const float* w_out = A_.in[20]; const float* w1 = A_.in[25]; const float* w2 = A_.in[27];
    for (int it = gw; it < I_IN + I_OUT + I_W1 + I_W2; it += NGW) {
        int r = it;
        if (r < I_W1) { const int le = r / (8 * 64), q = r % (8 * 64), kb = q / 64, nb = q % 64, n0 = nb * 32;
            const int drow = (n0 < 1024) ? ((n0 >> 7) * 256 + (n0 & 127)) : (((n0 - 1024) >> 7) * 256 + 128 + ((n0 - 1024) & 127));
            transpose_item_fp8(w1 + (size_t)le * 1024 * 2048, 2048, W1T + (size_t)le * 2048 * 1024, kb * 128, n0, drow, scr, F.lane); continue; }
        r -= I_W1;
        if (r < I_W2) { const int le = r / (8 * 32), q = r % (8 * 32), kb = q / 32, nb = q % 32;
            transpose_item_fp8(w2 + (size_t)le * 1024 * 1024, 1024, W2T + (size_t)le * 1024 * 1024, kb * 128, nb * 32, nb * 32, scr, F.lane); continue; }
        r -= I_W2;
        if (r < I_IN) { const int l = r / (16 * 40), q = r % (16 * 40), kb = q / 40, nb = q % 40, n0 = nb * 64;
            const int drow = (n0 < 1024) ? n0 : ((n0 < 1536) ? (2048 + n0 - 1024) : (n0 - 512));
            transpose_item(w_in + (size_t)l * 1024 * 2560, 2560, WINT + (size_t)l * 2560 * 1024, kb * 64, n0, drow, scr, F.lane); continue; }
        r -= I_IN;
        { const int l = r / (16 * 16), q = r % (16 * 16), kb = q / 16, nb = q % 16;
            transpose_item(w_out + (size_t)l * 1024 * 1024, 1024, WOUTT + (size_t)l * 1024 * 1024, kb * 64, nb * 64, nb * 64, scr, F.lane); }
    }
    float* HA = (float*)(F.ws + WS_HA); bf16_t* XB = (bf16_t*)(F.ws + WS_XB);
    for (int m = gw; m < T; m += NGW) {
        f32x4 v[4];
#pragma unroll
        for (int j = 0; j < 4; ++j) v[j] = *(const f32x4*)(A_.in[0] + (size_t)m * D + 4 * F.lane + 256 * j);
        ln_store(v, A_.in[1], A_.in[2], HA + (size_t)m * D, XB + (size_t)m * D, F.lane);
    }
}

constexpr int P2_KP = VA_PARK_OFF;
constexpr int P2_ORD = MISC_OFF + 1024;
constexpr int P2_FLG = MISC_OFF + 2304;
constexpr int CW_QUEUE = 20480;
constexpr size_t WS_KN = 768 * MiB + 512 * 1024;


constexpr int SEGT = 32, N_UNSPLIT = 400, N_SPLIT = 560, N_ITEMS = N_UNSPLIT + N_SPLIT;
struct ItemTabs { unsigned short item[1024]; unsigned short order[1024]; unsigned short segstart[128]; };
constexpr int west_of(int h) { return h == 0 ? 6 : (h == 1 ? 14 : (h == 2 ? 46 : 1000)); }
constexpr ItemTabs make_item_tabs() {
    ItemTabs t{}; int cost[1024] = {};
    for (int i = 0; i < 1024; ++i) { t.item[i] = 0; t.order[i] = 0; }
    for (int i = 0; i < 384; ++i) { const int h = i >> 7, qb = i & 127; t.item[i] = (unsigned short)(h | (qb << 2)); const int c = 2 * qb + 2; cost[i] = c < west_of(h) ? c : west_of(h); }
    for (int i = 384; i < 400; ++i) { const int qb = i - 384; t.item[i] = (unsigned short)(3 | (qb << 2)); cost[i] = 2 * qb + 2; }
    int n = 400;
    for (int qb = 0; qb < 128; ++qb) { t.segstart[qb] = (unsigned short)(n - 400);
        if (qb >= 16) { const int ns = (qb + 16) >> 4; for (int s = 0; s < ns; ++s) { t.item[n] = (unsigned short)(3 | (qb << 2) | (s << 9) | 0x8000); const int rem = 2 * qb + 2 - SEGT * s; cost[n] = rem < SEGT ? rem : SEGT; ++n; } } }
    int k = 0;
    for (int c = 64; c >= 1; --c) for (int i = 0; i < n; ++i) if (cost[i] == c) t.order[k++] = (unsigned short)i;
    return t;
}
__device__ const ItemTabs g_tabs = make_item_tabs();
constexpr size_t WS_PART = WS_END;
constexpr size_t PART_WAVE = 16896, PART_SLOT = 8 * PART_WAVE;
constexpr size_t WS_XB8 = ((WS_PART + (size_t)N_SPLIT * PART_SLOT + MiB) / MiB) * MiB;
constexpr size_t WS_END2 = WS_XB8 + 17 * MiB;

namespace attn {
__device__ __forceinline__ int crow(int r, int hi) { return (r & 3) + 8 * (r >> 2) + 4 * hi; }
__device__ __forceinline__ int swz(int row, int chunk) { return row * 128 + ((chunk ^ ((row >> 1) & 7)) << 4); }
#define MFMA32(a, b, c) __builtin_amdgcn_mfma_f32_32x32x16_bf16(a, b, c, 0, 0, 0)

__device__ __forceinline__ void attn_finish(LAS unsigned char* lds, f32x16 (&O)[4], float lsum, bf16_t* MIX, const float* subg, float lam, float outscale, int h, int rowmin, int c, int rg, int lane) {
    const int ln = lane & 31, hi = lane >> 5;
    const float ltot = lsum + shx(lsum, lane << 2, 32);
    LAS float* ex = (LAS float*)lds;
    if (c == 1) {
        const float sc = lam / ltot;
#pragma unroll
        for (int db = 0; db < 4; ++db)
#pragma unroll
            for (int r = 0; r < 16; ++r) ex[(rg * 64 + db * 16 + r) * 64 + lane] = O[db][r] * sc;
    }
    __syncthreads();
    if (c == 0) {
        const float inv = 1.0f / ltot; float ss = 0.f;
#pragma unroll
        for (int db = 0; db < 4; ++db)
#pragma unroll
            for (int r = 0; r < 16; ++r) { const float o = O[db][r] * inv - ex[(rg * 64 + db * 16 + r) * 64 + lane]; O[db][r] = o; ss += o * o; }
        ss += shx(ss, lane << 2, 32);
        const float rn = __builtin_amdgcn_rsqf(ss * (1.0f / 128.0f) + LN_EPS) * outscale;
        bf16_t* op = MIX + (size_t)(rowmin + ln) * 1024 + h * 128 + 4 * hi;
#pragma unroll
        for (int db = 0; db < 4; ++db)
#pragma unroll
            for (int g = 0; g < 4; ++g) { const int dv0 = 32 * db + 8 * g;
                const f32x4 gv = *(const f32x4*)(subg + dv0 + 4 * hi);
                u32x2 wv; wv.x = cvt_pk_bf16(O[db][4 * g + 0] * rn * gv.x, O[db][4 * g + 1] * rn * gv.y); wv.y = cvt_pk_bf16(O[db][4 * g + 2] * rn * gv.z, O[db][4 * g + 3] * rn * gv.w);
                *(u32x2*)(op + dv0) = wv; }
    }
    __syncthreads();
}
__device__ __forceinline__ void attn_unit(LAS unsigned char* lds, const unsigned char* wsb, bf16_t* MIX, const float* subg, float lam, float outscale, int h, int qb, int jt_top, int jt_bot, float* part, const int tid) {
    const int w = __builtin_amdgcn_readfirstlane(tid >> 6), lane = tid & 63, ln = lane & 31, hi = lane >> 5;
    const int c = w >> 2, rg = w & 3;
    const int i0 = qb * 128, rowmin = i0 + 32 * rg;
    const float slope2 = __builtin_amdgcn_exp2f(-2.0f * (float)(h + 1)) * LOG2E;
    const LAS float* kp = (const LAS float*)(lds + P2_KP) + (h * 2 + c) * 256;
    volatile LAS unsigned* flg = (volatile LAS unsigned*)(lds + P2_FLG);
    const bf16_t* U = (const bf16_t*)(wsb + WS_U);
    bf16x8 Qf[4];
    { const bf16_t* qp = U + (size_t)(rowmin + ln) * NCOLA + UQ + h * 128 + c * 64 + 8 * hi;
#pragma unroll
      for (int ks = 0; ks < 4; ++ks) Qf[ks] = *(const bf16x8*)(qp + 16 * ks); }
    float qn;
    { float ss = 0.f;
#pragma unroll
      for (int ks = 0; ks < 4; ++ks)
#pragma unroll
          for (int j = 0; j < 8; ++j) { const float v = bf2f((bf16_t)Qf[ks][j]); ss += v * v; }
      ss += shx(ss, lane << 2, 32); qn = fsqrt(ss) * 1.001f; }
    float mlb;
    { const bf16_t* kd = U + (size_t)(rowmin + ln) * NCOLA + UK + h * 128 + c * 64 + 8 * hi; float dd = 0.f;
#pragma unroll
        for (int ks = 0; ks < 4; ++ks) { const bf16x8 kv = *(const bf16x8*)(kd + 16 * ks);
#pragma unroll
            for (int j = 0; j < 8; ++j) dd += bf2f((bf16_t)Qf[ks][j]) * bf2f((bf16_t)kv[j]); }
        dd += shx(dd, lane << 2, 32); mlb = dd + slope2 * (float)(rowmin + ln - i0) - 0.01f; }
    unsigned kso0, kso1, vso0, vso1;
    { const int r8 = lane >> 3, cp = lane & 7;
      { const int key = 8 * ((2 * w) & 7) + r8, ch = cp ^ ((key >> 1) & 7); kso0 = (unsigned)WS_U + (unsigned)(key * NCOLA + UK + h * 128 + c * 64 + ch * 8) * 2u; }
      { const int key = 8 * ((2 * w + 1) & 7) + r8, ch = cp ^ ((key >> 1) & 7); kso1 = (unsigned)WS_U + (unsigned)(key * NCOLA + UK + h * 128 + c * 64 + ch * 8) * 2u; }
      { const int dv = 8 * (2 * w) + r8, ch = cp ^ ((dv >> 1) & 7); vso0 = (unsigned)WS_VT + (unsigned)((h * 128 + dv) * T + ch * 8) * 2u; }
      { const int dv = 8 * (2 * w + 1) + r8, ch = cp ^ ((dv >> 1) & 7); vso1 = (unsigned)WS_VT + (unsigned)((h * 128 + dv) * T + ch * 8) * 2u; } }
    int o4[4];
#pragma unroll
    for (int j = 0; j < 4; ++j) o4[j] = ln * 128 + (((2 * j + hi) ^ ((ln >> 1) & 7)) << 4);
    bf16x8 KA0, KA1;
    { u32x4 a0 = (u32x4){0u, 0u, 0u, 0u}, a1 = a0;
      if (hi == 0) { const float b0f = slope2 * (float)ln, b1f = slope2 * (float)(ln + 32);
          const unsigned h0 = cvt_pk_bf16(b0f, 0.f) & 0xffffu, h1 = cvt_pk_bf16(b1f, 0.f) & 0xffffu;
          a0.x = cvt_pk_bf16(b0f, b0f - bflo(h0)); a0.y = 0x3F803F80u; a1.x = cvt_pk_bf16(b1f, b1f - bflo(h1)); a1.y = 0x3F803F80u; }
      KA0 = __builtin_bit_cast(bf16x8, a0); KA1 = __builtin_bit_cast(bf16x8, a1); }
    f32x16 O[4];
#pragma unroll
    for (int db = 0; db < 4; ++db)
#pragma unroll
        for (int r = 0; r < 16; ++r) O[db][r] = 0.f;
    float m = mlb, lsum = 0.f, al_pend = 1.0f;
    const int jt_hi = jt_top;
#define AB(t) (((jt_hi - (t)) & 3) * 32768)
#define A_GLDS(gp, lp) __builtin_amdgcn_global_load_lds((const unsigned*)(gp), (LAS unsigned*)(lp), 16, 0, 0)
#define A_GL(t) do { const unsigned kb_ = (unsigned)(t) * (unsigned)(64 * NCOLA * 2), vb_ = (unsigned)(t) * 128u; LAS unsigned char* d_ = lds + AB(t) + w * 2048; \
        A_GLDS(wsb + (size_t)(kso0 + kb_), d_); A_GLDS(wsb + (size_t)(kso1 + kb_), d_ + 1024); A_GLDS(wsb + (size_t)(vso0 + vb_), d_ + 16384); A_GLDS(wsb + (size_t)(vso1 + vb_), d_ + 16384 + 1024); } while (0)
#define A_BAR() do { asm volatile("s_waitcnt lgkmcnt(0)" ::: "memory"); __builtin_amdgcn_s_barrier(); asm volatile("" ::: "memory"); } while (0)
#define SB0 __builtin_amdgcn_sched_barrier(0)
#define A_VLD(dst, b_, db) do { _Pragma("unroll") for (int g = 0; g < 4; ++g) dst[g] = *(const LAS bf16x8*)((b_) + o4[g] + (db) * 4096); } while (0)
#define A_VMM(srcf, db) do { _Pragma("unroll") for (int g = 0; g < 4; ++g) O[db] = MFMA32(srcf[g], Pf[g], O[db]); } while (0)
#define A_QA(t) bf16x8 QA_; { float sl_ = slope2; asm volatile("" : "+v"(sl_)); const float c_ = __builtin_fmaf(sl_, (float)((t) * 64 - i0), -m); \
        const unsigned ch_ = cvt_pk_bf16(c_, 0.f) & 0xffffu; u32x4 q_ = (u32x4){0u, 0u, 0u, 0u}; \
        if (hi == 0) { q_.x = 0x3F803F80u; q_.y = cvt_pk_bf16(c_, c_ - bflo(ch_)); } QA_ = __builtin_bit_cast(bf16x8, q_); }
#define A_QKMM() do { f32x16 z_; _Pragma("unroll") for (int r = 0; r < 16; ++r) z_[r] = 0.f; s0 = MFMA32(KA0, QA_, z_); s1 = MFMA32(KA1, QA_, z_); \
        _Pragma("unroll") for (int ks = 0; ks < 4; ++ks) { s0 = MFMA32(FA[ks], Qf[ks], s0); s1 = MFMA32(FB[ks], Qf[ks], s1); } } while (0)
#define A_MASK(t) do { const int j0_ = (t) * 64; if (j0_ + 63 > rowmin) { int lz_ = lane; asm volatile("" : "+v"(lz_)); const int qrow_ = rowmin + (lz_ & 31), hz_ = lz_ >> 5; \
            _Pragma("unroll") for (int r = 0; r < 16; ++r) { const int key_ = j0_ + crow(r, hz_); if (key_ > qrow_) s0[r] = -30000.0f; if (key_ + 32 > qrow_) s1[r] = -30000.0f; } } } while (0)
#define A_SM_MAX() float mx_ = vmax3(s0[0], s1[0], s0[1]), my_ = vmax3(s1[1], s0[2], s1[2]); \
        _Pragma("unroll") for (int r = 3; r < 15; r += 2) { mx_ = vmax3(mx_, s0[r], s1[r]); my_ = vmax3(my_, s0[r + 1], s1[r + 1]); } \
        mx_ = vmax3(mx_, s0[15], s1[15]); mx_ = vmax3(mx_, my_, mx_); \
        mx_ = vmax3(mx_, shx(mx_, lane << 2, 32), mx_);
#define A_THR 6.0f
#define A_SM_NEWMAX() float al_ = 1.0f; if (__any(mx_ > A_THR)) { const float d_ = vmax3(mx_, 0.f, 0.f); al_ = __builtin_amdgcn_exp2f(-d_); m += d_; \
            _Pragma("unroll") for (int r = 0; r < 16; ++r) { s0[r] -= d_; s1[r] -= d_; } } al_pend = al_;
#define A_SM_EXP(sv) _Pragma("unroll") for (int r = 0; r < 16; ++r) sv[r] = __builtin_amdgcn_exp2f(sv[r]);
#define A_SM_FIN() float ps_ = vadd(s0[0], s1[0]), pt_ = vadd(s0[1], s1[1]); \
        _Pragma("unroll") for (int r = 2; r < 16; r += 2) { ps_ = vadd(ps_, s0[r]); pt_ = vadd(pt_, s0[r + 1]); ps_ = vadd(ps_, s1[r]); pt_ = vadd(pt_, s1[r + 1]); } \
        lsum = __builtin_fmaf(lsum, al_, vadd(ps_, pt_)); \
        _Pragma("unroll") for (int s2 = 0; s2 < 2; ++s2) { u32x4 a_, b2_; \
            a_.x = cvt_pk_bf16(s0[8 * s2 + 0], s0[8 * s2 + 1]); a_.y = cvt_pk_bf16(s0[8 * s2 + 2], s0[8 * s2 + 3]); a_.z = cvt_pk_bf16(s0[8 * s2 + 4], s0[8 * s2 + 5]); a_.w = cvt_pk_bf16(s0[8 * s2 + 6], s0[8 * s2 + 7]); \
            b2_.x = cvt_pk_bf16(s1[8 * s2 + 0], s1[8 * s2 + 1]); b2_.y = cvt_pk_bf16(s1[8 * s2 + 2], s1[8 * s2 + 3]); b2_.z = cvt_pk_bf16(s1[8 * s2 + 4], s1[8 * s2 + 5]); b2_.w = cvt_pk_bf16(s1[8 * s2 + 6], s1[8 * s2 + 7]); \
            Pf[s2] = __builtin_bit_cast(bf16x8, a_); Pf[2 + s2] = __builtin_bit_cast(bf16x8, b2_); }
#define A_FUSED(t) do { const LAS unsigned char* kb3_ = lds + AB((t) - 1) + c * 8192; const LAS unsigned char* vb2_ = lds + AB(t) + 16384; \
        A_QA((t) - 1); A_VLD(FA, kb3_, 0); A_VLD(FB, kb3_, 1); SB0; \
        A_QKMM(); \
        A_VLD(FA, vb2_, 0); A_VLD(FB, vb2_, 1); SB0; \
        A_VMM(FA, 0); A_MASK((t) - 1); A_SM_MAX(); A_VLD(FA, vb2_, 2); SB0; \
        A_VMM(FB, 1); A_SM_NEWMAX(); A_SM_EXP(s0); A_VLD(FB, vb2_, 3); SB0; \
        A_VMM(FA, 2); A_SM_EXP(s1); SB0; \
        A_VMM(FB, 3); A_SM_FIN(); SB0; } while (0)
    A_GL(jt_hi); A_GL(jt_hi - 1);
    if (jt_hi - 2 >= jt_bot) { A_GL(jt_hi - 2); asm volatile("s_waitcnt vmcnt(4)" ::: "memory"); } else asm volatile("s_waitcnt vmcnt(0)" ::: "memory");
    A_BAR();
    bool skip = false;
    bf16x8 Pf[4], FA[4], FB[4];
    f32x16 s0, s1;
    {
        const LAS unsigned char* kb3_ = lds + AB(jt_hi) + c * 8192;
        A_QA(jt_hi); A_VLD(FA, kb3_, 0); A_VLD(FB, kb3_, 1);
        A_QKMM();
        A_MASK(jt_hi); A_SM_MAX(); A_SM_NEWMAX(); A_SM_EXP(s0); A_SM_EXP(s1); A_SM_FIN();
    }
    int jt = jt_hi;
    for (; jt > jt_bot; --jt) {
        const int cur = (jt_hi - jt) & 1;
        if (jt - 3 >= jt_bot) A_GL(jt - 3);
        bool done = false;
        if (!skip) {
            if (__any(al_pend != 1.0f)) {
#pragma unroll
                for (int db = 0; db < 4; ++db)
#pragma unroll
                    for (int r = 0; r < 16; ++r) O[db][r] *= al_pend;
            }
            al_pend = 1.0f;
            const float bnd = qn * kp[jt - 1] - m + slope2 * (float)((jt - 1) * 64 + 63 - i0);
            done = __all(bnd < -48.0f);
            A_FUSED(jt);
        }
        skip = skip || done;
        if (lane == 0) flg[cur * 8 + w] = skip ? 1u : 0u;
        if (jt - 3 >= jt_bot) asm volatile("s_waitcnt vmcnt(4)" ::: "memory"); else asm volatile("s_waitcnt vmcnt(0)" ::: "memory");
        A_BAR();
        { const u32x4 f0 = *(const LAS u32x4*)(lds + P2_FLG + cur * 32), f1 = *(const LAS u32x4*)(lds + P2_FLG + cur * 32 + 16);
          if ((f0.x & f0.y & f0.z & f0.w & f1.x & f1.y & f1.z & f1.w) != 0u) break; }
    }
    if (!skip) {
        if (__any(al_pend != 1.0f)) {
#pragma unroll
            for (int db = 0; db < 4; ++db)
#pragma unroll
                for (int r = 0; r < 16; ++r) O[db][r] *= al_pend;
        }
        const LAS unsigned char* vb2_ = lds + AB(jt_bot) + 16384;
        A_VLD(FA, vb2_, 0); A_VLD(FB, vb2_, 1); A_VMM(FA, 0); A_VLD(FA, vb2_, 2); A_VMM(FB, 1); A_VLD(FB, vb2_, 3); A_VMM(FA, 2); A_VMM(FB, 3);
    }
    asm volatile("s_waitcnt vmcnt(0)" ::: "memory");
    A_BAR();
#undef AB
#undef A_GLDS
#undef A_GL
#undef A_BAR
#undef SB0
#undef A_VLD
#undef A_VMM
#undef A_QA
#undef A_QKMM
#undef A_THR
#undef A_MASK
#undef A_SM_MAX
#undef A_SM_NEWMAX
#undef A_SM_EXP
#undef A_SM_FIN
#undef A_FUSED
    if (part) {
        float* pw = part + (size_t)w * (PART_WAVE / 4);
#pragma unroll
        for (int db = 0; db < 4; ++db)
#pragma unroll
            for (int r = 0; r < 16; ++r) pw[(db * 16 + r) * 64 + lane] = O[db][r];
        pw[4096 + lane] = m; pw[4160 + lane] = lsum;
    } else attn_finish(lds, O, lsum, MIX, subg, lam, outscale, h, rowmin, c, rg, lane);
}
__device__ __forceinline__ void attn_combine(LAS unsigned char* lds, const unsigned char* wsb, bf16_t* MIX, const float* subg, float lam, float outscale, int qb, const int tid) {
    const int w = __builtin_amdgcn_readfirstlane(tid >> 6), lane = tid & 63, c = w >> 2, rg = w & 3;
    const int nseg = (qb + 16) >> 4, slot0 = g_tabs.segstart[qb];
    const float* pb = (const float*)(wsb + WS_PART) + (size_t)slot0 * (PART_SLOT / 4) + (size_t)w * (PART_WAVE / 4);
    float M = -__builtin_inff();
    for (int s = 0; s < nseg; ++s) M = fmaxf(M, pb[(size_t)s * (PART_SLOT / 4) + 4096 + lane]);
    f32x16 O[4];
#pragma unroll
    for (int db = 0; db < 4; ++db)
#pragma unroll
        for (int r = 0; r < 16; ++r) O[db][r] = 0.f;
    float lsum = 0.f;
    for (int s = 0; s < nseg; ++s) { const float* ps = pb + (size_t)s * (PART_SLOT / 4);
        const float sc = __builtin_amdgcn_exp2f(ps[4096 + lane] - M); lsum += sc * ps[4160 + lane];
#pragma unroll
        for (int db = 0; db < 4; ++db)
#pragma unroll
            for (int r = 0; r < 16; ++r) O[db][r] += sc * ps[(db * 16 + r) * 64 + lane]; }
    attn_finish(lds, O, lsum, MIX, subg, lam, outscale, 3, qb * 128 + 32 * rg, c, rg, lane);
}
#undef MFMA32
}

__device__ __forceinline__ void phase_knorm(Frame& F) {
    const bf16_t* U = (const bf16_t*)(F.ws + WS_U); float* KN = (float*)(F.ws + WS_KN);
    const int gw = F.bid * NWAVES + F.wave, NGW = F.G * NWAVES;
    for (int item = gw; item < 2048; item += NGW) {
        const int hc = item >> 8, jt = item & 255;
        const bf16_t* kr = U + (size_t)(jt * 64 + F.lane) * NCOLA + UK + hc * 64;
        float ss = 0.f;
#pragma unroll
        for (int q = 0; q < 8; ++q) { const u32x4 v = *(const u32x4*)(kr + 8 * q);
            ss += bflo(v.x) * bflo(v.x) + bfhi(v.x) * bfhi(v.x) + bflo(v.y) * bflo(v.y) + bfhi(v.y) * bfhi(v.y) + bflo(v.z) * bflo(v.z) + bfhi(v.z) * bfhi(v.z) + bflo(v.w) * bflo(v.w) + bfhi(v.w) * bfhi(v.w); }
#pragma unroll
        for (int o = 1; o < 64; o <<= 1) ss = fmaxf(ss, shx(ss, F.lane << 2, o));
        if (F.lane == 0) KN[item] = ss;
    }
}

__device__ __forceinline__ void lru_unit(Frame& F, const ArgsV& A_, int l, int unit) {
    const bf16_t* U = (const bf16_t*)(F.ws + WS_U);
    float* HLOC = (float*)(F.ws + WS_HLOC); float* CUMA = (float*)(F.ws + WS_CUMA); float* AGG = (float*)(F.ws + WS_AGG);
    const float* cw = A_.in[9] + l * 4 * 256; const float* cb = A_.in[10] + l * 256;
    const float* wa = A_.in[11] + l * 4 * 4096; const float* ba = A_.in[12] + l * 256;
    const float* wx = A_.in[13] + l * 4 * 4096; const float* bx = A_.in[14] + l * 256; const float* lamp = A_.in[15] + l * 256;
    LAS float* wA = (LAS float*)F.lds; LAS float* wX = wA + 4096; LAS float* xc = wA + 8192; LAS float* wagg = wA + 8192 + 16384;
    const int w = F.wave, d = F.lane;
    const int chunk = unit >> 2, blk = unit & 3, t0 = chunk * 256, ch0 = blk * 64;
    for (int i = F.tid; i < 1024; i += NTHREADS) { *(LAS f32x4*)(wA + 4 * i) = *(const f32x4*)(wa + blk * 4096 + 4 * i); *(LAS f32x4*)(wX + 4 * i) = *(const f32x4*)(wx + blk * 4096 + 4 * i); }
    {
      const int g8 = F.tid & 7, chb = ch0 + 8 * g8;
      f32x4 wv[4][2], bv[2];
#pragma unroll
      for (int j = 0; j < 4; ++j) { wv[j][0] = *(const f32x4*)(cw + j * 256 + chb); wv[j][1] = *(const f32x4*)(cw + j * 256 + chb + 4); }
      bv[0] = *(const f32x4*)(cb + chb); bv[1] = *(const f32x4*)(cb + chb + 4);
#pragma unroll
      for (int k = 0; k < 4; ++k) { const int t = (F.tid >> 3) + 64 * k, tt = t0 + t;
          f32x4 a0 = bv[0], a1 = bv[1];
#pragma unroll
          for (int j = 0; j < 4; ++j) { const int ts = tt - 3 + j;
              if (ts >= 0) { const u32x4 x = *(const u32x4*)(U + (size_t)ts * NCOLA + ULX + chb);
                  a0.x += wv[j][0].x * bflo(x.x); a0.y += wv[j][0].y * bfhi(x.x); a0.z += wv[j][0].z * bflo(x.y); a0.w += wv[j][0].w * bfhi(x.y);
                  a1.x += wv[j][1].x * bflo(x.z); a1.y += wv[j][1].y * bfhi(x.z); a1.z += wv[j][1].z * bflo(x.w); a1.w += wv[j][1].w * bfhi(x.w); } }
          *(LAS f32x4*)(xc + t * 64 + 8 * g8) = a0; *(LAS f32x4*)(xc + t * 64 + 8 * g8 + 4) = a1; } }
    __syncthreads();
    float ga[32], gx[32];
#pragma unroll
    for (int tt = 0; tt < 32; ++tt) { ga[tt] = 0.f; gx[tt] = 0.f; }
    for (int c4 = 0; c4 < 16; ++c4) {
        const float wa0 = wA[(4 * c4 + 0) * 64 + d], wa1 = wA[(4 * c4 + 1) * 64 + d], wa2 = wA[(4 * c4 + 2) * 64 + d], wa3 = wA[(4 * c4 + 3) * 64 + d];
        const float wx0 = wX[(4 * c4 + 0) * 64 + d], wx1 = wX[(4 * c4 + 1) * 64 + d], wx2 = wX[(4 * c4 + 2) * 64 + d], wx3 = wX[(4 * c4 + 3) * 64 + d];
#pragma unroll
        for (int tt = 0; tt < 32; ++tt) { const f32x4 x = *(const LAS f32x4*)(xc + (32 * w + tt) * 64 + 4 * c4);
            ga[tt] += x.x * wa0 + x.y * wa1 + x.z * wa2 + x.w * wa3; gx[tt] += x.x * wx0 + x.y * wx1 + x.z * wx2 + x.w * wx3; } }
    const int ch = ch0 + d; const float bav = ba[ch], bxv = bx[ch];
    const float sp = flog(1.0f + fexp(-lamp[ch]));
    float hl = 0.f, ca = 1.f;
#pragma unroll
    for (int tt = 0; tt < 32; ++tt) {
        const float sa = sigmoidf_(ga[tt] + bav), sx = sigmoidf_(gx[tt] + bxv);
        const float log_a = -8.0f * sa * sp, a = fexp(log_a), mult = fsqrt(fmaxf(1.0f - a * a, 0.f));
        const float b = mult * sx * xc[(32 * w + tt) * 64 + d];
        hl = a * hl + b; ca *= a; ga[tt] = hl; gx[tt] = ca;
    }
    wagg[(w * 2 + 0) * 64 + d] = ca; wagg[(w * 2 + 1) * 64 + d] = hl;
    __syncthreads();
    float cin = 0.f, cprod = 1.f;
    for (int w2 = 0; w2 < w; ++w2) { const float A2 = wagg[(w2 * 2 + 0) * 64 + d], B2 = wagg[(w2 * 2 + 1) * 64 + d]; cin = A2 * cin + B2; cprod *= A2; }
#pragma unroll
    for (int tt = 0; tt < 32; ++tt) { const size_t o = (size_t)(t0 + 32 * w + tt) * 256 + ch; const float hh = ga[tt] + gx[tt] * cin, cA = gx[tt] * cprod; HLOC[o] = hh; CUMA[o] = cA;
        if (w == 7 && tt == 31) { AGG[(chunk * 2 + 0) * 256 + ch] = cA; AGG[(chunk * 2 + 1) * 256 + ch] = hh; } }
    __syncthreads();
}

__device__ __forceinline__ void conf_unit(Frame& F, const ArgsV& A_, int l, int unit) {
    const bf16_t* U = (const bf16_t*)(F.ws + WS_U); bf16_t* MIX = (bf16_t*)(F.ws + WS_MIX);
    const float* cw = A_.in[16] + l * 31 * 256; const float* cb = A_.in[17] + l * 256; const float* lg = A_.in[18] + l * 256; const float* lb = A_.in[19] + l * 256;
    LAS float* gin = (LAS float*)F.lds; LAS float* cout = gin + 62 * 256;
    const int ch = F.tid & 255, half = F.tid >> 8, t0 = unit * 32;
    for (int it = F.tid; it < 62 * 32; it += NTHREADS) { const int r = it >> 5, g8 = it & 31, ts = t0 - 30 + r;
        f32x4 v0 = (f32x4){0.f, 0.f, 0.f, 0.f}, v1 = v0;
        if (ts >= 0) { const u32x4 a = *(const u32x4*)(U + (size_t)ts * NCOLA + UCA + 8 * g8), b = *(const u32x4*)(U + (size_t)ts * NCOLA + UCB + 8 * g8);
            v0.x = bflo(a.x) * sigmoidf_(bflo(b.x)); v0.y = bfhi(a.x) * sigmoidf_(bfhi(b.x)); v0.z = bflo(a.y) * sigmoidf_(bflo(b.y)); v0.w = bfhi(a.y) * sigmoidf_(bfhi(b.y));
            v1.x = bflo(a.z) * sigmoidf_(bflo(b.z)); v1.y = bfhi(a.z) * sigmoidf_(bfhi(b.z)); v1.z = bflo(a.w) * sigmoidf_(bflo(b.w)); v1.w = bfhi(a.w) * sigmoidf_(bfhi(b.w)); }
        *(LAS f32x4*)(gin + r * 256 + 8 * g8) = v0; *(LAS f32x4*)(gin + r * 256 + 8 * g8 + 4) = v1; }
    float wreg[31];
#pragma unroll
    for (int j = 0; j < 31; ++j) wreg[j] = cw[j * 256 + ch];
    const float bb = cb[ch];
    __syncthreads();
    { float x[46];
#pragma unroll
      for (int k = 0; k < 46; ++k) x[k] = gin[(half * 16 + k) * 256 + ch];
#pragma unroll
      for (int tt = 0; tt < 16; ++tt) { float a = bb;
#pragma unroll
          for (int j = 0; j < 31; ++j) a += wreg[j] * x[tt + j];
          cout[(half * 16 + tt) * 256 + ch] = a; } }
    __syncthreads();
#pragma unroll
    for (int q = 0; q < 4; ++q) { const int t = 4 * F.wave + q;
        f32x4 v = *(const LAS f32x4*)(cout + t * 256 + 4 * F.lane);
        const float mean = wave_sum((v.x + v.y) + (v.z + v.w), F.lane << 2) * (1.f / 256.f); v = v - mean;
        const float var = wave_sum((v.x * v.x + v.y * v.y) + (v.z * v.z + v.w * v.w), F.lane << 2) * (1.f / 256.f), rstd = __builtin_amdgcn_rsqf(var + LN_EPS);
        const f32x4 gv = *(const f32x4*)(lg + 4 * F.lane), bv = *(const f32x4*)(lb + 4 * F.lane);
        f32x4 y = v * rstd * gv + bv;
        y.x = y.x * sigmoidf_(y.x); y.y = y.y * sigmoidf_(y.y); y.z = y.z * sigmoidf_(y.z); y.w = y.w * sigmoidf_(y.w);
        u32x2 wv; wv.x = pk2(y.x, y.y); wv.y = pk2(y.z, y.w);
        *(u32x2*)(MIX + (size_t)(t0 + t) * 1024 + 768 + 4 * F.lane) = wv; }
    __syncthreads();
}

__device__ __forceinline__ void phase_mixers(Frame& F, const ArgsV& A_, int l, int probe) {
    const bf16_t* U = (const bf16_t*)(F.ws + WS_U); const bf16_t* VT = (const bf16_t*)(F.ws + WS_VT); bf16_t* MIX = (bf16_t*)(F.ws + WS_MIX);
    { const float* KN = (const float*)(F.ws + WS_KN); LAS float* kp = (LAS float*)(F.lds + P2_KP);
      const int tb = F.wave, ln = F.lane;
      const f32x4 v = *(const f32x4*)(KN + tb * 256 + 4 * ln);
      const float p0 = v.x, p1 = fmaxf(p0, v.y), p2 = fmaxf(p1, v.z), p3 = fmaxf(p2, v.w);
      float run = p3;
#pragma unroll
      for (int o = 1; o < 64; o <<= 1) { const float t = shup(run, ln << 2, o); if (ln >= o) run = fmaxf(run, t); }
      float ex = shup(run, ln << 2, 1); if (ln == 0) ex = 0.f;
      f32x4 o4; o4.x = fsqrt(fmaxf(ex, p0)); o4.y = fsqrt(fmaxf(ex, p1)); o4.z = fsqrt(fmaxf(ex, p2)); o4.w = fsqrt(fmaxf(ex, p3));
      *(LAS f32x4*)(kp + tb * 256 + 4 * ln) = o4;
    }
    float d1 = 0.f, d2 = 0.f;
    { const float* lq1 = A_.in[4] + l * 64; const float* lk1 = A_.in[5] + l * 64; const float* lq2 = A_.in[6] + l * 64; const float* lk2 = A_.in[7] + l * 64;
      d1 = wave_sum(lq1[F.lane] * lk1[F.lane], F.lane << 2); d2 = wave_sum(lq2[F.lane] * lk2[F.lane], F.lane << 2); }
    const float lam_init = 0.8f - 0.6f * fexp(-0.3f * (float)l);
    const float lam = fexp(d1) - fexp(d2) + lam_init;
    const float* subg = A_.in[8] + l * 128;
    unsigned* qhead = (unsigned*)(F.ws + WS_CTL) + CW_QUEUE + 64 * l;
    volatile LAS unsigned* slot = (volatile LAS unsigned*)(F.lds + P2_FLG) + 16;
    __syncthreads();
    for (;;) {
        if (F.tid == 0) slot[0] = atomicAdd(qhead, 1u);
        __syncthreads();
        const int q = (int)__builtin_amdgcn_readfirstlane(slot[0]);
        __syncthreads();
        if (q >= N_ITEMS + 256 + 512) break;
        if (probe) {
            if (probe == 1 && q >= N_ITEMS) continue;
            if (probe == 2 && (q < N_ITEMS || q >= N_ITEMS + 256)) continue;
            if (probe == 3 && q < N_ITEMS + 256) continue;
            if (probe >= 4 && probe <= 7 && (q >= N_ITEMS || (g_tabs.item[g_tabs.order[q]] & 3) != probe - 4)) continue;
        }
        Frame Fu = make_frame(F.lds, F.ws);
        if (q < N_ITEMS) { const int idx = g_tabs.order[q], it = g_tabs.item[idx]; const int h = it & 3, qb = (it >> 2) & 127;
            if (it & 0x8000) { const int seg = (it >> 9) & 7, jt_top = 2 * qb + 1 - SEGT * seg; const int jb = jt_top - (SEGT - 1);
                attn::attn_unit(Fu.lds, (const unsigned char*)Fu.ws, (bf16_t*)(Fu.ws + WS_MIX), subg, lam, 1.0f - lam_init, h, qb, jt_top, jb > 0 ? jb : 0, (float*)(Fu.ws + WS_PART) + (size_t)(idx - N_UNSPLIT) * (PART_SLOT / 4), Fu.tid); }
            else attn::attn_unit(Fu.lds, (const unsigned char*)Fu.ws, (bf16_t*)(Fu.ws + WS_MIX), subg, lam, 1.0f - lam_init, h, qb, 2 * qb + 1, 0, nullptr, Fu.tid); }
        else if (q < N_ITEMS + 256) lru_unit(Fu, A_, l, q - N_ITEMS);
        else conf_unit(Fu, A_, l, q - N_ITEMS - 256);
    }
}

__device__ __forceinline__ void phase_lru_fix(Frame& F, const ArgsV& A_, int l) {
    const bf16_t* U = (const bf16_t*)(F.ws + WS_U); bf16_t* MIX = (bf16_t*)(F.ws + WS_MIX);
    const float* HLOC = (const float*)(F.ws + WS_HLOC); const float* CUMA = (const float*)(F.ws + WS_CUMA); const float* AGG = (const float*)(F.ws + WS_AGG);
    LAS float* ag = (LAS float*)F.lds;
    const int ch = F.tid & 255, half = F.tid >> 8;
    for (int unit = F.bid; unit < 256; unit += F.G) {
        const int chunk = unit >> 2, qt = unit & 3, t0 = chunk * 256 + qt * 64 + half * 32;
        for (int i = F.tid; i < chunk * 128; i += NTHREADS) *(LAS f32x4*)(ag + 4 * i) = *(const f32x4*)(AGG + 4 * i);
        __syncthreads();
        float cin = 0.f;
        for (int k = 0; k < chunk; ++k) cin = ag[(k * 2 + 0) * 256 + ch] * cin + ag[(k * 2 + 1) * 256 + ch];
        for (int t = 0; t < 32; ++t) { const size_t tt = (size_t)(t0 + t);
            const float hh = HLOC[tt * 256 + ch] + CUMA[tt * 256 + ch] * cin;
            const float y = bf2f(U[tt * NCOLA + ULY + ch]);
            const float gl = y * frcp(1.0f + fexp(-2.0f * 0.7978845608028654f * (y + 0.044715f * y * y * y)));
            MIX[tt * 1024 + 512 + ch] = (bf16_t)f2bf(hh * gl); }
        __syncthreads();
    }
    { const float* lq1 = A_.in[4] + l * 64; const float* lk1 = A_.in[5] + l * 64; const float* lq2 = A_.in[6] + l * 64; const float* lk2 = A_.in[7] + l * 64;
      const float d1 = wave_sum(lq1[F.lane] * lk1[F.lane], F.lane << 2), d2 = wave_sum(lq2[F.lane] * lk2[F.lane], F.lane << 2);
      const float lam_init = 0.8f - 0.6f * fexp(-0.3f * (float)l), lam = fexp(d1) - fexp(d2) + lam_init;
      for (int unit = F.bid; unit < 112; unit += F.G) attn::attn_combine(F.lds, (const unsigned char*)F.ws, MIX, A_.in[8] + l * 128, lam, 1.0f - lam_init, 16 + unit, F.tid); }
}

__device__ __forceinline__ void phase_ln1(Frame& F, const ArgsV& A_, int l) {
    const float* HA = (const float*)(F.ws + WS_HA); const float* MO = (const float*)(F.ws + WS_MIXO); float* HB = (float*)(F.ws + WS_HB); bf16_t* XB = (bf16_t*)(F.ws + WS_XB);
    const int gw = F.bid * NWAVES + F.wave, NGW = F.G * NWAVES;
    for (int m = gw; m < T; m += NGW) {
        f32x4 v[4];
#pragma unroll
        for (int j = 0; j < 4; ++j) v[j] = *(const f32x4*)(HA + (size_t)m * D + 4 * F.lane + 256 * j) * ALPHA + *(const f32x4*)(MO + (size_t)m * D + 4 * F.lane + 256 * j);
        ln_store(v, A_.in[21] + l * D, A_.in[22] + l * D, HB + (size_t)m * D, nullptr, F.lane, (unsigned char*)(F.ws + WS_XB8) + (size_t)m * D);
    }
}

__device__ __forceinline__ void phase_router(Frame& F, const ArgsV& A_, int l) {
    const float* HB = (const float*)(F.ws + WS_HB); const float* rw = A_.in[23] + (size_t)l * 1024 * 32; const float* rb = A_.in[24] + l * 32;
    int* TKS = (int*)(F.ws + WS_TKS); float* TKG = (float*)(F.ws + WS_TKG); int* LIST = (int*)(F.ws + WS_LIST);
    unsigned* gcnt = (unsigned*)(F.ws + WS_CTL) + CW_CNT + l * 64;
    LAS float* part = (LAS float*)F.lds;
    LAS float* lg = (LAS float*)(F.lds + 65536);
    LAS unsigned* lcnt = (LAS unsigned*)(F.lds + 81920);
    const int ln = F.lane & 31, hf = F.lane >> 5, kb = F.wave * 128;
    float rwv[16][4];
#pragma unroll
    for (int i = 0; i < 16; ++i)
#pragma unroll
        for (int s = 0; s < 4; ++s) rwv[i][s] = rw[(size_t)(kb + 8 * i + 4 * hf + s) * 32 + ln];
    for (int base = F.bid * 64; base < T; base += F.G * 64) {
        if (F.tid < 64) lcnt[F.tid] = 0u;
#pragma unroll
        for (int g = 0; g < 2; ++g) {
            f32x4 hv[16];
            const float* hp = HB + (size_t)(base + 32 * g + ln) * D + kb + 4 * hf;
#pragma unroll
            for (int i = 0; i < 16; ++i) hv[i] = *(const f32x4*)(hp + 8 * i);
            f32x16 acc;
#pragma unroll
            for (int r = 0; r < 16; ++r) acc[r] = 0.f;
#pragma unroll
            for (int i = 0; i < 16; ++i) {
                acc = __builtin_amdgcn_mfma_f32_32x32x2f32(rwv[i][0], hv[i].x, acc, 0, 0, 0);
                acc = __builtin_amdgcn_mfma_f32_32x32x2f32(rwv[i][1], hv[i].y, acc, 0, 0, 0);
                acc = __builtin_amdgcn_mfma_f32_32x32x2f32(rwv[i][2], hv[i].z, acc, 0, 0, 0);
                acc = __builtin_amdgcn_mfma_f32_32x32x2f32(rwv[i][3], hv[i].w, acc, 0, 0, 0);
            }
#pragma unroll
            for (int r = 0; r < 16; ++r) { const int e = (r & 3) + 8 * (r >> 2) + 4 * hf; part[((F.wave * 2 + g) * 32 + e) * 32 + ln] = acc[r]; }
        }
        __syncthreads();
        { const int tt = F.tid & 63, eg = F.tid >> 6;
#pragma unroll
          for (int q = 0; q < 4; ++q) { const int e = 4 * eg + q; float s = rb[e];
#pragma unroll
              for (int w2 = 0; w2 < 8; ++w2) s += part[((w2 * 2 + (tt >> 5)) * 32 + e) * 32 + (tt & 31)];
              lg[tt * 33 + e] = s; } }
        __syncthreads();
        int sel[4]; float sv[4]; int pos[4];
        if (F.tid < 64) {
            float v[32];
#pragma unroll
            for (int e = 0; e < 32; ++e) v[e] = lg[F.tid * 33 + e];
#pragma unroll
            for (int k = 0; k < 4; ++k) { float best = -__builtin_inff(); int bi = 0;
#pragma unroll
                for (int e = 0; e < 32; ++e) { if (v[e] > best) { best = v[e]; bi = e; } }
                sel[k] = bi; sv[k] = best;
#pragma unroll
                for (int e = 0; e < 32; ++e) if (e == bi) v[e] = -__builtin_inff(); }
            const float e1 = fexp(sv[1] - sv[0]), e2 = fexp(sv[2] - sv[0]), e3 = fexp(sv[3] - sv[0]), inv = 1.0f / (1.0f + e1 + e2 + e3);
            sv[0] = inv; sv[1] = e1 * inv; sv[2] = e2 * inv; sv[3] = e3 * inv;
#pragma unroll
            for (int k = 0; k < 4; ++k) pos[k] = (int)atomicAdd((unsigned*)&lcnt[sel[k]], 1u);
        }
        __syncthreads();
        if (F.tid < 32) lcnt[32 + F.tid] = atomicAdd(&gcnt[F.tid], lcnt[F.tid]);
        __syncthreads();
        if (F.tid < 64) {
            const int t = base + F.tid;
#pragma unroll
            for (int k = 0; k < 4; ++k) { const int p = pos[k] + (int)lcnt[32 + sel[k]]; TKS[t * 4 + k] = sel[k] * T + p; TKG[t * 4 + k] = sv[k]; LIST[(size_t)sel[k] * T + p] = t; }
        }
        __syncthreads();
    }
}

__device__ __forceinline__ void moe_tables(Frame& F, int l, int NT) {
    LAS int* tab = (LAS int*)(F.lds + MISC_OFF);
    if (F.wave == 0) {
        const unsigned* gcnt = (const unsigned*)(F.ws + WS_CTL) + CW_CNT + l * 64;
        const int e = F.lane & 31;
        const int c = (int)__hip_atomic_load(&gcnt[e], __ATOMIC_RELAXED, __HIP_MEMORY_SCOPE_AGENT);
        const int tm = (c + 255) >> 8;
        int incl = tm;
#pragma unroll
        for (int o = 1; o < 32; o <<= 1) { const int v = shupi(incl, F.lane << 2, o); if (e >= o) incl += v; }
        if (F.lane < 32) { tab[e] = (incl - tm) * NT; tab[40 + e] = (incl - tm) * 256; tab[80 + e] = c; if (e == 31) tab[32] = incl * NT; }
    }
    __syncthreads();
}

__device__ __forceinline__ void phase_combine(Frame& F, const ArgsV& A_, int l, float* outp) {
    moe_tables(F, l, 1);
    const LAS int* tab = (const LAS int*)(F.lds + MISC_OFF);
    const float* HB = (const float*)(F.ws + WS_HB); const bf16_t* Y = (const bf16_t*)(F.ws + WS_Y);
    const int* TKS = (const int*)(F.ws + WS_TKS); const float* TKG = (const float*)(F.ws + WS_TKG);
    float* HA = outp ? outp : (float*)(F.ws + WS_HA); bf16_t* XB = outp ? nullptr : (bf16_t*)(F.ws + WS_XB);
    const int gw = F.bid * NWAVES + F.wave, NGW = F.G * NWAVES;
    for (int m = gw; m < T; m += NGW) {
        f32x4 v[4];
#pragma unroll
        for (int j = 0; j < 4; ++j) v[j] = *(const f32x4*)(HB + (size_t)m * D + 4 * F.lane + 256 * j) * ALPHA;
#pragma unroll
        for (int k = 0; k < 4; ++k) { const int code = TKS[m * 4 + k]; const float g = TKG[m * 4 + k]; const int e = code >> 14, p = code & (T - 1);
            const bf16_t* yr = Y + (size_t)(tab[40 + e] + p) * 1024 + 4 * F.lane;
#pragma unroll
            for (int j = 0; j < 4; ++j) { const u32x2 wv = *(const u32x2*)(yr + 256 * j); v[j].x += g * bflo(wv.x); v[j].y += g * bfhi(wv.x); v[j].z += g * bflo(wv.y); v[j].w += g * bfhi(wv.y); } }
        ln_store(v, A_.in[29] + l * D, A_.in[30] + l * D, HA + (size_t)m * D, XB ? XB + (size_t)m * D : nullptr, F.lane);
    }
    __syncthreads();
}

constexpr int PH_PER_LAYER = 10, N_PHASES = 1 + NL * PH_PER_LAYER;

__global__ void __launch_bounds__(NTHREADS, 2) mk_fwd(Args args) {
    extern __shared__ __attribute__((aligned(16))) unsigned char lds_raw[];
    LAS unsigned char* const lds = (LAS unsigned char*)lds_raw;
    const int lo = args.ph_lo, hi = args.ph_hi;
    volatile LAS unsigned* bst = (volatile LAS unsigned*)(lds + MISC_OFF + 2048);
    if (threadIdx.x < 2) bst[threadIdx.x] = 0u;
    if (threadIdx.x == 0) {
        LAS unsigned long long* pt = (LAS unsigned long long*)(lds + PTAB_OFF);
#pragma unroll
        for (int k = 0; k < 31; ++k) pt[k] = (unsigned long long)args.in[k];
    }
    __syncthreads();
    XcdBarrier bar; bar.bar = (unsigned*)(args.ws + WS_CTL) + CW_BAR; bar.x = 0; bar.st = bst;
    if (hi - lo > 1) bar = xcd_barrier_post((unsigned*)(args.ws + WS_CTL) + CW_BAR, bst);
    const ArgsV AV{InTab{lds}};
#ifdef ONLY_SUB
    const int only_sub = ONLY_SUB;
#else
    const int only_sub = -2;
#endif
#pragma unroll 1
    for (int ph = lo; ph < hi; ++ph) {
        const int l = (ph > 0) ? (ph - 1) / PH_PER_LAYER : 0;
        int sub = (ph > 0) ? (ph - 1) % PH_PER_LAYER : -1;
        if (only_sub != -2 && sub != only_sub) continue;
        bool seam = true;
        switch (sub) {
        case -1: { Frame F = make_frame(lds, args.ws); phase_prologue(F, AV); } break;
        case 0: {
            Frame F = make_frame(lds, args.ws);
            pg8::PlainOrder S; S.init(WS_XB, WS_WINT + (size_t)l * 2560 * 1024 * 2, T, NCOLA, F.G, F.bid);
            pg8::EpiBf16 E{(bf16_t*)(F.ws + WS_U), NCOLA, nullptr, 0, 0.125f * LOG2E, 512};
            pg8::gemm_phase<pg8::EpiBf16, pg8::PlainOrder, true>(F.lds, (const char*)F.ws, F.tid, S, E); } break;
        case 1: {
            Frame F = make_frame(lds, args.ws);
            pg8::PlainOrder S; S.init(WS_WINT + ((size_t)l * 2560 + 2048) * 1024 * 2, WS_XB, 512, T, F.G, F.bid);
            pg8::EpiVT E{(bf16_t*)(F.ws + WS_VT)};
            pg8::gemm_phase<pg8::EpiVT, pg8::PlainOrder, true>(F.lds, (const char*)F.ws, F.tid, S, E);
            phase_knorm(F); } break;
        case 2: { Frame F = make_frame(lds, args.ws); phase_mixers(F, AV, l, args.probe); } break;
        case 3: { Frame F = make_frame(lds, args.ws); phase_lru_fix(F, AV, l); } break;
        case 4: {
            Frame F = make_frame(lds, args.ws);
            pg8::PlainOrder S; S.init(WS_MIX, WS_WOUTT + (size_t)l * 1024 * 1024 * 2, T, D, F.G, F.bid);
            pg8::EpiF32 E{(float*)(F.ws + WS_MIXO), D};
            pg8::gemm_phase<pg8::EpiF32, pg8::PlainOrder, true>(F.lds, (const char*)F.ws, F.tid, S, E); } break;
        case 5: { Frame F = make_frame(lds, args.ws); phase_ln1(F, AV, l); } break;
        case 6: { Frame F = make_frame(lds, args.ws); phase_router(F, AV, l); } break;
        case 7: {
            Frame F = make_frame(lds, args.ws);
            moe_tables(F, l, 8);
            pg8::MoeOrder S{(unsigned)WS_XB8, (unsigned)(WS_W1T + (size_t)l * NE * 2048 * 1024), 2048u * 1024u, 8, 1, (const int*)(F.ws + WS_LIST), (const LAS int*)(F.lds + MISC_OFF), F.G, F.bid, KD};
            pg8::EpiAct E{(unsigned char*)(F.ws + WS_ACT), AV.in[26] + (size_t)l * NE * 2048};
            pg8::gemm_phase<pg8::EpiAct, pg8::MoeOrder, true, true>(F.lds, (const char*)F.ws, F.tid, S, E); } break;
        case 8: {
            Frame F = make_frame(lds, args.ws);
            moe_tables(F, l, 4);
            pg8::MoeOrder S{(unsigned)WS_ACT, (unsigned)(WS_W2T + (size_t)l * NE * 1024 * 1024), 1024u * 1024u, 4, 0, nullptr, (const LAS int*)(F.lds + MISC_OFF), F.G, F.bid, KD};
            pg8::EpiBf16 E{(bf16_t*)(F.ws + WS_Y), 1024, AV.in[28] + (size_t)l * NE * 1024, 1024, 1.0f, 0};
            pg8::gemm_phase<pg8::EpiBf16, pg8::MoeOrder, true, true>(F.lds, (const char*)F.ws, F.tid, S, E); } break;
        default: { Frame F = make_frame(lds, args.ws); phase_combine(F, AV, l, (l == NL - 1) ? args.out : nullptr); } break;
        }
        if (seam && ph + 1 < hi) xcd_barrier(bar);
    }
}

extern "C" void kernel_launch(void* const* d_in, const int* in_sizes, int n_in, void* d_out, int out_size, void* d_ws, size_t ws_size, hipStream_t stream) {
    static int grid = 0;
    if (grid == 0) {
        if (n_in != 31 || out_size != T * D || ws_size < WS_END2) { fprintf(stderr, "kernel_launch: unexpected sizes n_in %d out %d ws %zu (need %zu)\n", n_in, out_size, ws_size, (size_t)WS_END); grid = -1; return; }
        int dev = 0, cus = 0, per_cu = 0;
        if (hipGetDevice(&dev) != hipSuccess || hipDeviceGetAttribute(&cus, hipDeviceAttributeMultiprocessorCount, dev) != hipSuccess) { grid = -1; return; }
        if (hipFuncSetAttribute((const void*)mk_fwd, hipFuncAttributeMaxDynamicSharedMemorySize, LDS_BYTES) != hipSuccess) { fprintf(stderr, "kernel_launch: hipFuncSetAttribute failed\n"); grid = -1; return; }
        if (hipOccupancyMaxActiveBlocksPerMultiprocessor(&per_cu, (const void*)mk_fwd, NTHREADS, LDS_BYTES) != hipSuccess || per_cu < 1) { fprintf(stderr, "kernel_launch: occupancy query says %d blocks per CU\n", per_cu); (void)hipGetLastError(); grid = -1; return; }
        grid = cus;
    }
    if (grid < 0) return;
    (void)hipMemsetAsync((char*)d_ws + WS_CTL, 0, CTL_ZERO_BYTES, stream);
    Args a{};
    for (int i = 0; i < 31; ++i) a.in[i] = (const float*)d_in[i];
    a.out = (float*)d_out; a.ws = (unsigned char*)d_ws;
#if MK_ONE_LAUNCH
    a.ph_lo = 0; a.ph_hi = N_PHASES;
    hipLaunchKernelGGL(mk_fwd, dim3(grid), dim3(NTHREADS), LDS_BYTES, stream, a);
#ifdef PROBE_LO
    (void)hipMemsetAsync((char*)d_ws + WS_CTL + CW_BAR * 4, 0, XCD_BAR_WORDS * 4, stream);
    (void)hipMemsetAsync((char*)d_ws + WS_CTL + CW_QUEUE * 4, 0, 1024, stream);
    a.probe = PROBE_MODE;
    a.ph_lo = PROBE_LO; a.ph_hi = PROBE_HI;
    hipLaunchKernelGGL(mk_fwd, dim3(grid), dim3(NTHREADS), LDS_BYTES, stream, a);
#endif
#else
    for (int p = 0; p < N_PHASES; ++p) { a.ph_lo = p; a.ph_hi = p + 1; hipLaunchKernelGGL(mk_fwd, dim3(grid), dim3(NTHREADS), LDS_BYTES, stream, a); }
#endif
}
```

```cpp
#include <hip/hip_runtime.h>
#include <cstdio>
#include <cstdint>

#ifndef PROBE_DUP
#define PROBE_DUP 0
#endif
#ifndef MK_ONE_LAUNCH
#define MK_ONE_LAUNCH 1
#endif

#define LAS __attribute__((address_space(3)))
#define GAS __attribute__((address_space(1)))
typedef unsigned short bf16_t;
typedef short bf16x8 __attribute__((ext_vector_type(8)));
typedef float f32x2 __attribute__((ext_vector_type(2)));
typedef float f32x4 __attribute__((ext_vector_type(4)));
typedef float f32x16 __attribute__((ext_vector_type(16)));
typedef unsigned u32x4 __attribute__((ext_vector_type(4)));
typedef unsigned u32x2 __attribute__((ext_vector_type(2)));
typedef int i32x8 __attribute__((ext_vector_type(8)));
typedef int i32x4 __attribute__((ext_vector_type(4)));

constexpr int T = 16384, D = 1024, NL = 2, NE = 32, KD = 1024;
constexpr int NCOLA = 2048;
constexpr int UQ = 0, UK = 512, ULX = 1024, ULY = 1280, UCA = 1536, UCB = 1792;
constexpr float LN_EPS = 1e-5f;
constexpr float ALPHA = 1.41421356237309515f;
constexpr float LOG2E = 1.44269504088896341f;
constexpr int NWAVES = 8, NTHREADS = 512;
constexpr int ACT_ROWS = 65536 + 32 * 256 + 256;

constexpr size_t MiB = 1u << 20;
constexpr size_t WS_CTL = 0, CTL_ZERO_BYTES = 1 * MiB;
constexpr size_t WS_WINT = 2 * MiB;
constexpr size_t WS_WOUTT = 12 * MiB;
constexpr size_t WS_W1T = 16 * MiB;
constexpr size_t WS_W2T = 272 * MiB;
constexpr size_t WS_HA = 400 * MiB;
constexpr size_t WS_HB = 464 * MiB;
constexpr size_t WS_XB = 528 * MiB;
constexpr size_t WS_U = 560 * MiB;
constexpr size_t WS_VT = 624 * MiB;
constexpr size_t WS_MIX = 640 * MiB;
constexpr size_t WS_MIXO = 672 * MiB;
constexpr size_t WS_HLOC = 736 * MiB;
constexpr size_t WS_CUMA = 752 * MiB;
constexpr size_t WS_AGG = 768 * MiB;
constexpr size_t WS_TKS = 769 * MiB;
constexpr size_t WS_TKG = 769 * MiB + 512 * 1024;
constexpr size_t WS_LIST = 770 * MiB;
constexpr size_t WS_ACT = 772 * MiB;
constexpr size_t WS_Y = 920 * MiB;
constexpr size_t WS_END = 1068 * MiB;
static_assert(WS_ACT + (size_t)ACT_ROWS * 2048 <= WS_Y && WS_Y + (size_t)ACT_ROWS * 2048 <= WS_END, "ws map");
constexpr int CW_BAR = 4096;
constexpr int CW_CNT = 16384;

constexpr int RING_BYTES = 135168;
constexpr int MISC_OFF = RING_BYTES;
constexpr int LDS_BYTES = 147456;
constexpr int VA_PARK_OFF = MISC_OFF + 4096;

__device__ __forceinline__ unsigned f2bf(float f) { unsigned u = __builtin_bit_cast(unsigned, f); return (u + 0x7fffu + ((u >> 16) & 1u)) >> 16; }
__device__ __forceinline__ unsigned pk2(float lo, float hi) { return f2bf(lo) | (f2bf(hi) << 16); }
__device__ __forceinline__ float bf2f(bf16_t v) { return __builtin_bit_cast(float, (unsigned)v << 16); }
__device__ __forceinline__ float bflo(unsigned w) { return __builtin_bit_cast(float, w << 16); }
__device__ __forceinline__ float bfhi(unsigned w) { return __builtin_bit_cast(float, w & 0xffff0000u); }
typedef __bf16 bf16x2_t __attribute__((ext_vector_type(2)));
__device__ __forceinline__ unsigned cvt_pk_bf16(float lo, float hi) { const f32x2 v = {lo, hi}; const bf16x2_t b = __builtin_convertvector(v, bf16x2_t); return __builtin_bit_cast(unsigned, b); }
__device__ __forceinline__ float shx(float v, int lane4, int mask) { return __builtin_bit_cast(float, __builtin_amdgcn_ds_bpermute(lane4 ^ (mask << 2), __builtin_bit_cast(int, v))); }
__device__ __forceinline__ float shup(float v, int lane4, int d) { return __builtin_bit_cast(float, __builtin_amdgcn_ds_bpermute(lane4 - (d << 2), __builtin_bit_cast(int, v))); }
__device__ __forceinline__ int shupi(int v, int lane4, int d) { return __builtin_amdgcn_ds_bpermute(lane4 - (d << 2), v); }
__device__ __forceinline__ float wave_sum(float v, int lane4) {
#pragma unroll
    for (int o = 1; o < 64; o <<= 1) v += shx(v, lane4, o);
    return v;
}
__device__ __forceinline__ float ex2(float x) { return __builtin_amdgcn_exp2f(x); }
__device__ __forceinline__ float fexp(float x) { return __builtin_amdgcn_exp2f(x * LOG2E); }
__device__ __forceinline__ float frcp(float x) { return __builtin_amdgcn_rcpf(x); }
__device__ __forceinline__ float fsqrt(float x) { return __builtin_amdgcn_sqrtf(x); }
__device__ __forceinline__ float flog(float x) { return __builtin_amdgcn_logf(x) * 0.693147180559945f; }
__device__ __forceinline__ float vmax3(float a, float b, float c) { float r; asm("v_max3_f32 %0, %1, %2, %3" : "=v"(r) : "v"(a), "v"(b), "v"(c)); return r; }
__device__ __forceinline__ float vadd(float a, float b) { float r; asm("v_add_f32 %0, %1, %2" : "=v"(r) : "v"(a), "v"(b)); return r; }
__device__ __forceinline__ float sigmoidf_(float x) { return frcp(1.0f + fexp(-x)); }
#define LDS_WAIT() asm volatile("s_waitcnt lgkmcnt(0)" ::: "memory")
#define VM_WAIT() asm volatile("s_waitcnt vmcnt(0)" ::: "memory")

namespace pg8 {
constexpr int BM = 256, BK = 64, HALF = 128, HTB = HALF * BK * 2, STAGE_BYTES = 8 * HTB, NXCD = 8, WGM = 8;
__device__ __forceinline__ int lds_byte(int r, int c) { const int st = (r >> 4) * 2 + (c >> 5), rr = r & 15, cc = c & 31, ob = rr * 64 + cc * 2; return st * 1024 + (ob ^ (((ob >> 9) & 1) << 5)); }
__device__ __forceinline__ void stage_rc(int b, int& R, int& C) { const unsigned ub = (unsigned)b, st = ub >> 10, sb = ub & 1023u, swz = sb ^ (((sb >> 9) & 1u) << 5); R = (int)((st >> 1) * 16u + (swz >> 6)); C = (int)((st & 1u) * 32u + ((swz & 63u) >> 1)); }
__device__ __forceinline__ int perm32(int rho) { const int n = rho >> 4, i = rho & 15; return 8 * (i >> 2) + 4 * n + (i & 3); }

struct Unit { unsigned A, B; int pn, e, orow; unsigned va00, va01, va10, va11; };

struct PlainOrder {
    unsigned A, Bt; int nM, nN, nwg, G, c, rowb;
    __device__ void init(size_t A_, size_t Bt_, int M, int N, int G_, int c_, int rowb_ = KD * 2) { rowb = rowb_; A = (unsigned)A_; Bt = (unsigned)Bt_; nM = M / BM; nN = N / BM; nwg = nM * nN; G = G_; c = c_; }
    __device__ __forceinline__ bool next(int i, Unit& u, int tid) const {
        const long L = (long)i * G + c; if (L >= nwg) return false;
        int R0, C0, R1, C1; stage_rc(tid * 16, R0, C0); stage_rc(tid * 16 + 8192, R1, C1);
        int wgid = (int)L; { const int q = nwg / NXCD, r = nwg % NXCD, xcd = wgid % NXCD, off = wgid / NXCD; wgid = (xcd < r ? xcd * (q + 1) : r * (q + 1) + (xcd - r) * q) + off; }
        const int nig = WGM * nN, gid = wgid / nig, fm = gid * WGM, gsz = (nM - fm) < WGM ? (nM - fm) : WGM;
        const int pm = fm + ((wgid % nig) % gsz), pn = (wgid % nig) / gsz;
        u.A = A + (unsigned)pm * (unsigned)(BM * rowb); u.B = Bt + (unsigned)pn * (unsigned)(BM * rowb); u.pn = pn; u.e = 0; u.orow = pm * BM;
        u.va00 = (unsigned)(R0 * rowb + C0 * 2); u.va01 = (unsigned)(R1 * rowb + C1 * 2); u.va10 = (unsigned)((R0 + HALF) * rowb + C0 * 2); u.va11 = (unsigned)((R1 + HALF) * rowb + C1 * 2);
        return true;
    }
};

struct MoeOrder {
    unsigned Abase, Bt, bstride; int NT; int gather; const int* list; const LAS int* tab; int G, c, rowb;
    __device__ __forceinline__ bool next(int i, Unit& u, int tid) const {
        const int NU = __builtin_amdgcn_readfirstlane(tab[32]);
        int L;
        if ((G & 7) == 0) { const int g8 = G >> 3, per = (NU + 7) >> 3, idx = i * g8 + (c >> 3); if (idx >= per) return false; L = (c & 7) * per + idx; }
        else L = i * G + c;
        if (L >= NU) return false;
        int R0, C0, R1, C1; stage_rc(tid * 16, R0, C0); stage_rc(tid * 16 + 8192, R1, C1);
        const int ln_ = tid & 63;
        int e = __popcll(__ballot(ln_ >= 1 && ln_ < 32 && L >= tab[ln_ & 31]));
        e = __builtin_amdgcn_readfirstlane(e);
        const int ub = __builtin_amdgcn_readfirstlane(tab[e]), ub1 = __builtin_amdgcn_readfirstlane(tab[e + 1]);
        const int ps = __builtin_amdgcn_readfirstlane(tab[40 + e]), cnt = __builtin_amdgcn_readfirstlane(tab[80 + e]);
        const int tm = (ub1 - ub) / NT, r = L - ub, mt = r % tm, nt = r / tm;
        u.e = e; u.pn = nt; u.orow = ps + mt * BM;
        u.B = Bt + (unsigned)e * bstride + (unsigned)nt * (unsigned)(BM * rowb);
        if (gather) {
            u.A = Abase;
            const int* lp = list + (size_t)e * T + mt * BM; const int lim = cnt - mt * BM;
            const int t00 = (R0 < lim) ? lp[R0] : 0, t01 = (R1 < lim) ? lp[R1] : 0, t10 = (R0 + HALF < lim) ? lp[R0 + HALF] : 0, t11 = (R1 + HALF < lim) ? lp[R1 + HALF] : 0;
            u.va00 = (unsigned)(t00 * rowb + C0 * 2); u.va01 = (unsigned)(t01 * rowb + C1 * 2); u.va10 = (unsigned)(t10 * rowb + C0 * 2); u.va11 = (unsigned)(t11 * rowb + C1 * 2);
        } else {
            u.A = Abase + (unsigned)u.orow * (unsigned)rowb;
            u.va00 = (unsigned)(R0 * rowb + C0 * 2); u.va01 = (unsigned)(R1 * rowb + C1 * 2); u.va10 = (unsigned)((R0 + HALF) * rowb + C0 * 2); u.va11 = (unsigned)((R1 + HALF) * rowb + C1 * 2);
        }
        return true;
    }
};

struct EpiBf16 {
    static constexpr bool PERM = true;
    bf16_t* O; int ldc; const float* bias; int bias_stride; float scale0; int scale_cols;
    __device__ __forceinline__ void operator()(const f32x4 (&acc)[2][2][4][2], const Unit& u, int wr, int wc, int fr, int fq) const {
        const int row0 = u.orow + wr * 64 + fr, colt = u.pn * BM, col0 = colt + wc * 32 + 8 * fq;
        const float sc = (colt < scale_cols) ? scale0 : 1.f;
        const float* bp = bias ? bias + (size_t)u.e * bias_stride : nullptr;
        f32x4 bv[2][2];
#pragma unroll
        for (int bj = 0; bj < 2; ++bj)
#pragma unroll
            for (int n = 0; n < 2; ++n) bv[bj][n] = bp ? *(const f32x4*)(bp + col0 + bj * HALF + 4 * n) : (f32x4){0.f, 0.f, 0.f, 0.f};
#pragma unroll
        for (int ai = 0; ai < 2; ++ai)
#pragma unroll
            for (int m = 0; m < 4; ++m) { bf16_t* rowp = O + (size_t)(row0 + ai * HALF + m * 16) * ldc + col0;
#pragma unroll
                for (int bj = 0; bj < 2; ++bj) { f32x4 v0 = (acc[ai][bj][m][0] + bv[bj][0]) * sc, v1 = (acc[ai][bj][m][1] + bv[bj][1]) * sc;
                    u32x4 w; w.x = cvt_pk_bf16(v0[0], v0[1]); w.y = cvt_pk_bf16(v0[2], v0[3]); w.z = cvt_pk_bf16(v1[0], v1[1]); w.w = cvt_pk_bf16(v1[2], v1[3]);
                    *(u32x4*)(rowp + bj * HALF) = w; } }
    }
};
struct EpiVT {
    static constexpr bool PERM = false;
    bf16_t* O;
    __device__ __forceinline__ void operator()(const f32x4 (&acc)[2][2][4][2], const Unit& u, int wr, int wc, int fr, int fq) const {
        const int sfq = (fq == 1) ? 2 : ((fq == 2) ? 1 : fq);
        const int row0 = u.orow + wr * 64 + fr, col0 = u.pn * BM + wc * 32 + 4 * sfq;
#pragma unroll
        for (int ai = 0; ai < 2; ++ai)
#pragma unroll
            for (int m = 0; m < 4; ++m) { bf16_t* rowp = O + (size_t)(row0 + ai * HALF + m * 16) * T + col0;
#pragma unroll
                for (int bj = 0; bj < 2; ++bj)
#pragma unroll
                    for (int n = 0; n < 2; ++n) { const f32x4 v = acc[ai][bj][m][n]; u32x2 w; w.x = cvt_pk_bf16(v[0], v[1]); w.y = cvt_pk_bf16(v[2], v[3]); *(u32x2*)(rowp + bj * HALF + n * 16) = w; } }
    }
};
struct EpiF32 {
    static constexpr bool PERM = false;
    float* O; int ldc;
    __device__ __forceinline__ void operator()(const f32x4 (&acc)[2][2][4][2], const Unit& u, int wr, int wc, int fr, int fq) const {
        const int row0 = u.orow + wr * 64 + fr, col0 = u.pn * BM + wc * 32 + 4 * fq;
#pragma unroll
        for (int ai = 0; ai < 2; ++ai)
#pragma unroll
            for (int m = 0; m < 4; ++m) { float* rowp = O + (size_t)(row0 + ai * HALF + m * 16) * ldc + col0;
#pragma unroll
                for (int bj = 0; bj < 2; ++bj)
#pragma unroll
                    for (int n = 0; n < 2; ++n) *(f32x4*)(rowp + bj * HALF + n * 16) = acc[ai][bj][m][n]; }
    }
};
struct EpiAct {
    static constexpr bool PERM = true;
    unsigned char* O; const float* b1;
    __device__ __forceinline__ void operator()(const f32x4 (&acc)[2][2][4][2], const Unit& u, int wr, int wc, int fr, int fq) const {
        const int row0 = u.orow + wr * 64 + fr, j0 = u.pn * HALF + wc * 32 + 8 * fq;
        const float* bp = b1 + (size_t)u.e * 2048;
        f32x4 bg[2], bl[2];
#pragma unroll
        for (int n = 0; n < 2; ++n) { bg[n] = *(const f32x4*)(bp + j0 + 4 * n); bl[n] = *(const f32x4*)(bp + 1024 + j0 + 4 * n); }
#pragma unroll
        for (int ai = 0; ai < 2; ++ai)
#pragma unroll
            for (int m = 0; m < 4; ++m) { unsigned char* rowp = O + (size_t)(row0 + ai * HALF + m * 16) * 1024 + j0;
                float o[8];
#pragma unroll
                for (int n = 0; n < 2; ++n)
#pragma unroll
                    for (int q = 0; q < 4; ++q) { float g = acc[ai][0][m][n][q] + bg[n][q], l = acc[ai][1][m][n][q] + bl[n][q];
                        g = fminf(g, 7.0f); l = fminf(fmaxf(l, -7.0f), 7.0f);
                        o[n * 4 + q] = g * (1.0f / (1.0f + __builtin_amdgcn_exp2f(-1.702f * LOG2E * g))) * (l + 1.0f); }
                int w0 = 0, w1 = 0;
                w0 = __builtin_amdgcn_cvt_pk_fp8_f32(o[0], o[1], w0, false); w0 = __builtin_amdgcn_cvt_pk_fp8_f32(o[2], o[3], w0, true);
                w1 = __builtin_amdgcn_cvt_pk_fp8_f32(o[4], o[5], w1, false); w1 = __builtin_amdgcn_cvt_pk_fp8_f32(o[6], o[7], w1, true);
                u32x2 w; w.x = (unsigned)w0; w.y = (unsigned)w1; *(u32x2*)rowp = w; }
    }
};

__device__ __forceinline__ void mfma_fp8(f32x4& acc, const i32x8 w, const i32x8 x, int sw, int sx) {
    asm volatile("s_nop 1\n\tv_mfma_scale_f32_16x16x128_f8f6f4 %0, %1, %2, %0, %3, %4 op_sel_hi:[0,0,0]" : "+v"(acc) : "v"(w), "v"(x), "v"(sw), "v"(sx));
}
template <class Epi, class Sched, bool ALIGN_EPI, bool FP8 = false>
__device__ __forceinline__ void gemm_phase(LAS unsigned char* lds, const char* wsb, const int tid0, const Sched& S, const Epi& E) {
    Unit cur, nxt; int ui = 0;
    if (!S.next(0, cur, tid0)) return;
    int tid = tid0; asm volatile("" : "+v"(tid));
    const int wid = __builtin_amdgcn_readfirstlane(tid >> 6), lane = tid & 63, wr = wid >> 2, wc = wid & 3, fr = lane & 15, fq = lane >> 4;
    constexpr int ROWB = FP8 ? KD : KD * 2, nt = ROWB / (BK * 2);
    unsigned voffB[2];
    { int R0, C0, R1, C1; stage_rc(tid * 16, R0, C0); stage_rc(tid * 16 + 8192, R1, C1);
      const int Rb0 = Epi::PERM ? ((R0 & ~31) + perm32(R0 & 31)) : R0, Rb1 = Epi::PERM ? ((R1 & ~31) + perm32(R1 & 31)) : R1;
      voffB[0] = (unsigned)(Rb0 * ROWB + C0 * 2); voffB[1] = (unsigned)(Rb1 * ROWB + C1 * 2); }
    constexpr unsigned kstep = (unsigned)(BK * 2);
    constexpr unsigned hstep = (unsigned)HALF * ROWB;
    const unsigned ldsw = (unsigned)wid * 1024u;
    const int aoff = lds_byte(wr * 64 + fr, fq * 8), boff = lds_byte(wc * 32 + fr, fq * 8);
#define PG8_SA(b, h) (((b) * 2 + (h)) * HTB)
#define PG8_SB(b, h) ((4 + (b) * 2 + (h)) * HTB)
#define PG8_GLDS(gp, lp) __builtin_amdgcn_global_load_lds((const unsigned*)(gp), (LAS unsigned*)(lp), 16, 0, 0)
#define PG8_STB(bufoff, gbase) do { PG8_GLDS(wsb + (size_t)((gbase) + voffB[0]), lds + (bufoff) + ldsw); PG8_GLDS(wsb + (size_t)((gbase) + voffB[1]), lds + (bufoff) + ldsw + 8192); } while (0)
#define PG8_STA(bufoff, gbase, v0, v1) do { PG8_GLDS(wsb + (size_t)((gbase) + (v0)), lds + (bufoff) + ldsw); PG8_GLDS(wsb + (size_t)((gbase) + (v1)), lds + (bufoff) + ldsw + 8192); } while (0)
#define PG8_LDA(dst, b, h) do { _Pragma("unroll") for (int m = 0; m < 4; ++m) _Pragma("unroll") for (int k = 0; k < 2; ++k) dst[m][k] = *(const LAS bf16x8*)(lds + PG8_SA(b, h) + aoff + m * 2048 + k * 1024); } while (0)
#define PG8_LDB(dst, b, h) do { _Pragma("unroll") for (int n = 0; n < 2; ++n) _Pragma("unroll") for (int k = 0; k < 2; ++k) dst[n][k] = *(const LAS bf16x8*)(lds + PG8_SB(b, h) + boff + n * 2048 + k * 1024); } while (0)
#define PG8_CAT(x) __builtin_bit_cast(i32x8, __builtin_shufflevector(__builtin_bit_cast(i32x4, x[0]), __builtin_bit_cast(i32x4, x[1]), 0, 1, 2, 3, 4, 5, 6, 7))
#define PG8_MMA(ai, bj, At, Bt) do { __builtin_amdgcn_s_setprio(1); _Pragma("unroll") for (int m = 0; m < 4; ++m) _Pragma("unroll") for (int n = 0; n < 2; ++n) { \
        if constexpr (FP8) mfma_fp8(acc[ai][bj][m][n], PG8_CAT(Bt[n]), PG8_CAT(At[m]), sc_w, sc_x); \
        else { _Pragma("unroll") for (int k = 0; k < 2; ++k) acc[ai][bj][m][n] = __builtin_amdgcn_mfma_f32_16x16x32_bf16(Bt[n][k], At[m][k], acc[ai][bj][m][n], 0, 0, 0); } } __builtin_amdgcn_s_setprio(0); } while (0)
#define PG8_WAIT_V(n) asm volatile("s_waitcnt vmcnt(" #n ")" ::: "memory")
#define PG8_WAIT_L(n) asm volatile("s_waitcnt lgkmcnt(" #n ")" ::: "memory")
#define PG8_BAR __builtin_amdgcn_s_barrier()
#define PG8_SCHED __builtin_amdgcn_sched_barrier(0)
    f32x4 acc[2][2][4][2];
#pragma unroll
    for (int a = 0; a < 2; ++a)
#pragma unroll
        for (int b = 0; b < 2; ++b)
#pragma unroll
            for (int m = 0; m < 4; ++m)
#pragma unroll
                for (int n = 0; n < 2; ++n) acc[a][b][m][n] = (f32x4){0.f, 0.f, 0.f, 0.f};
    bf16x8 At[4][2], B0[2][2], B1[2][2];
    const int sc_w = 122, sc_x = 127;
    unsigned cA = cur.A, cB = cur.B;
    unsigned c00 = cur.va00, c01 = cur.va01, c10 = cur.va10, c11 = cur.va11;
    PG8_STB(PG8_SB(0, 0), cB); PG8_STB(PG8_SB(0, 1), cB + hstep); PG8_STA(PG8_SA(0, 0), cA, c00, c01); PG8_STA(PG8_SA(0, 1), cA, c10, c11);
    if (wr == 1) PG8_BAR;
    PG8_WAIT_V(2); PG8_BAR;
    PG8_STB(PG8_SB(1, 0), cB + kstep); PG8_STA(PG8_SA(1, 0), cA + kstep, c00, c01); PG8_STB(PG8_SB(1, 1), cB + hstep + kstep);
    PG8_WAIT_V(6); PG8_BAR;
    for (;;) {
        const bool has_next = S.next(ui + 1, nxt, tid);
        const unsigned nA = has_next ? nxt.A : cA, nB = has_next ? nxt.B : cB;
        { u32x4 pv; pv.x = has_next ? nxt.va00 : c00; pv.y = has_next ? nxt.va01 : c01; pv.z = has_next ? nxt.va10 : c10; pv.w = has_next ? nxt.va11 : c11; *(LAS u32x4*)(lds + VA_PARK_OFF + tid * 16) = pv; }
        for (int t = 0; t < nt; t += 2) {
            const bool last = (t == nt - 2);
            const unsigned a1 = cA + (unsigned)(t + 1) * kstep;
            const unsigned a2 = last ? nA : cA + (unsigned)(t + 2) * kstep, b2 = last ? nB : cB + (unsigned)(t + 2) * kstep;
            const unsigned a3 = a2 + kstep, b3 = b2 + kstep;
            unsigned s00 = c00, s01 = c01, s10 = c10, s11 = c11;
            if (last) { const u32x4 pv = *(const LAS u32x4*)(lds + VA_PARK_OFF + tid * 16); s00 = pv.x; s01 = pv.y; s10 = pv.z; s11 = pv.w; }
            PG8_LDB(B0, 0, 0); PG8_LDB(B1, 0, 1); PG8_SCHED; PG8_LDA(At, 0, 0); PG8_STA(PG8_SA(1, 1), a1, c10, c11);
            PG8_WAIT_V(8); PG8_WAIT_L(0); PG8_BAR; PG8_MMA(0, 0, At, B0); PG8_MMA(0, 1, At, B1); PG8_BAR; PG8_SCHED;
            PG8_LDA(At, 0, 1); PG8_STB(PG8_SB(0, 0), b2); PG8_STB(PG8_SB(0, 1), b2 + hstep); PG8_STA(PG8_SA(0, 0), a2, s00, s01);
            PG8_WAIT_V(8); PG8_WAIT_L(0); PG8_BAR; PG8_MMA(1, 0, At, B0); PG8_MMA(1, 1, At, B1); PG8_BAR; PG8_SCHED;
            PG8_LDB(B0, 1, 0); PG8_LDB(B1, 1, 1); PG8_SCHED; PG8_LDA(At, 1, 0); PG8_STA(PG8_SA(0, 1), a2, s10, s11);
            PG8_WAIT_V(8); PG8_WAIT_L(0); PG8_BAR; PG8_MMA(0, 0, At, B0); PG8_MMA(0, 1, At, B1); PG8_BAR; PG8_SCHED;
            PG8_LDA(At, 1, 1); PG8_STB(PG8_SB(1, 0), b3); PG8_STB(PG8_SB(1, 1), b3 + hstep); PG8_STA(PG8_SA(1, 0), a3, s00, s01);
            PG8_WAIT_V(8); PG8_WAIT_L(0); PG8_BAR; PG8_MMA(1, 0, At, B0); PG8_MMA(1, 1, At, B1); PG8_BAR; PG8_SCHED;
        }
        if constexpr (ALIGN_EPI) { if (wr == 0) PG8_BAR; }
        if constexpr (FP8) asm volatile("s_nop 15\n\ts_nop 15\n\ts_nop 15" ::: "memory");
        E(acc, cur, wr, wc, fr, fq);
        if (!has_next) break;
#pragma unroll
        for (int a = 0; a < 2; ++a)
#pragma unroll
            for (int b = 0; b < 2; ++b)
#pragma unroll
                for (int m = 0; m < 4; ++m)
#pragma unroll
                    for (int n = 0; n < 2; ++n) acc[a][b][m][n] = (f32x4){0.f, 0.f, 0.f, 0.f};
        cur = nxt; cA = nA; cB = nB; { const u32x4 pv = *(const LAS u32x4*)(lds + VA_PARK_OFF + tid * 16); c00 = pv.x; c01 = pv.y; c10 = pv.z; c11 = pv.w; } ++ui;
        if constexpr (ALIGN_EPI) { if (wr == 1) PG8_BAR; }
    }
    PG8_WAIT_V(0);
    if constexpr (!ALIGN_EPI) { if (wr == 0) PG8_BAR; }
    PG8_BAR;
#undef PG8_SA
#undef PG8_SB
#undef PG8_GLDS
#undef PG8_STB
#undef PG8_STA
#undef PG8_LDA
#undef PG8_LDB
#undef PG8_MMA
#undef PG8_CAT
#undef PG8_WAIT_V
#undef PG8_WAIT_L
#undef PG8_BAR
#undef PG8_SCHED
}
}

#define XB_TMO      128
#define XB_XCNT(j)  (256  + 64 * (j))
#define XB_XSUB(j)  (1280 + 64 * (j))
#define XB_XGEN(j)  (2304 + 64 * (j))
#define XB_TOP      3328
#define XB_TOPGEN   3392
#define XCD_BAR_WORDS 3456
#define XB_SPIN_CAP (1u << 22)
__device__ __forceinline__ unsigned xb_ld(unsigned* p)              { return __hip_atomic_load(p, __ATOMIC_RELAXED, __HIP_MEMORY_SCOPE_AGENT); }
__device__ __forceinline__ unsigned xb_add(unsigned* p, unsigned v) { return __hip_atomic_fetch_add(p, v, __ATOMIC_RELAXED, __HIP_MEMORY_SCOPE_AGENT); }
__device__ __forceinline__ unsigned xb_xcc_id() { return (unsigned)__builtin_amdgcn_s_getreg((3 << 11) | 20) & 0xFu; }
#define XB_SPIN(cond, bar) do { unsigned _sp = 0; while (cond) { __builtin_amdgcn_s_sleep(1); \
    if ((++_sp & 255u) == 0u) { if (xb_ld(&(bar)[XB_TMO])) break; if (_sp > XB_SPIN_CAP) { atomicAdd(&(bar)[XB_TMO], 1u); break; } } } } while (0)
struct XcdBarrier { unsigned* bar; unsigned x; volatile LAS unsigned* st; };
__device__ __forceinline__ XcdBarrier xcd_barrier_post(unsigned* bar, volatile LAS unsigned* st) {
    XcdBarrier b; b.bar = bar; b.x = xb_xcc_id(); b.st = st;
    if (threadIdx.x == 0) (void)xb_add(&bar[XB_XCNT(b.x)], 1u);
    return b;
}
__device__ __forceinline__ void xcd_barrier_complete(unsigned* bar, unsigned x, unsigned& nloc, unsigned& nx) {
    const unsigned G = gridDim.x * gridDim.y * gridDim.z;
    unsigned sum, cnt, mine, sp = 0u;
    for (;;) {
        sum = 0u; cnt = 0u; mine = 0u;
#pragma unroll 1
        for (unsigned j = 0; j < 16; ++j) { const unsigned c = xb_ld(&bar[XB_XCNT(j)]); sum += c; cnt += (c > 0u) ? 1u : 0u; mine = (j == x) ? c : mine; }
        if (sum == G) break;
        __builtin_amdgcn_s_sleep(1);
        if ((++sp & 255u) == 0u) { if (xb_ld(&bar[XB_TMO])) break; if (sp > XB_SPIN_CAP) { atomicAdd(&bar[XB_TMO], 1u); break; } }
    }
    nloc = mine > 0u ? mine : 1u; nx = cnt > 0u ? cnt : 1u;
}
__device__ __forceinline__ void xcd_barrier(const XcdBarrier& b) {
    asm volatile("s_waitcnt vmcnt(0)" ::: "memory");
    __syncthreads();
    if (threadIdx.x == 0) {
        unsigned* bar = b.bar;
        __builtin_amdgcn_s_waitcnt(0);
        unsigned nloc = b.st[0], nx = b.st[1];
        if (nloc == 0u) { xcd_barrier_complete(bar, b.x, nloc, nx); b.st[0] = nloc; b.st[1] = nx; }
        const unsigned old = xb_add(&bar[XB_XSUB(b.x)], 1u);
        const unsigned gen = old / nloc;
        if (old + 1u == (gen + 1u) * nloc) {
            __builtin_amdgcn_fence(__ATOMIC_RELEASE, "agent");
            asm volatile("s_waitcnt vmcnt(0)" ::: "memory");
            const unsigned og = xb_add(&bar[XB_TOP], 1u);
            const unsigned tg = og / nx;
            if (og + 1u == (tg + 1u) * nx) xb_add(&bar[XB_TOPGEN], 1u);
            else XB_SPIN(xb_ld(&bar[XB_TOPGEN]) == tg, bar);
            __builtin_amdgcn_fence(__ATOMIC_ACQUIRE, "agent");
            xb_add(&bar[XB_XGEN(b.x)], 1u);
            asm volatile("s_waitcnt vmcnt(0)" ::: "memory");
        } else {
            XB_SPIN(xb_ld(&bar[XB_XGEN(b.x)]) == gen, bar);
            __builtin_amdgcn_fence(__ATOMIC_ACQUIRE, "agent");
            asm volatile("s_waitcnt vmcnt(0)" ::: "memory");
        }
    }
    __syncthreads();
}

struct Args { const float* in[31]; float* out; unsigned char* ws; int ph_lo, ph_hi, probe, pad; };

struct Frame {
    LAS unsigned char* lds;
    int tid, lane, wave, G, bid;
    unsigned char* ws;
};
constexpr int PTAB_OFF = MISC_OFF + 3072;
struct InTab { LAS unsigned char* lds;
    __device__ __forceinline__ const float* operator[](int k) const {
        const LAS unsigned* p = (const LAS unsigned*)(lds + PTAB_OFF) + 2 * k;
        const unsigned lo = __builtin_amdgcn_readfirstlane(p[0]), hi = __builtin_amdgcn_readfirstlane(p[1]);
        return (const float*)(((unsigned long long)hi << 32) | lo); } };
struct ArgsV { InTab in; };
__device__ __forceinline__ Frame make_frame(LAS unsigned char* lds, unsigned char* ws) {
    Frame F; F.lds = lds;
    int tid = threadIdx.x; asm volatile("" : "+v"(tid));
    F.tid = tid; F.lane = tid & 63; F.wave = __builtin_amdgcn_readfirstlane(tid >> 6);
    F.G = gridDim.x; F.bid = blockIdx.x;
    unsigned long long w = (unsigned long long)ws; asm volatile("" : "+s"(w)); F.ws = (unsigned char*)w;
    return F;
}

__device__ __forceinline__ void transpose_item(const float* W, int N, bf16_t* WT, int k0, int n0, int drow0, LAS float* scr, int lane) {
    f32x4 v[16];
    const int lr = lane >> 4, lc = (lane & 15) * 4;
#pragma unroll
    for (int i = 0; i < 16; ++i) v[i] = __builtin_nontemporal_load((const f32x4*)(W + (size_t)(k0 + 4 * i + lr) * N + n0 + lc));
#pragma unroll
    for (int i = 0; i < 16; ++i) { LAS float* s = scr + (4 * i + lr) * 65 + lc; s[0] = v[i].x; s[1] = v[i].y; s[2] = v[i].z; s[3] = v[i].w; }
    LDS_WAIT(); asm volatile("" ::: "memory");
    const int c = lane & 7;
#pragma unroll
    for (int j = 0; j < 8; ++j) { const int n = (lane >> 3) + 8 * j; const LAS float* s = scr + (8 * c) * 65 + n;
        u32x4 o; o.x = pk2(s[0 * 65], s[1 * 65]); o.y = pk2(s[2 * 65], s[3 * 65]); o.z = pk2(s[4 * 65], s[5 * 65]); o.w = pk2(s[6 * 65], s[7 * 65]);
        *(u32x4*)(WT + (size_t)(drow0 + n) * KD + k0 + 8 * c) = o; }
    LDS_WAIT(); asm volatile("" ::: "memory");
}
__device__ __forceinline__ void transpose_item_fp8(const float* W, int N, unsigned char* WT, int k0, int n0, int drow0, LAS float* scr, int lane) {
    f32x4 v[16];
    const int lr = lane >> 3, lc = (lane & 7) * 4;
#pragma unroll
    for (int i = 0; i < 16; ++i) v[i] = __builtin_nontemporal_load((const f32x4*)(W + (size_t)(k0 + 8 * i + lr) * N + n0 + lc));
#pragma unroll
    for (int i = 0; i < 16; ++i) { LAS float* s = scr + (8 * i + lr) * 33 + lc; s[0] = v[i].x; s[1] = v[i].y; s[2] = v[i].z; s[3] = v[i].w; }
    LDS_WAIT(); asm volatile("" ::: "memory");
#pragma unroll
    for (int j = 0; j < 4; ++j) { const int id = lane + 64 * j, n = id >> 3, kc = id & 7; const LAS float* s = scr + (16 * kc) * 33 + n;
        int o[4];
#pragma unroll
        for (int q = 0; q < 4; ++q) { int w8 = 0;
            w8 = __builtin_amdgcn_cvt_pk_fp8_f32(32.f * s[(4 * q + 0) * 33], 32.f * s[(4 * q + 1) * 33], w8, false);
            w8 = __builtin_amdgcn_cvt_pk_fp8_f32(32.f * s[(4 * q + 2) * 33], 32.f * s[(4 * q + 3) * 33], w8, true); o[q] = w8; }
        u32x4 ov; ov.x = (unsigned)o[0]; ov.y = (unsigned)o[1]; ov.z = (unsigned)o[2]; ov.w = (unsigned)o[3];
        *(u32x4*)(WT + (size_t)(drow0 + n) * KD + k0 + 16 * kc) = ov; }
    LDS_WAIT(); asm volatile("" ::: "memory");
}
__device__ __forceinline__ void ln_store(f32x4 (&v)[4], const float* g, const float* b, float* of32, bf16_t* obf, int lane, unsigned char* of8 = nullptr) {
    float s = 0.f;
#pragma unroll
    for (int j = 0; j < 4; ++j) s += (v[j].x + v[j].y) + (v[j].z + v[j].w);
    const float mean = wave_sum(s, lane << 2) * (1.f / D); float s2 = 0.f;
#pragma unroll
    for (int j = 0; j < 4; ++j) { v[j] = v[j] - mean; s2 += (v[j].x * v[j].x + v[j].y * v[j].y) + (v[j].z * v[j].z + v[j].w * v[j].w); }
    const float rstd = __builtin_amdgcn_rsqf(wave_sum(s2, lane << 2) * (1.f / D) + LN_EPS);
#pragma unroll
    for (int j = 0; j < 4; ++j) {
        const f32x4 gv = *(const f32x4*)(g + 4 * lane + 256 * j), bv = *(const f32x4*)(b + 4 * lane + 256 * j);
        const f32x4 o = v[j] * rstd * gv + bv;
        if (of32) *(f32x4*)(of32 + 4 * lane + 256 * j) = o;
        if (obf) { u32x2 w; w.x = pk2(o.x, o.y); w.y = pk2(o.z, o.w); *(u32x2*)(obf + 4 * lane + 256 * j) = w; }
        if (of8) { int w8 = 0; w8 = __builtin_amdgcn_cvt_pk_fp8_f32(o.x, o.y, w8, false); w8 = __builtin_amdgcn_cvt_pk_fp8_f32(o.z, o.w, w8, true); *(int*)(of8 + 4 * lane + 256 * j) = w8; }
    }
}

__device__ __forceinline__ void phase_prologue(Frame& F, const ArgsV& A_) {
    LAS float* scr = (LAS float*)(F.lds + F.wave * 16896);
    const int gw = F.bid * NWAVES + F.wave, NGW = F.G * NWAVES;
    bf16_t* WINT = (bf16_t*)(F.ws + WS_WINT); bf16_t* WOUTT = (bf16_t*)(F.ws + WS_WOUTT); unsigned char* W1T = (unsigned char*)(F.ws + WS_W1T); unsigned char* W2T = (unsigned char*)(F.ws + WS_W2T);
    constexpr int I_IN = NL * 16 * 40, I_OUT = NL * 16 * 16, I_W1 = NL * NE * 8 * 64, I_W2 = NL * NE * 8 * 32;
    const float* w_in = A_.in[3]; const float* w_out = A_.in[20]; const float* w1 = A_.in[25]; const float* w2 = A_.in[27];
    for (int it = gw; it < I_IN + I_OUT + I_W1 + I_W2; it += NGW) {
        int r = it;
        if (r < I_W1) { const int le = r / (8 * 64), q = r % (8 * 64), kb = q / 64, nb = q % 64, n0 = nb * 32;
            const int drow = (n0 < 1024) ? ((n0 >> 7) * 256 + (n0 & 127)) : (((n0 - 1024) >> 7) * 256 + 128 + ((n0 - 1024) & 127));
            transpose_item_fp8(w1 + (size_t)le * 1024 * 2048, 2048, W1T + (size_t)le * 2048 * 1024, kb * 128, n0, drow, scr, F.lane); continue; }
        r -= I_W1;
        if (r < I_W2) { const int le = r / (8 * 32), q = r % (8 * 32), kb = q / 32, nb = q % 32;
            transpose_item_fp8(w2 + (size_t)le * 1024 * 1024, 1024, W2T + (size_t)le * 1024 * 1024, kb * 128, nb * 32, nb * 32, scr, F.lane); continue; }
        r -= I_W2;
        if (r < I_IN) { const int l = r / (16 * 40), q = r % (16 * 40), kb = q / 40, nb = q % 40, n0 = nb * 64;
            const int drow = (n0 < 1024) ? n0 : ((n0 < 1536) ? (2048 + n0 - 1024) : (n0 - 512));
            transpose_item(w_in + (size_t)l * 1024 * 2560, 2560, WINT + (size_t)l * 2560 * 1024, kb * 64, n0, drow, scr, F.lane); continue; }
        r -= I_IN;
        { const int l = r / (16 * 16), q = r % (16 * 16), kb = q / 16, nb = q % 16;
            transpose_item(w_out + (size_t)l * 1024 * 1024, 1024, WOUTT + (size_t)l * 1024 * 1024, kb * 64, nb * 64, nb * 64, scr, F.lane); }
    }
    float* HA = (float*)(F.ws + WS_HA); bf16_t* XB = (bf16_t*)(F.ws + WS_XB);
    for (int m = gw; m < T; m += NGW) {
        f32x4 v[4];
#pragma unroll
        for (int j = 0; j < 4; ++j) v[j] = *(const f32x4*)(A_.in[0] + (size_t)m * D + 4 * F.lane + 256 * j);
        ln_store(v, A_.in[1], A_.in[2], HA + (size_t)m * D, XB + (size_t)m * D, F.lane);
    }
}

constexpr int P2_KP = VA_PARK_OFF;
constexpr int P2_ORD = MISC_OFF + 1024;
constexpr int P2_FLG = MISC_OFF + 2304;
constexpr int CW_QUEUE = 20480;
constexpr size_t WS_KN = 768 * MiB + 512 * 1024;


constexpr int SEGT = 32, N_UNSPLIT = 400, N_SPLIT = 560, N_ITEMS = N_UNSPLIT + N_SPLIT;
struct ItemTabs { unsigned short item[1024]; unsigned short order[1024]; unsigned short segstart[128]; };
constexpr int west_of(int h) { return h == 0 ? 6 : (h == 1 ? 14 : (h == 2 ? 46 : 1000)); }
constexpr ItemTabs make_item_tabs() {
    ItemTabs t{}; int cost[1024] = {};
    for (int i = 0; i < 1024; ++i) { t.item[i] = 0; t.order[i] = 0; }
    for (int i = 0; i < 384; ++i) { const int h = i >> 7, qb = i & 127; t.item[i] = (unsigned short)(h | (qb << 2)); const int c = 2 * qb + 2; cost[i] = c < west_of(h) ? c : west_of(h); }
    for (int i = 384; i < 400; ++i) { const int qb = i - 384; t.item[i] = (unsigned short)(3 | (qb << 2)); cost[i] = 2 * qb + 2; }
    int n = 400;
    for (int qb = 0; qb < 128; ++qb) { t.segstart[qb] = (unsigned short)(n - 400);
        if (qb >= 16) { const int ns = (qb + 16) >> 4; for (int s = 0; s < ns; ++s) { t.item[n] = (unsigned short)(3 | (qb << 2) | (s << 9) | 0x8000); const int rem = 2 * qb + 2 - SEGT * s; cost[n] = rem < SEGT ? rem : SEGT; ++n; } } }
    int k = 0;
    for (int c = 64; c >= 1; --c) for (int i = 0; i < n; ++i) if (cost[i] == c) t.order[k++] = (unsigned short)i;
    return t;
}
__device__ const ItemTabs g_tabs = make_item_tabs();
constexpr size_t WS_PART = WS_END;
constexpr size_t PART_WAVE = 16896, PART_SLOT = 8 * PART_WAVE;
constexpr size_t WS_XB8 = ((WS_PART + (size_t)N_SPLIT * PART_SLOT + MiB) / MiB) * MiB;
constexpr size_t WS_END2 = WS_XB8 + 17 * MiB;

namespace attn {
__device__ __forceinline__ int crow(int r, int hi) { return (r & 3) + 8 * (r >> 2) + 4 * hi; }
__device__ __forceinline__ int swz(int row, int chunk) { return row * 128 + ((chunk ^ ((row >> 1) & 7)) << 4); }
#define MFMA32(a, b, c) __builtin_amdgcn_mfma_f32_32x32x16_bf16(a, b, c, 0, 0, 0)

__device__ __forceinline__ void attn_finish(LAS unsigned char* lds, f32x16 (&O)[4], float lsum, bf16_t* MIX, const float* subg, float lam, float outscale, int h, int rowmin, int c, int rg, int lane) {
    const int ln = lane & 31, hi = lane >> 5;
    const float ltot = lsum + shx(lsum, lane << 2, 32);
    LAS float* ex = (LAS float*)lds;
    if (c == 1) {
        const float sc = lam / ltot;
#pragma unroll
        for (int db = 0; db < 4; ++db)
#pragma unroll
            for (int r = 0; r < 16; ++r) ex[(rg * 64 + db * 16 + r) * 64 + lane] = O[db][r] * sc;
    }
    __syncthreads();
    if (c == 0) {
        const float inv = 1.0f / ltot; float ss = 0.f;
#pragma unroll
        for (int db = 0; db < 4; ++db)
#pragma unroll
            for (int r = 0; r < 16; ++r) { const float o = O[db][r] * inv - ex[(rg * 64 + db * 16 + r) * 64 + lane]; O[db][r] = o; ss += o * o; }
        ss += shx(ss, lane << 2, 32);
        const float rn = __builtin_amdgcn_rsqf(ss * (1.0f / 128.0f) + LN_EPS) * outscale;
        bf16_t* op = MIX + (size_t)(rowmin + ln) * 1024 + h * 128 + 4 * hi;
#pragma unroll
        for (int db = 0; db < 4; ++db)
#pragma unroll
            for (int g = 0; g < 4; ++g) { const int dv0 = 32 * db + 8 * g;
                const f32x4 gv = *(const f32x4*)(subg + dv0 + 4 * hi);
                u32x2 wv; wv.x = cvt_pk_bf16(O[db][4 * g + 0] * rn * gv.x, O[db][4 * g + 1] * rn * gv.y); wv.y = cvt_pk_bf16(O[db][4 * g + 2] * rn * gv.z, O[db][4 * g + 3] * rn * gv.w);
                *(u32x2*)(op + dv0) = wv; }
    }
    __syncthreads();
}
__device__ __forceinline__ void attn_unit(LAS unsigned char* lds, const unsigned char* wsb, bf16_t* MIX, const float* subg, float lam, float outscale, int h, int qb, int jt_top, int jt_bot, float* part, const int tid) {
    const int w = __builtin_amdgcn_readfirstlane(tid >> 6), lane = tid & 63, ln = lane & 31, hi = lane >> 5;
    const int c = w >> 2, rg = w & 3;
    const int i0 = qb * 128, rowmin = i0 + 32 * rg;
    const float slope2 = __builtin_amdgcn_exp2f(-2.0f * (float)(h + 1)) * LOG2E;
    const LAS float* kp = (const LAS float*)(lds + P2_KP) + (h * 2 + c) * 256;
    volatile LAS unsigned* flg = (volatile LAS unsigned*)(lds + P2_FLG);
    const bf16_t* U = (const bf16_t*)(wsb + WS_U);
    bf16x8 Qf[4];
    { const bf16_t* qp = U + (size_t)(rowmin + ln) * NCOLA + UQ + h * 128 + c * 64 + 8 * hi;
#pragma unroll
      for (int ks = 0; ks < 4; ++ks) Qf[ks] = *(const bf16x8*)(qp + 16 * ks); }
    float qn;
    { float ss = 0.f;
#pragma unroll
      for (int ks = 0; ks < 4; ++ks)
#pragma unroll
          for (int j = 0; j < 8; ++j) { const float v = bf2f((bf16_t)Qf[ks][j]); ss += v * v; }
      ss += shx(ss, lane << 2, 32); qn = fsqrt(ss) * 1.001f; }
    float mlb;
    { const bf16_t* kd = U + (size_t)(rowmin + ln) * NCOLA + UK + h * 128 + c * 64 + 8 * hi; float dd = 0.f;
#pragma unroll
        for (int ks = 0; ks < 4; ++ks) { const bf16x8 kv = *(const bf16x8*)(kd + 16 * ks);
#pragma unroll
            for (int j = 0; j < 8; ++j) dd += bf2f((bf16_t)Qf[ks][j]) * bf2f((bf16_t)kv[j]); }
        dd += shx(dd, lane << 2, 32); mlb = dd + slope2 * (float)(rowmin + ln - i0) - 0.01f; }
    unsigned kso0, kso1, vso0, vso1;
    { const int r8 = lane >> 3, cp = lane & 7;
      { const int key = 8 * ((2 * w) & 7) + r8, ch = cp ^ ((key >> 1) & 7); kso0 = (unsigned)WS_U + (unsigned)(key * NCOLA + UK + h * 128 + c * 64 + ch * 8) * 2u; }
      { const int key = 8 * ((2 * w + 1) & 7) + r8, ch = cp ^ ((key >> 1) & 7); kso1 = (unsigned)WS_U + (unsigned)(key * NCOLA + UK + h * 128 + c * 64 + ch * 8) * 2u; }
      { const int dv = 8 * (2 * w) + r8, ch = cp ^ ((dv >> 1) & 7); vso0 = (unsigned)WS_VT + (unsigned)((h * 128 + dv) * T + ch * 8) * 2u; }
      { const int dv = 8 * (2 * w + 1) + r8, ch = cp ^ ((dv >> 1) & 7); vso1 = (unsigned)WS_VT + (unsigned)((h * 128 + dv) * T + ch * 8) * 2u; } }
    int o4[4];
#pragma unroll
    for (int j = 0; j < 4; ++j) o4[j] = ln * 128 + (((2 * j + hi) ^ ((ln >> 1) & 7)) << 4);
    bf16x8 KA0, KA1;
    { u32x4 a0 = (u32x4){0u, 0u, 0u, 0u}, a1 = a0;
      if (hi == 0) { const float b0f = slope2 * (float)ln, b1f = slope2 * (float)(ln + 32);
          const unsigned h0 = cvt_pk_bf16(b0f, 0.f) & 0xffffu, h1 = cvt_pk_bf16(b1f, 0.f) & 0xffffu;
          a0.x = cvt_pk_bf16(b0f, b0f - bflo(h0)); a0.y = 0x3F803F80u; a1.x = cvt_pk_bf16(b1f, b1f - bflo(h1)); a1.y = 0x3F803F80u; }
      KA0 = __builtin_bit_cast(bf16x8, a0); KA1 = __builtin_bit_cast(bf16x8, a1); }
    f32x16 O[4];
#pragma unroll
    for (int db = 0; db < 4; ++db)
#pragma unroll
        for (int r = 0; r < 16; ++r) O[db][r] = 0.f;
    float m = mlb, lsum = 0.f, al_pend = 1.0f;
    const int jt_hi = jt_top;
#define AB(t) (((jt_hi - (t)) & 3) * 32768)
#define A_GLDS(gp, lp) __builtin_amdgcn_global_load_lds((const unsigned*)(gp), (LAS unsigned*)(lp), 16, 0, 0)
#define A_GL(t) do { const unsigned kb_ = (unsigned)(t) * (unsigned)(64 * NCOLA * 2), vb_ = (unsigned)(t) * 128u; LAS unsigned char* d_ = lds + AB(t) + w * 2048; \
        A_GLDS(wsb + (size_t)(kso0 + kb_), d_); A_GLDS(wsb + (size_t)(kso1 + kb_), d_ + 1024); A_GLDS(wsb + (size_t)(vso0 + vb_), d_ + 16384); A_GLDS(wsb + (size_t)(vso1 + vb_), d_ + 16384 + 1024); } while (0)
#define A_BAR() do { asm volatile("s_waitcnt lgkmcnt(0)" ::: "memory"); __builtin_amdgcn_s_barrier(); asm volatile("" ::: "memory"); } while (0)
#define SB0 __builtin_amdgcn_sched_barrier(0)
#define A_VLD(dst, b_, db) do { _Pragma("unroll") for (int g = 0; g < 4; ++g) dst[g] = *(const LAS bf16x8*)((b_) + o4[g] + (db) * 4096); } while (0)
#define A_VMM(srcf, db) do { _Pragma("unroll") for (int g = 0; g < 4; ++g) O[db] = MFMA32(srcf[g], Pf[g], O[db]); } while (0)
#define A_QA(t) bf16x8 QA_; { float sl_ = slope2; asm volatile("" : "+v"(sl_)); const float c_ = __builtin_fmaf(sl_, (float)((t) * 64 - i0), -m); \
        const unsigned ch_ = cvt_pk_bf16(c_, 0.f) & 0xffffu; u32x4 q_ = (u32x4){0u, 0u, 0u, 0u}; \
        if (hi == 0) { q_.x = 0x3F803F80u; q_.y = cvt_pk_bf16(c_, c_ - bflo(ch_)); } QA_ = __builtin_bit_cast(bf16x8, q_); }
#define A_QKMM() do { f32x16 z_; _Pragma("unroll") for (int r = 0; r < 16; ++r) z_[r] = 0.f; s0 = MFMA32(KA0, QA_, z_); s1 = MFMA32(KA1, QA_, z_); \
        _Pragma("unroll") for (int ks = 0; ks < 4; ++ks) { s0 = MFMA32(FA[ks], Qf[ks], s0); s1 = MFMA32(FB[ks], Qf[ks], s1); } } while (0)
#define A_MASK(t) do { const int j0_ = (t) * 64; if (j0_ + 63 > rowmin) { int lz_ = lane; asm volatile("" : "+v"(lz_)); const int qrow_ = rowmin + (lz_ & 31), hz_ = lz_ >> 5; \
            _Pragma("unroll") for (int r = 0; r < 16; ++r) { const int key_ = j0_ + crow(r, hz_); if (key_ > qrow_) s0[r] = -30000.0f; if (key_ + 32 > qrow_) s1[r] = -30000.0f; } } } while (0)
#define A_SM_EXP(sv) _Pragma("unroll") for (int r = 0; r < 16; ++r) sv[r] = __builtin_amdgcn_exp2f(sv[r]);
#define A_SM_FIN() float ps_ = vadd(s0[0], s1[0]), pt_ = vadd(s0[1], s1[1]); \
        _Pragma("unroll") for (int r = 2; r < 16; r += 2) { ps_ = vadd(ps_, s0[r]); pt_ = vadd(pt_, s0[r + 1]); ps_ = vadd(ps_, s1[r]); pt_ = vadd(pt_, s1[r + 1]); } \
        ps_ = vadd(ps_, pt_); float al_ = 1.0f; \
        if (__any(ps_ > 1048576.0f)) {       \
            float mxp_ = s0[0]; _Pragma("unroll") for (int r = 0; r < 16; ++r) mxp_ = fmaxf(mxp_, fmaxf(s0[r], s1[r])); \
            mxp_ = fmaxf(mxp_, shx(mxp_, lane << 2, 32)); \
            const float d_ = fmaxf(__builtin_floorf(__builtin_amdgcn_logf(fmaxf(mxp_, 1.0f))), 0.f); al_ = __builtin_amdgcn_exp2f(-d_); m += d_; ps_ *= al_; \
            _Pragma("unroll") for (int r = 0; r < 16; ++r) { s0[r] *= al_; s1[r] *= al_; } } \
        al_pend = al_; lsum = __builtin_fmaf(lsum, al_, ps_); \
        _Pragma("unroll") for (int s2 = 0; s2 < 2; ++s2) { u32x4 a_, b2_; \
            a_.x = cvt_pk_bf16(s0[8 * s2 + 0], s0[8 * s2 + 1]); a_.y = cvt_pk_bf16(s0[8 * s2 + 2], s0[8 * s2 + 3]); a_.z = cvt_pk_bf16(s0[8 * s2 + 4], s0[8 * s2 + 5]); a_.w = cvt_pk_bf16(s0[8 * s2 + 6], s0[8 * s2 + 7]); \
            b2_.x = cvt_pk_bf16(s1[8 * s2 + 0], s1[8 * s2 + 1]); b2_.y = cvt_pk_bf16(s1[8 * s2 + 2], s1[8 * s2 + 3]); b2_.z = cvt_pk_bf16(s1[8 * s2 + 4], s1[8 * s2 + 5]); b2_.w = cvt_pk_bf16(s1[8 * s2 + 6], s1[8 * s2 + 7]); \
            Pf[s2] = __builtin_bit_cast(bf16x8, a_); Pf[2 + s2] = __builtin_bit_cast(bf16x8, b2_); }
#define A_FUSED(t) do { const LAS unsigned char* kb3_ = lds + AB((t) - 1) + c * 8192; const LAS unsigned char* vb2_ = lds + AB(t) + 16384; \
        A_QA((t) - 1); A_VLD(FA, kb3_, 0); A_VLD(FB, kb3_, 1); SB0; \
        A_QKMM(); \
        A_VLD(FA, vb2_, 0); A_VLD(FB, vb2_, 1); SB0; \
        A_VMM(FA, 0); A_MASK((t) - 1); A_VLD(FA, vb2_, 2); SB0; \
        A_VMM(FB, 1); A_SM_EXP(s0); A_VLD(FB, vb2_, 3); SB0; \
        A_VMM(FA, 2); A_SM_EXP(s1); SB0; \
        A_VMM(FB, 3); A_SM_FIN(); SB0; } while (0)
    A_GL(jt_hi); A_GL(jt_hi - 1);
    if (jt_hi - 2 >= jt_bot) { A_GL(jt_hi - 2); asm volatile("s_waitcnt vmcnt(4)" ::: "memory"); } else asm volatile("s_waitcnt vmcnt(0)" ::: "memory");
    A_BAR();
    bool skip = false;
    bf16x8 Pf[4], FA[4], FB[4];
    f32x16 s0, s1;
    {
        const LAS unsigned char* kb3_ = lds + AB(jt_hi) + c * 8192;
        A_QA(jt_hi); A_VLD(FA, kb3_, 0); A_VLD(FB, kb3_, 1);
        A_QKMM();
        A_MASK(jt_hi); A_SM_EXP(s0); A_SM_EXP(s1); A_SM_FIN();
    }
    int jt = jt_hi;
    for (; jt > jt_bot; --jt) {
        const int cur = (jt_hi - jt) & 1;
        if (jt - 3 >= jt_bot) A_GL(jt - 3);
        bool done = false;
        if (!skip) {
            if (__any(al_pend != 1.0f)) {
#pragma unroll
                for (int db = 0; db < 4; ++db)
#pragma unroll
                    for (int r = 0; r < 16; ++r) O[db][r] *= al_pend;
            }
            al_pend = 1.0f;
            const float bnd = qn * kp[jt - 1] - m + slope2 * (float)((jt - 1) * 64 + 63 - i0);
            done = __all(bnd < -48.0f);
            A_FUSED(jt);
        }
        skip = skip || done;
        if (lane == 0) flg[cur * 8 + w] = skip ? 1u : 0u;
        if (jt - 3 >= jt_bot) asm volatile("s_waitcnt vmcnt(4)" ::: "memory"); else asm volatile("s_waitcnt vmcnt(0)" ::: "memory");
        A_BAR();
        { const u32x4 f0 = *(const LAS u32x4*)(lds + P2_FLG + cur * 32), f1 = *(const LAS u32x4*)(lds + P2_FLG + cur * 32 + 16);
          if ((f0.x & f0.y & f0.z & f0.w & f1.x & f1.y & f1.z & f1.w) != 0u) break; }
    }
    if (!skip) {
        if (__any(al_pend != 1.0f)) {
#pragma unroll
            for (int db = 0; db < 4; ++db)
#pragma unroll
                for (int r = 0; r < 16; ++r) O[db][r] *= al_pend;
        }
        const LAS unsigned char* vb2_ = lds + AB(jt_bot) + 16384;
        A_VLD(FA, vb2_, 0); A_VLD(FB, vb2_, 1); A_VMM(FA, 0); A_VLD(FA, vb2_, 2); A_VMM(FB, 1); A_VLD(FB, vb2_, 3); A_VMM(FA, 2); A_VMM(FB, 3);
    }
    asm volatile("s_waitcnt vmcnt(0)" ::: "memory");
    A_BAR();
#undef AB
#undef A_GLDS
#undef A_GL
#undef A_BAR
#undef SB0
#undef A_VLD
#undef A_VMM
#undef A_QA
#undef A_QKMM
#undef A_THR
#undef A_MASK
#undef A_SM_EXP
#undef A_SM_FIN
#undef A_FUSED
    if (part) {
        float* pw = part + (size_t)w * (PART_WAVE / 4);
#pragma unroll
        for (int db = 0; db < 4; ++db)
#pragma unroll
            for (int r = 0; r < 16; ++r) pw[(db * 16 + r) * 64 + lane] = O[db][r];
        pw[4096 + lane] = m; pw[4160 + lane] = lsum;
    } else attn_finish(lds, O, lsum, MIX, subg, lam, outscale, h, rowmin, c, rg, lane);
}
__device__ __forceinline__ void attn_combine(LAS unsigned char* lds, const unsigned char* wsb, bf16_t* MIX, const float* subg, float lam, float outscale, int qb, const int tid) {
    const int w = __builtin_amdgcn_readfirstlane(tid >> 6), lane = tid & 63, c = w >> 2, rg = w & 3;
    const int nseg = (qb + 16) >> 4, slot0 = g_tabs.segstart[qb];
    const float* pb = (const float*)(wsb + WS_PART) + (size_t)slot0 * (PART_SLOT / 4) + (size_t)w * (PART_WAVE / 4);
    float M = -__builtin_inff();
    for (int s = 0; s < nseg; ++s) M = fmaxf(M, pb[(size_t)s * (PART_SLOT / 4) + 4096 + lane]);
    f32x16 O[4];
#pragma unroll
    for (int db = 0; db < 4; ++db)
#pragma unroll
        for (int r = 0; r < 16; ++r) O[db][r] = 0.f;
    float lsum = 0.f;
    for (int s = 0; s < nseg; ++s) { const float* ps = pb + (size_t)s * (PART_SLOT / 4);
        const float sc = __builtin_amdgcn_exp2f(ps[4096 + lane] - M); lsum += sc * ps[4160 + lane];
#pragma unroll
        for (int db = 0; db < 4; ++db)
#pragma unroll
            for (int r = 0; r < 16; ++r) O[db][r] += sc * ps[(db * 16 + r) * 64 + lane]; }
    attn_finish(lds, O, lsum, MIX, subg, lam, outscale, 3, qb * 128 + 32 * rg, c, rg, lane);
}
#undef MFMA32
}

__device__ __forceinline__ void phase_knorm(Frame& F) {
    const bf16_t* U = (const bf16_t*)(F.ws + WS_U); float* KN = (float*)(F.ws + WS_KN);
    const int gw = F.bid * NWAVES + F.wave, NGW = F.G * NWAVES;
    for (int item = gw; item < 2048; item += NGW) {
        const int hc = item >> 8, jt = item & 255;
        const bf16_t* kr = U + (size_t)(jt * 64 + F.lane) * NCOLA + UK + hc * 64;
        float ss = 0.f;
#pragma unroll
        for (int q = 0; q < 8; ++q) { const u32x4 v = *(const u32x4*)(kr + 8 * q);
            ss += bflo(v.x) * bflo(v.x) + bfhi(v.x) * bfhi(v.x) + bflo(v.y) * bflo(v.y) + bfhi(v.y) * bfhi(v.y) + bflo(v.z) * bflo(v.z) + bfhi(v.z) * bfhi(v.z) + bflo(v.w) * bflo(v.w) + bfhi(v.w) * bfhi(v.w); }
#pragma unroll
        for (int o = 1; o < 64; o <<= 1) ss = fmaxf(ss, shx(ss, F.lane << 2, o));
        if (F.lane == 0) KN[item] = ss;
    }
}

__device__ __forceinline__ void lru_unit(Frame& F, const ArgsV& A_, int l, int unit) {
    const bf16_t* U = (const bf16_t*)(F.ws + WS_U);
    float* HLOC = (float*)(F.ws + WS_HLOC); float* CUMA = (float*)(F.ws + WS_CUMA); float* AGG = (float*)(F.ws + WS_AGG);
    const float* cw = A_.in[9] + l * 4 * 256; const float* cb = A_.in[10] + l * 256;
    const float* wa = A_.in[11] + l * 4 * 4096; const float* ba = A_.in[12] + l * 256;
    const float* wx = A_.in[13] + l * 4 * 4096; const float* bx = A_.in[14] + l * 256; const float* lamp = A_.in[15] + l * 256;
    LAS float* wA = (LAS float*)F.lds; LAS float* wX = wA + 4096; LAS float* xc = wA + 8192; LAS float* wagg = wA + 8192 + 16384;
    const int w = F.wave, d = F.lane;
    const int chunk = unit >> 2, blk = unit & 3, t0 = chunk * 256, ch0 = blk * 64;
    for (int i = F.tid; i < 1024; i += NTHREADS) { *(LAS f32x4*)(wA + 4 * i) = *(const f32x4*)(wa + blk * 4096 + 4 * i); *(LAS f32x4*)(wX + 4 * i) = *(const f32x4*)(wx + blk * 4096 + 4 * i); }
    {
      const int g8 = F.tid & 7, chb = ch0 + 8 * g8;
      f32x4 wv[4][2], bv[2];
#pragma unroll
      for (int j = 0; j < 4; ++j) { wv[j][0] = *(const f32x4*)(cw + j * 256 + chb); wv[j][1] = *(const f32x4*)(cw + j * 256 + chb + 4); }
      bv[0] = *(const f32x4*)(cb + chb); bv[1] = *(const f32x4*)(cb + chb + 4);
#pragma unroll
      for (int k = 0; k < 4; ++k) { const int t = (F.tid >> 3) + 64 * k, tt = t0 + t;
          f32x4 a0 = bv[0], a1 = bv[1];
#pragma unroll
          for (int j = 0; j < 4; ++j) { const int ts = tt - 3 + j;
              if (ts >= 0) { const u32x4 x = *(const u32x4*)(U + (size_t)ts * NCOLA + ULX + chb);
                  a0.x += wv[j][0].x * bflo(x.x); a0.y += wv[j][0].y * bfhi(x.x); a0.z += wv[j][0].z * bflo(x.y); a0.w += wv[j][0].w * bfhi(x.y);
                  a1.x += wv[j][1].x * bflo(x.z); a1.y += wv[j][1].y * bfhi(x.z); a1.z += wv[j][1].z * bflo(x.w); a1.w += wv[j][1].w * bfhi(x.w); } }
          *(LAS f32x4*)(xc + t * 64 + 8 * g8) = a0; *(LAS f32x4*)(xc + t * 64 + 8 * g8 + 4) = a1; } }
    __syncthreads();
    float ga[32], gx[32];
#pragma unroll
    for (int tt = 0; tt < 32; ++tt) { ga[tt] = 0.f; gx[tt] = 0.f; }
    for (int c4 = 0; c4 < 16; ++c4) {
        const float wa0 = wA[(4 * c4 + 0) * 64 + d], wa1 = wA[(4 * c4 + 1) * 64 + d], wa2 = wA[(4 * c4 + 2) * 64 + d], wa3 = wA[(4 * c4 + 3) * 64 + d];
        const float wx0 = wX[(4 * c4 + 0) * 64 + d], wx1 = wX[(4 * c4 + 1) * 64 + d], wx2 = wX[(4 * c4 + 2) * 64 + d], wx3 = wX[(4 * c4 + 3) * 64 + d];
#pragma unroll
        for (int tt = 0; tt < 32; ++tt) { const f32x4 x = *(const LAS f32x4*)(xc + (32 * w + tt) * 64 + 4 * c4);
            ga[tt] += x.x * wa0 + x.y * wa1 + x.z * wa2 + x.w * wa3; gx[tt] += x.x * wx0 + x.y * wx1 + x.z * wx2 + x.w * wx3; } }
    const int ch = ch0 + d; const float bav = ba[ch], bxv = bx[ch];
    const float sp = flog(1.0f + fexp(-lamp[ch]));
    float hl = 0.f, ca = 1.f;
#pragma unroll
    for (int tt = 0; tt < 32; ++tt) {
        const float sa = sigmoidf_(ga[tt] + bav), sx = sigmoidf_(gx[tt] + bxv);
        const float log_a = -8.0f * sa * sp, a = fexp(log_a), mult = fsqrt(fmaxf(1.0f - a * a, 0.f));
        const float b = mult * sx * xc[(32 * w + tt) * 64 + d];
        hl = a * hl + b; ca *= a; ga[tt] = hl; gx[tt] = ca;
    }
    wagg[(w * 2 + 0) * 64 + d] = ca; wagg[(w * 2 + 1) * 64 + d] = hl;
    __syncthreads();
    float cin = 0.f, cprod = 1.f;
    for (int w2 = 0; w2 < w; ++w2) { const float A2 = wagg[(w2 * 2 + 0) * 64 + d], B2 = wagg[(w2 * 2 + 1) * 64 + d]; cin = A2 * cin + B2; cprod *= A2; }
#pragma unroll
    for (int tt = 0; tt < 32; ++tt) { const size_t o = (size_t)(t0 + 32 * w + tt) * 256 + ch; const float hh = ga[tt] + gx[tt] * cin, cA = gx[tt] * cprod; HLOC[o] = hh; CUMA[o] = cA;
        if (w == 7 && tt == 31) { AGG[(chunk * 2 + 0) * 256 + ch] = cA; AGG[(chunk * 2 + 1) * 256 + ch] = hh; } }
    __syncthreads();
}

__device__ __forceinline__ void conf_unit(Frame& F, const ArgsV& A_, int l, int unit) {
    const bf16_t* U = (const bf16_t*)(F.ws + WS_U); bf16_t* MIX = (bf16_t*)(F.ws + WS_MIX);
    const float* cw = A_.in[16] + l * 31 * 256; const float* cb = A_.in[17] + l * 256; const float* lg = A_.in[18] + l * 256; const float* lb = A_.in[19] + l * 256;
    LAS float* gin = (LAS float*)F.lds; LAS float* cout = gin + 62 * 256;
    const int ch = F.tid & 255, half = F.tid >> 8, t0 = unit * 32;
    for (int it = F.tid; it < 62 * 32; it += NTHREADS) { const int r = it >> 5, g8 = it & 31, ts = t0 - 30 + r;
        f32x4 v0 = (f32x4){0.f, 0.f, 0.f, 0.f}, v1 = v0;
        if (ts >= 0) { const u32x4 a = *(const u32x4*)(U + (size_t)ts * NCOLA + UCA + 8 * g8), b = *(const u32x4*)(U + (size_t)ts * NCOLA + UCB + 8 * g8);
            v0.x = bflo(a.x) * sigmoidf_(bflo(b.x)); v0.y = bfhi(a.x) * sigmoidf_(bfhi(b.x)); v0.z = bflo(a.y) * sigmoidf_(bflo(b.y)); v0.w = bfhi(a.y) * sigmoidf_(bfhi(b.y));
            v1.x = bflo(a.z) * sigmoidf_(bflo(b.z)); v1.y = bfhi(a.z) * sigmoidf_(bfhi(b.z)); v1.z = bflo(a.w) * sigmoidf_(bflo(b.w)); v1.w = bfhi(a.w) * sigmoidf_(bfhi(b.w)); }
        *(LAS f32x4*)(gin + r * 256 + 8 * g8) = v0; *(LAS f32x4*)(gin + r * 256 + 8 * g8 + 4) = v1; }
    float wreg[31];
#pragma unroll
    for (int j = 0; j < 31; ++j) wreg[j] = cw[j * 256 + ch];
    const float bb = cb[ch];
    __syncthreads();
    { float x[46];
#pragma unroll
      for (int k = 0; k < 46; ++k) x[k] = gin[(half * 16 + k) * 256 + ch];
#pragma unroll
      for (int tt = 0; tt < 16; ++tt) { float a = bb;
#pragma unroll
          for (int j = 0; j < 31; ++j) a += wreg[j] * x[tt + j];
          cout[(half * 16 + tt) * 256 + ch] = a; } }
    __syncthreads();
#pragma unroll
    for (int q = 0; q < 4; ++q) { const int t = 4 * F.wave + q;
        f32x4 v = *(const LAS f32x4*)(cout + t * 256 + 4 * F.lane);
        const float mean = wave_sum((v.x + v.y) + (v.z + v.w), F.lane << 2) * (1.f / 256.f); v = v - mean;
        const float var = wave_sum((v.x * v.x + v.y * v.y) + (v.z * v.z + v.w * v.w), F.lane << 2) * (1.f / 256.f), rstd = __builtin_amdgcn_rsqf(var + LN_EPS);
        const f32x4 gv = *(const f32x4*)(lg + 4 * F.lane), bv = *(const f32x4*)(lb + 4 * F.lane);
        f32x4 y = v * rstd * gv + bv;
        y.x = y.x * sigmoidf_(y.x); y.y = y.y * sigmoidf_(y.y); y.z = y.z * sigmoidf_(y.z); y.w = y.w * sigmoidf_(y.w);
        u32x2 wv; wv.x = pk2(y.x, y.y); wv.y = pk2(y.z, y.w);
        *(u32x2*)(MIX + (size_t)(t0 + t) * 1024 + 768 + 4 * F.lane) = wv; }
    __syncthreads();
}

__device__ __forceinline__ void phase_mixers(Frame& F, const ArgsV& A_, int l, int probe) {
    const bf16_t* U = (const bf16_t*)(F.ws + WS_U); const bf16_t* VT = (const bf16_t*)(F.ws + WS_VT); bf16_t* MIX = (bf16_t*)(F.ws + WS_MIX);
    { const float* KN = (const float*)(F.ws + WS_KN); LAS float* kp = (LAS float*)(F.lds + P2_KP);
      const int tb = F.wave, ln = F.lane;
      const f32x4 v = *(const f32x4*)(KN + tb * 256 + 4 * ln);
      const float p0 = v.x, p1 = fmaxf(p0, v.y), p2 = fmaxf(p1, v.z), p3 = fmaxf(p2, v.w);
      float run = p3;
#pragma unroll
      for (int o = 1; o < 64; o <<= 1) { const float t = shup(run, ln << 2, o); if (ln >= o) run = fmaxf(run, t); }
      float ex = shup(run, ln << 2, 1); if (ln == 0) ex = 0.f;
      f32x4 o4; o4.x = fsqrt(fmaxf(ex, p0)); o4.y = fsqrt(fmaxf(ex, p1)); o4.z = fsqrt(fmaxf(ex, p2)); o4.w = fsqrt(fmaxf(ex, p3));
      *(LAS f32x4*)(kp + tb * 256 + 4 * ln) = o4;
    }
    float d1 = 0.f, d2 = 0.f;
    { const float* lq1 = A_.in[4] + l * 64; const float* lk1 = A_.in[5] + l * 64; const float* lq2 = A_.in[6] + l * 64; const float* lk2 = A_.in[7] + l * 64;
      d1 = wave_sum(lq1[F.lane] * lk1[F.lane], F.lane << 2); d2 = wave_sum(lq2[F.lane] * lk2[F.lane], F.lane << 2); }
    const float lam_init = 0.8f - 0.6f * fexp(-0.3f * (float)l);
    const float lam = fexp(d1) - fexp(d2) + lam_init;
    const float* subg = A_.in[8] + l * 128;
    unsigned* qhead = (unsigned*)(F.ws + WS_CTL) + CW_QUEUE + 64 * l;
    volatile LAS unsigned* slot = (volatile LAS unsigned*)(F.lds + P2_FLG) + 16;
    __syncthreads();
    for (;;) {
        if (F.tid == 0) slot[0] = atomicAdd(qhead, 1u);
        __syncthreads();
        const int q = (int)__builtin_amdgcn_readfirstlane(slot[0]);
        __syncthreads();
        if (q >= N_ITEMS + 256 + 512) break;
        if (probe) {
            if (probe == 1 && q >= N_ITEMS) continue;
            if (probe == 2 && (q < N_ITEMS || q >= N_ITEMS + 256)) continue;
            if (probe == 3 && q < N_ITEMS + 256) continue;
            if (probe >= 4 && probe <= 7 && (q >= N_ITEMS || (g_tabs.item[g_tabs.order[q]] & 3) != probe - 4)) continue;
        }
        Frame Fu = make_frame(F.lds, F.ws);
        if (q < N_ITEMS) { const int idx = g_tabs.order[q], it = g_tabs.item[idx]; const int h = it & 3, qb = (it >> 2) & 127;
            if (it & 0x8000) { const int seg = (it >> 9) & 7, jt_top = 2 * qb + 1 - SEGT * seg; const int jb = jt_top - (SEGT - 1);
                attn::attn_unit(Fu.lds, (const unsigned char*)Fu.ws, (bf16_t*)(Fu.ws + WS_MIX), subg, lam, 1.0f - lam_init, h, qb, jt_top, jb > 0 ? jb : 0, (float*)(Fu.ws + WS_PART) + (size_t)(idx - N_UNSPLIT) * (PART_SLOT / 4), Fu.tid); }
            else attn::attn_unit(Fu.lds, (const unsigned char*)Fu.ws, (bf16_t*)(Fu.ws + WS_MIX), subg, lam, 1.0f - lam_init, h, qb, 2 * qb + 1, 0, nullptr, Fu.tid); }
        else if (q < N_ITEMS + 256) lru_unit(Fu, A_, l, q - N_ITEMS);
        else conf_unit(Fu, A_, l, q - N_ITEMS - 256);
    }
}

__device__ __forceinline__ void phase_lru_fix(Frame& F, const ArgsV& A_, int l) {
    const bf16_t* U = (const bf16_t*)(F.ws + WS_U); bf16_t* MIX = (bf16_t*)(F.ws + WS_MIX);
    const float* HLOC = (const float*)(F.ws + WS_HLOC); const float* CUMA = (const float*)(F.ws + WS_CUMA); const float* AGG = (const float*)(F.ws + WS_AGG);
    LAS float* ag = (LAS float*)F.lds;
    const int ch = F.tid & 255, half = F.tid >> 8;
    for (int unit = F.bid; unit < 256; unit += F.G) {
        const int chunk = unit >> 2, qt = unit & 3, t0 = chunk * 256 + qt * 64 + half * 32;
        for (int i = F.tid; i < chunk * 128; i += NTHREADS) *(LAS f32x4*)(ag + 4 * i) = *(const f32x4*)(AGG + 4 * i);
        __syncthreads();
        float cin = 0.f;
        for (int k = 0; k < chunk; ++k) cin = ag[(k * 2 + 0) * 256 + ch] * cin + ag[(k * 2 + 1) * 256 + ch];
        for (int t = 0; t < 32; ++t) { const size_t tt = (size_t)(t0 + t);
            const float hh = HLOC[tt * 256 + ch] + CUMA[tt * 256 + ch] * cin;
            const float y = bf2f(U[tt * NCOLA + ULY + ch]);
            const float gl = y * frcp(1.0f + fexp(-2.0f * 0.7978845608028654f * (y + 0.044715f * y * y * y)));
            MIX[tt * 1024 + 512 + ch] = (bf16_t)f2bf(hh * gl); }
        __syncthreads();
    }
    { const float* lq1 = A_.in[4] + l * 64; const float* lk1 = A_.in[5] + l * 64; const float* lq2 = A_.in[6] + l * 64; const float* lk2 = A_.in[7] + l * 64;
      const float d1 = wave_sum(lq1[F.lane] * lk1[F.lane], F.lane << 2), d2 = wave_sum(lq2[F.lane] * lk2[F.lane], F.lane << 2);
      const float lam_init = 0.8f - 0.6f * fexp(-0.3f * (float)l), lam = fexp(d1) - fexp(d2) + lam_init;
      for (int unit = F.bid; unit < 112; unit += F.G) attn::attn_combine(F.lds, (const unsigned char*)F.ws, MIX, A_.in[8] + l * 128, lam, 1.0f - lam_init, 16 + unit, F.tid); }
}

__device__ __forceinline__ void phase_ln1(Frame& F, const ArgsV& A_, int l) {
    const float* HA = (const float*)(F.ws + WS_HA); const float* MO = (const float*)(F.ws + WS_MIXO); float* HB = (float*)(F.ws + WS_HB); bf16_t* XB = (bf16_t*)(F.ws + WS_XB);
    const int gw = F.bid * NWAVES + F.wave, NGW = F.G * NWAVES;
    for (int m = gw; m < T; m += NGW) {
        f32x4 v[4];
#pragma unroll
        for (int j = 0; j < 4; ++j) v[j] = *(const f32x4*)(HA + (size_t)m * D + 4 * F.lane + 256 * j) * ALPHA + *(const f32x4*)(MO + (size_t)m * D + 4 * F.lane + 256 * j);
        ln_store(v, A_.in[21] + l * D, A_.in[22] + l * D, HB + (size_t)m * D, nullptr, F.lane, (unsigned char*)(F.ws + WS_XB8) + (size_t)m * D);
    }
}

__device__ __forceinline__ void phase_router(Frame& F, const ArgsV& A_, int l) {
    const float* HB = (const float*)(F.ws + WS_HB); const float* rw = A_.in[23] + (size_t)l * 1024 * 32; const float* rb = A_.in[24] + l * 32;
    int* TKS = (int*)(F.ws + WS_TKS); float* TKG = (float*)(F.ws + WS_TKG); int* LIST = (int*)(F.ws + WS_LIST);
    unsigned* gcnt = (unsigned*)(F.ws + WS_CTL) + CW_CNT + l * 64;
    LAS float* part = (LAS float*)F.lds;
    LAS float* lg = (LAS float*)(F.lds + 65536);
    LAS unsigned* lcnt = (LAS unsigned*)(F.lds + 81920);
    const int ln = F.lane & 31, hf = F.lane >> 5, kb = F.wave * 128;
    float rwv[16][4];
#pragma unroll
    for (int i = 0; i < 16; ++i)
#pragma unroll
        for (int s = 0; s < 4; ++s) rwv[i][s] = rw[(size_t)(kb + 8 * i + 4 * hf + s) * 32 + ln];
    for (int base = F.bid * 64; base < T; base += F.G * 64) {
        if (F.tid < 64) lcnt[F.tid] = 0u;
#pragma unroll
        for (int g = 0; g < 2; ++g) {
            f32x4 hv[16];
            const float* hp = HB + (size_t)(base + 32 * g + ln) * D + kb + 4 * hf;
#pragma unroll
            for (int i = 0; i < 16; ++i) hv[i] = *(const f32x4*)(hp + 8 * i);
            f32x16 acc;
#pragma unroll
            for (int r = 0; r < 16; ++r) acc[r] = 0.f;
#pragma unroll
            for (int i = 0; i < 16; ++i) {
                acc = __builtin_amdgcn_mfma_f32_32x32x2f32(rwv[i][0], hv[i].x, acc, 0, 0, 0);
                acc = __builtin_amdgcn_mfma_f32_32x32x2f32(rwv[i][1], hv[i].y, acc, 0, 0, 0);
                acc = __builtin_amdgcn_mfma_f32_32x32x2f32(rwv[i][2], hv[i].z, acc, 0, 0, 0);
                acc = __builtin_amdgcn_mfma_f32_32x32x2f32(rwv[i][3], hv[i].w, acc, 0, 0, 0);
            }
#pragma unroll
            for (int r = 0; r < 16; ++r) { const int e = (r & 3) + 8 * (r >> 2) + 4 * hf; part[((F.wave * 2 + g) * 32 + e) * 32 + ln] = acc[r]; }
        }
        __syncthreads();
        { const int tt = F.tid & 63, eg = F.tid >> 6;
#pragma unroll
          for (int q = 0; q < 4; ++q) { const int e = 4 * eg + q; float s = rb[e];
#pragma unroll
              for (int w2 = 0; w2 < 8; ++w2) s += part[((w2 * 2 + (tt >> 5)) * 32 + e) * 32 + (tt & 31)];
              lg[tt * 33 + e] = s; } }
        __syncthreads();
        int sel[4]; float sv[4]; int pos[4];
        if (F.tid < 64) {
            float v[32];
#pragma unroll
            for (int e = 0; e < 32; ++e) v[e] = lg[F.tid * 33 + e];
#pragma unroll
            for (int k = 0; k < 4; ++k) { float best = -__builtin_inff(); int bi = 0;
#pragma unroll
                for (int e = 0; e < 32; ++e) { if (v[e] > best) { best = v[e]; bi = e; } }
                sel[k] = bi; sv[k] = best;
#pragma unroll
                for (int e = 0; e < 32; ++e) if (e == bi) v[e] = -__builtin_inff(); }
            const float e1 = fexp(sv[1] - sv[0]), e2 = fexp(sv[2] - sv[0]), e3 = fexp(sv[3] - sv[0]), inv = 1.0f / (1.0f + e1 + e2 + e3);
            sv[0] = inv; sv[1] = e1 * inv; sv[2] = e2 * inv; sv[3] = e3 * inv;
#pragma unroll
            for (int k = 0; k < 4; ++k) pos[k] = (int)atomicAdd((unsigned*)&lcnt[sel[k]], 1u);
        }
        __syncthreads();
        if (F.tid < 32) lcnt[32 + F.tid] = atomicAdd(&gcnt[F.tid], lcnt[F.tid]);
        __syncthreads();
        if (F.tid < 64) {
            const int t = base + F.tid;
#pragma unroll
            for (int k = 0; k < 4; ++k) { const int p = pos[k] + (int)lcnt[32 + sel[k]]; TKS[t * 4 + k] = sel[k] * T + p; TKG[t * 4 + k] = sv[k]; LIST[(size_t)sel[k] * T + p] = t; }
        }
        __syncthreads();
    }
}

__device__ __forceinline__ void moe_tables(Frame& F, int l, int NT) {
    LAS int* tab = (LAS int*)(F.lds + MISC_OFF);
    if (F.wave == 0) {
        const unsigned* gcnt = (const unsigned*)(F.ws + WS_CTL) + CW_CNT + l * 64;
        const int e = F.lane & 31;
        const int c = (int)__hip_atomic_load(&gcnt[e], __ATOMIC_RELAXED, __HIP_MEMORY_SCOPE_AGENT);
        const int tm = (c + 255) >> 8;
        int incl = tm;
#pragma unroll
        for (int o = 1; o < 32; o <<= 1) { const int v = shupi(incl, F.lane << 2, o); if (e >= o) incl += v; }
        if (F.lane < 32) { tab[e] = (incl - tm) * NT; tab[40 + e] = (incl - tm) * 256; tab[80 + e] = c; if (e == 31) tab[32] = incl * NT; }
    }
    __syncthreads();
}

__device__ __forceinline__ void phase_combine(Frame& F, const ArgsV& A_, int l, float* outp) {
    moe_tables(F, l, 1);
    const LAS int* tab = (const LAS int*)(F.lds + MISC_OFF);
    const float* HB = (const float*)(F.ws + WS_HB); const bf16_t* Y = (const bf16_t*)(F.ws + WS_Y);
    const int* TKS = (const int*)(F.ws + WS_TKS); const float* TKG = (const float*)(F.ws + WS_TKG);
    float* HA = outp ? outp : (float*)(F.ws + WS_HA); bf16_t* XB = outp ? nullptr : (bf16_t*)(F.ws + WS_XB);
    const int gw = F.bid * NWAVES + F.wave, NGW = F.G * NWAVES;
    for (int m = gw; m < T; m += NGW) {
        f32x4 v[4];
#pragma unroll
        for (int j = 0; j < 4; ++j) v[j] = *(const f32x4*)(HB + (size_t)m * D + 4 * F.lane + 256 * j) * ALPHA;
#pragma unroll
        for (int k = 0; k < 4; ++k) { const int code = TKS[m * 4 + k]; const float g = TKG[m * 4 + k]; const int e = code >> 14, p = code & (T - 1);
            const bf16_t* yr = Y + (size_t)(tab[40 + e] + p) * 1024 + 4 * F.lane;
#pragma unroll
            for (int j = 0; j < 4; ++j) { const u32x2 wv = *(const u32x2*)(yr + 256 * j); v[j].x += g * bflo(wv.x); v[j].y += g * bfhi(wv.x); v[j].z += g * bflo(wv.y); v[j].w += g * bfhi(wv.y); } }
        ln_store(v, A_.in[29] + l * D, A_.in[30] + l * D, HA + (size_t)m * D, XB ? XB + (size_t)m * D : nullptr, F.lane);
    }
    __syncthreads();
}

constexpr int PH_PER_LAYER = 10, N_PHASES = 1 + NL * PH_PER_LAYER;

__global__ void __launch_bounds__(NTHREADS, 2) mk_fwd(Args args) {
    extern __shared__ __attribute__((aligned(16))) unsigned char lds_raw[];
    LAS unsigned char* const lds = (LAS unsigned char*)lds_raw;
    const int lo = args.ph_lo, hi = args.ph_hi;
    volatile LAS unsigned* bst = (volatile LAS unsigned*)(lds + MISC_OFF + 2048);
    if (threadIdx.x < 2) bst[threadIdx.x] = 0u;
    if (threadIdx.x == 0) {
        LAS unsigned long long* pt = (LAS unsigned long long*)(lds + PTAB_OFF);
#pragma unroll
        for (int k = 0; k < 31; ++k) pt[k] = (unsigned long long)args.in[k];
    }
    __syncthreads();
    XcdBarrier bar; bar.bar = (unsigned*)(args.ws + WS_CTL) + CW_BAR; bar.x = 0; bar.st = bst;
    if (hi - lo > 1) bar = xcd_barrier_post((unsigned*)(args.ws + WS_CTL) + CW_BAR, bst);
    const ArgsV AV{InTab{lds}};
#ifdef ONLY_SUB
    const int only_sub = ONLY_SUB;
#else
    const int only_sub = -2;
#endif
#pragma unroll 1
    for (int ph = lo; ph < hi; ++ph) {
        const int l = (ph > 0) ? (ph - 1) / PH_PER_LAYER : 0;
        int sub = (ph > 0) ? (ph - 1) % PH_PER_LAYER : -1;
        if (only_sub != -2 && sub != only_sub) continue;
        bool seam = true;
        switch (sub) {
        case -1: { Frame F = make_frame(lds, args.ws); phase_prologue(F, AV); } break;
        case 0: {
            Frame F = make_frame(lds, args.ws);
            pg8::PlainOrder S; S.init(WS_XB, WS_WINT + (size_t)l * 2560 * 1024 * 2, T, NCOLA, F.G, F.bid);
            pg8::EpiBf16 E{(bf16_t*)(F.ws + WS_U), NCOLA, nullptr, 0, 0.125f * LOG2E, 512};
            pg8::gemm_phase<pg8::EpiBf16, pg8::PlainOrder, true>(F.lds, (const char*)F.ws, F.tid, S, E); } break;
        case 1: {
            Frame F = make_frame(lds, args.ws);
            pg8::PlainOrder S; S.init(WS_WINT + ((size_t)l * 2560 + 2048) * 1024 * 2, WS_XB, 512, T, F.G, F.bid);
            pg8::EpiVT E{(bf16_t*)(F.ws + WS_VT)};
            pg8::gemm_phase<pg8::EpiVT, pg8::PlainOrder, true>(F.lds, (const char*)F.ws, F.tid, S, E);
            phase_knorm(F); } break;
        case 2: { Frame F = make_frame(lds, args.ws); phase_mixers(F, AV, l, args.probe); } break;
        case 3: { Frame F = make_frame(lds, args.ws); phase_lru_fix(F, AV, l); } break;
        case 4: {
            Frame F = make_frame(lds, args.ws);
            pg8::PlainOrder S; S.init(WS_MIX, WS_WOUTT + (size_t)l * 1024 * 1024 * 2, T, D, F.G, F.bid);
            pg8::EpiF32 E{(float*)(F.ws + WS_MIXO), D};
            pg8::gemm_phase<pg8::EpiF32, pg8::PlainOrder, true>(F.lds, (const char*)F.ws, F.tid, S, E); } break;
        case 5: { Frame F = make_frame(lds, args.ws); phase_ln1(F, AV, l); } break;
        case 6: { Frame F = make_frame(lds, args.ws); phase_router(F, AV, l); } break;
        case 7: {
            Frame F = make_frame(lds, args.ws);
            moe_tables(F, l, 8);
            pg8::MoeOrder S{(unsigned)WS_XB8, (unsigned)(WS_W1T + (size_t)l * NE * 2048 * 1024), 2048u * 1024u, 8, 1, (const int*)(F.ws + WS_LIST), (const LAS int*)(F.lds + MISC_OFF), F.G, F.bid, KD};
            pg8::EpiAct E{(unsigned char*)(F.ws + WS_ACT), AV.in[26] + (size_t)l * NE * 2048};
            pg8::gemm_phase<pg8::EpiAct, pg8::MoeOrder, true, true>(F.lds, (const char*)F.ws, F.tid, S, E); } break;
        case 8: {
            Frame F = make_frame(lds, args.ws);
            moe_tables(F, l, 4);
            pg8::MoeOrder S{(unsigned)WS_ACT, (unsigned)(WS_W2T + (size_t)l * NE * 1024 * 1024), 1024u * 1024u, 4, 0, nullptr, (const LAS int*)(F.lds + MISC_OFF), F.G, F.bid, KD};
            pg8::EpiBf16 E{(bf16_t*)(F.ws + WS_Y), 1024, AV.in[28] + (size_t)l * NE * 1024, 1024, 1.0f, 0};
            pg8::gemm_phase<pg8::EpiBf16, pg8::MoeOrder, true, true>(F.lds, (const char*)F.ws, F.tid, S, E); } break;
        default: { Frame F = make_frame(lds, args.ws); phase_combine(F, AV, l, (l == NL - 1) ? args.out : nullptr); } break;
        }
        if (seam && ph + 1 < hi) xcd_barrier(bar);
    }
}

extern "C" void kernel_launch(void* const* d_in, const int* in_sizes, int n_in, void* d_out, int out_size, void* d_ws, size_t ws_size, hipStream_t stream) {
    static int grid = 0;
    if (grid == 0) {
        if (n_in != 31 || out_size != T * D || ws_size < WS_END2) { fprintf(stderr, "kernel_launch: unexpected sizes n_in %d out %d ws %zu (need %zu)\n", n_in, out_size, ws_size, (size_t)WS_END); grid = -1; return; }
        int dev = 0, cus = 0, per_cu = 0;
        if (hipGetDevice(&dev) != hipSuccess || hipDeviceGetAttribute(&cus, hipDeviceAttributeMultiprocessorCount, dev) != hipSuccess) { grid = -1; return; }
        if (hipFuncSetAttribute((const void*)mk_fwd, hipFuncAttributeMaxDynamicSharedMemorySize, LDS_BYTES) != hipSuccess) { fprintf(stderr, "kernel_launch: hipFuncSetAttribute failed\n"); grid = -1; return; }
        if (hipOccupancyMaxActiveBlocksPerMultiprocessor(&per_cu, (const void*)mk_fwd, NTHREADS, LDS_BYTES) != hipSuccess || per_cu < 1) { fprintf(stderr, "kernel_launch: occupancy query says %d blocks per CU\n", per_cu); (void)hipGetLastError(); grid = -1; return; }
        grid = cus;
    }
    if (grid < 0) return;
    (void)hipMemsetAsync((char*)d_ws + WS_CTL, 0, CTL_ZERO_BYTES, stream);
    Args a{};
    for (int i = 0; i < 31; ++i) a.in[i] = (const float*)d_in[i];
    a.out = (float*)d_out; a.ws = (unsigned char*)d_ws;
#if MK_ONE_LAUNCH
    a.ph_lo = 0; a.ph_hi = N_PHASES;
    hipLaunchKernelGGL(mk_fwd, dim3(grid), dim3(NTHREADS), LDS_BYTES, stream, a);
#ifdef PROBE_LO
    (void)hipMemsetAsync((char*)d_ws + WS_CTL + CW_BAR * 4, 0, XCD_BAR_WORDS * 4, stream);
    (void)hipMemsetAsync((char*)d_ws + WS_CTL + CW_QUEUE * 4, 0, 1024, stream);
    a.probe = PROBE_MODE;
    a.ph_lo = PROBE_LO; a.ph_hi = PROBE_HI;
    hipLaunchKernelGGL(mk_fwd, dim3(grid), dim3(NTHREADS), LDS_BYTES, stream, a);
#endif
#else
    for (int p = 0; p < N_PHASES; ++p) { a.ph_lo = p; a.ph_hi = p + 1; hipLaunchKernelGGL(mk_fwd, dim3(grid), dim3(NTHREADS), LDS_BYTES, stream, a); }
#endif
}
```
